# Optimizing an MI355X kernel written in HIP

```python
import jax
import jax.numpy as jnp
from jax import lax
import numpy as np

D_MODEL = 2048
BATCH = 1
SEQ = 16384
DEPTH = 2

GRID_W = 64
CTX_LEN = 256
NORM_EPS = 1e-6
MLA_HEADS = D_MODEL // 256
MLA_Q_RANK = D_MODEL // 4
MLA_KV_RANK = D_MODEL // 8
MLA_NOPE = 128
MLA_ROPE = 64
MLA_V = 128
MLA_SCALE = (MLA_NOPE + MLA_ROPE) ** -0.5
ROPE_THETA = 10000.0
Q_BLOCK = 128
NA_HEADS = D_MODEL // 256
NA_DIM = 128
NA_WIN_H = 8
NA_WIN_W = 16
NA_SCALE = NA_DIM ** -0.5
NA_WIDTH = NA_HEADS * NA_DIM
FNET_GROUPS = 8
FNET_GROUP_DIM = D_MODEL // FNET_GROUPS
N_EXPERTS = 16
EXPERT_FF = D_MODEL
EC_CAPACITY = 2
IN_SPLITS = (MLA_Q_RANK,
             MLA_Q_RANK + MLA_KV_RANK,
             MLA_Q_RANK + MLA_KV_RANK + MLA_ROPE,
             MLA_Q_RANK + MLA_KV_RANK + MLA_ROPE + NA_WIDTH,
             MLA_Q_RANK + MLA_KV_RANK + MLA_ROPE + 2 * NA_WIDTH)
IN_WIDTH = MLA_Q_RANK + MLA_KV_RANK + MLA_ROPE + 3 * NA_WIDTH
MIX_WIDTH = MLA_HEADS * MLA_V + NA_WIDTH
N_ATTN_LAYERS = (DEPTH + 1) // 2
N_FOURIER_LAYERS = DEPTH // 2

kernel_name = 'hybrid_mla_natten_fnet_ecmoe_dit'


def rms_norm(x, g):
    xf = x.astype(jnp.float32)
    y = xf * lax.rsqrt(jnp.mean(xf * xf, axis=-1, keepdims=True) + NORM_EPS)
    return (y * g.astype(jnp.float32)).astype(x.dtype)


def modulate(x, g, shift, scale):
    return rms_norm(x, g) * (1 + scale) + shift


def ada_terms(cvec, w, b):
    m = jax.nn.silu(cvec) @ w + b
    return jnp.split(m[..., None, :], 6, axis=-1)


def axial_angles(n):
    t = jnp.arange(n)
    n_freq = MLA_ROPE // 4
    inv_freq = ROPE_THETA ** (-jnp.arange(n_freq, dtype=jnp.float32) / n_freq)
    row = (t // GRID_W).astype(jnp.float32)[:, None] * inv_freq
    col = (t % GRID_W).astype(jnp.float32)[:, None] * inv_freq
    return row, col


def rotate_pairs(x, ang):
    x1, x2 = jnp.split(x, 2, axis=-1)
    cos = jnp.cos(ang).astype(x.dtype)
    sin = jnp.sin(ang).astype(x.dtype)
    return jnp.concatenate([x1 * cos - x2 * sin, x2 * cos + x1 * sin], axis=-1)


def rope_2d(x, ang_row, ang_col):
    x_row, x_col = jnp.split(x, 2, axis=-1)
    return jnp.concatenate([rotate_pairs(x_row, ang_row), rotate_pairs(x_col, ang_col)], axis=-1)


def project_heads(h, w_in, g_qn, w_uq, g_kvn, w_ukv, with_q):
    lead = h.shape[:-1]
    c_q, c_kv, k_rope, q_na, k_na, v_na = jnp.split(h @ w_in, IN_SPLITS, axis=-1)
    kv = (rms_norm(c_kv, g_kvn) @ w_ukv).reshape(*lead, MLA_HEADS, MLA_NOPE + MLA_V)
    heads = lambda t: t.reshape(*lead, NA_HEADS, NA_DIM)
    keys = (kv[..., :MLA_NOPE], k_rope, kv[..., MLA_NOPE:], heads(k_na), heads(v_na))
    if not with_q:
        return None, keys
    q = (rms_norm(c_q, g_qn) @ w_uq).reshape(*lead, MLA_HEADS, MLA_NOPE + MLA_ROPE)
    return (q[..., :MLA_NOPE], q[..., MLA_NOPE:], heads(q_na)), keys


def mla_attend(q_nope, q_rope, k_nope, k_rope, v):
    s = (jnp.einsum('bqhd,bkhd->bhqk', q_nope, k_nope).astype(jnp.float32)
         + jnp.einsum('bqhr,bkr->bhqk', q_rope, k_rope).astype(jnp.float32)) * MLA_SCALE
    p = jax.nn.softmax(s, axis=-1).astype(v.dtype)
    return jnp.einsum('bhqk,bkhd->bqhd', p, v)


def dense_attend(q, k, v, scale):
    s = jnp.einsum('bqhd,bkhd->bhqk', q, k).astype(jnp.float32) * scale
    p = jax.nn.softmax(s, axis=-1).astype(v.dtype)
    return jnp.einsum('bhqk,bkhd->bqhd', p, v)


def na_latent(q, k, v, k_ctx, v_ctx, rel_bias):
    b, n, nh, dh = q.shape
    rows_total = n // GRID_W
    wh = min(NA_WIN_H, rows_total)
    r = jnp.arange(rows_total)
    row_start = jnp.clip(r - wh // 2, 0, rows_total - wh)
    rows = row_start[:, None] + jnp.arange(wh)
    cq = jnp.arange(GRID_W)
    col_start = jnp.clip(cq - NA_WIN_W // 2, 0, GRID_W - NA_WIN_W)
    ck = jnp.arange(GRID_W)
    valid = (ck[None, :] >= col_start[:, None]) & (ck[None, :] < col_start[:, None] + NA_WIN_W)
    ro = rows - r[:, None] + NA_WIN_H - 1
    co = jnp.clip(ck[None, :] - cq[:, None] + NA_WIN_W - 1, 0, 2 * NA_WIN_W - 2)
    bias = rel_bias[:, ro[:, None, :, None], co[None, :, None, :]]
    qg = q.reshape(b, rows_total, GRID_W, nh, dh)
    kb = k.reshape(b, rows_total, GRID_W, nh, dh)[:, rows]
    vb = v.reshape(b, rows_total, GRID_W, nh, dh)[:, rows]
    s_loc = jnp.einsum('brqhd,brjkhd->bhrqjk', qg, kb).astype(jnp.float32) * NA_SCALE + bias[None].astype(jnp.float32)
    s_loc = jnp.where(valid[:, None, :], s_loc, jnp.finfo(jnp.float32).min)
    s_ctx = jnp.einsum('bnhd,bchd->bhnc', q, k_ctx).astype(jnp.float32) * NA_SCALE
    n_ctx = k_ctx.shape[1]
    s = jnp.concatenate([s_ctx, s_loc.reshape(b, nh, n, wh * GRID_W)], axis=-1)
    p = jax.nn.softmax(s, axis=-1).astype(v.dtype)
    p_ctx = p[..., :n_ctx]
    p_loc = p[..., n_ctx:].reshape(b, nh, rows_total, GRID_W, wh, GRID_W)
    o_loc = jnp.einsum('bhrqjk,brjkhd->brqhd', p_loc, vb).reshape(b, n, nh, dh)
    return jnp.einsum('bhnc,bchd->bnhd', p_ctx, v_ctx) + o_loc


def attention_mixer(h, hc, ang_row, ang_col, w_in, g_qn, w_uq, g_kvn, w_ukv, rel_bias, w_out, ctx_live):
    b, n, _ = h.shape
    (qn, qr, qa), (kn, kr, v, ka, va) = project_heads(h, w_in, g_qn, w_uq, g_kvn, w_ukv, True)
    qr = rope_2d(qr, ang_row[:, None], ang_col[:, None])
    kr = rope_2d(kr, ang_row, ang_col)
    cq, (ckn, ckr, cv, cka, cva) = project_heads(hc, w_in, g_qn, w_uq, g_kvn, w_ukv, ctx_live)
    kn_all = jnp.concatenate([ckn, kn], axis=1)
    kr_all = jnp.concatenate([ckr, kr], axis=1)
    v_all = jnp.concatenate([cv, v], axis=1)
    nb = n // Q_BLOCK
    def blocks(t):
        return jnp.moveaxis(t.reshape(b, nb, Q_BLOCK, *t.shape[2:]), 1, 0)
    o_a = lax.map(lambda qb: mla_attend(qb[0], qb[1], kn_all, kr_all, v_all), (blocks(qn), blocks(qr)))
    o_a = jnp.moveaxis(o_a, 0, 1).reshape(b, n, MLA_HEADS * MLA_V)
    o_b = na_latent(qa, ka, va, cka, cva, rel_bias).reshape(b, n, NA_WIDTH)
    y = jnp.concatenate([o_a, o_b], axis=-1) @ w_out
    if not ctx_live:
        return y, None
    cqn, cqr, cqa = cq
    n_ctx = hc.shape[1]
    oc_a = mla_attend(cqn, cqr, ckn, ckr, cv).reshape(b, n_ctx, MLA_HEADS * MLA_V)
    oc_b = dense_attend(cqa, cka, cva, NA_SCALE).reshape(b, n_ctx, NA_WIDTH)
    return y, jnp.concatenate([oc_a, oc_b], axis=-1) @ w_out


def fourier_mixer(h, w_out):
    b, n, d = h.shape
    hg = h.astype(jnp.float32).reshape(b, n, FNET_GROUPS, FNET_GROUP_DIM)
    f = jnp.fft.fft2(hg, axes=(1, 3), norm='ortho').real
    return f.reshape(b, n, d).astype(h.dtype) @ w_out


def ec_moe(h, w_router, w_gate, w_up, w_down):
    b, n, d = h.shape
    cap = EC_CAPACITY * n // N_EXPERTS
    aff = jax.nn.softmax((h @ w_router).astype(jnp.float32), axis=-1)
    gates, idx = lax.top_k(jnp.swapaxes(aff, 1, 2), cap)
    def per_sample(hs, gs, ids):
        xs = hs[ids]
        a = jnp.einsum('ecd,edf->ecf', xs, w_gate)
        u = jnp.einsum('ecd,edf->ecf', xs, w_up)
        y = jnp.einsum('ecf,efd->ecd', jax.nn.silu(a) * u, w_down) * gs[..., None].astype(hs.dtype)
        return jnp.zeros_like(hs).at[ids.reshape(-1)].add(y.reshape(-1, d))
    return jax.vmap(per_sample)(h, gates, idx)


def setup_inputs(seed: int = 0) -> dict:
    key = jax.random.key(seed)
    ks = jax.random.split(key, 22)
    def nrm(k, shape, s):
        return jax.random.normal(k, shape, jnp.float32) * s
    d = D_MODEL
    na_l = N_ATTN_LAYERS
    nf_l = N_FOURIER_LAYERS
    return {
        'x': nrm(ks[0], (BATCH, SEQ, d), 1.0),
        'c': nrm(ks[1], (BATCH, d), 1.0),
        'ctx': nrm(ks[2], (BATCH, CTX_LEN, d), 1.0),
        'c_ctx': nrm(ks[3], (d,), 1.0),
        'ada_w': nrm(ks[4], (DEPTH, d, 6 * d), 0.5 * d ** -0.5),
        'ada_b': nrm(ks[5], (DEPTH, 6 * d), 0.02),
        'g_mix': 1.0 + nrm(ks[6], (DEPTH, d), 0.02),
        'g_ffn': 1.0 + nrm(ks[7], (DEPTH, d), 0.02),
        'g_final': 1.0 + nrm(ks[8], (d,), 0.02),
        'w_in': nrm(ks[9], (na_l, d, IN_WIDTH), d ** -0.5),
        'g_qn': 1.0 + nrm(ks[10], (na_l, MLA_Q_RANK), 0.02),
        'w_uq': nrm(ks[11], (na_l, MLA_Q_RANK, MLA_HEADS * (MLA_NOPE + MLA_ROPE)), MLA_Q_RANK ** -0.5),
        'g_kvn': 1.0 + nrm(ks[12], (na_l, MLA_KV_RANK), 0.02),
        'w_ukv': nrm(ks[13], (na_l, MLA_KV_RANK, MLA_HEADS * (MLA_NOPE + MLA_V)), MLA_KV_RANK ** -0.5),
        'na_rel_bias': nrm(ks[14], (na_l, NA_HEADS, 2 * NA_WIN_H - 1, 2 * NA_WIN_W - 1), 0.1),
        'w_out_attn': nrm(ks[15], (na_l, MIX_WIDTH, d), MIX_WIDTH ** -0.5),
        'w_out_fourier': nrm(ks[16], (nf_l, d, d), d ** -0.5),
        'w_router': nrm(ks[17], (DEPTH, d, N_EXPERTS), d ** -0.5),
        'w_gate': nrm(ks[18], (DEPTH, N_EXPERTS, d, EXPERT_FF), d ** -0.5),
        'w_up': nrm(ks[19], (DEPTH, N_EXPERTS, d, EXPERT_FF), d ** -0.5),
        'w_down': nrm(ks[20], (DEPTH, N_EXPERTS, EXPERT_FF, d), EXPERT_FF ** -0.5),
    }


def reference(x, c, ctx, c_ctx, ada_w, ada_b, g_mix, g_ffn, g_final, w_in, g_qn, w_uq, g_kvn, w_ukv,
              na_rel_bias, w_out_attn, w_out_fourier, w_router, w_gate, w_up, w_down):
    n_tok = x.shape[1]
    ang_row, ang_col = axial_angles(n_tok)
    last_attn = 2 * ((DEPTH - 1) // 2)
    for i in range(DEPTH):
        ctx_live = i < last_attn
        sh_m, sc_m, g_m, sh_f, sc_f, g_f = ada_terms(c, ada_w[i], ada_b[i])
        h = modulate(x, g_mix[i], sh_m, sc_m)
        if i % 2 == 0 or ctx_live:
            csh_m, csc_m, cg_m, csh_f, csc_f, cg_f = ada_terms(c_ctx, ada_w[i], ada_b[i])
            hc = modulate(ctx, g_mix[i], csh_m, csc_m)
        j = i // 2
        if i % 2 == 0:
            y, yc = attention_mixer(h, hc, ang_row, ang_col, w_in[j], g_qn[j], w_uq[j], g_kvn[j], w_ukv[j],
                                    na_rel_bias[j], w_out_attn[j], ctx_live)
        else:
            y = fourier_mixer(h, w_out_fourier[j])
            yc = fourier_mixer(hc, w_out_fourier[j]) if ctx_live else None
        x = x + g_m * y
        x = x + g_f * ec_moe(modulate(x, g_ffn[i], sh_f, sc_f), w_router[i], w_gate[i], w_up[i], w_down[i])
        if ctx_live:
            ctx = ctx + cg_m * yc
            ctx = ctx + cg_f * ec_moe(modulate(ctx, g_ffn[i], csh_f, csc_f), w_router[i], w_gate[i], w_up[i], w_down[i])
    return rms_norm(x, g_final)
```

```cpp
#include <hip/hip_runtime.h>
#include <cstdio>
#include <cstdint>

#ifndef N_LAUNCH_MODE
#define N_LAUNCH_MODE 0
#endif
#ifndef DEBUG_CHECK
#define DEBUG_CHECK 0
#endif

typedef unsigned short bf16_t;
typedef short bf16x8 __attribute__((ext_vector_type(8)));
typedef short s16x4 __attribute__((ext_vector_type(4)));
typedef float f32x2 __attribute__((ext_vector_type(2)));
typedef float f32x4 __attribute__((ext_vector_type(4)));
typedef float f32x16 __attribute__((ext_vector_type(16)));
typedef unsigned u32x2 __attribute__((ext_vector_type(2)));
typedef unsigned u32x4 __attribute__((ext_vector_type(4)));
#define LAS __attribute__((address_space(3)))

constexpr int DM = 2048, NTOK = 16384, NCTX = 256, NKEY = NTOK + NCTX, GW = 64, GH = 256;
constexpr int NH = 8, NE = 16, CAP = 2048, FF = 2048;
constexpr int INW = 3904, INWP = 4096;
constexpr float EPS = 1e-6f;
constexpr float LOG2E = 1.4426950408889634f;
constexpr float MLA_QS = 0.07216878364870322f * LOG2E;
constexpr float NA_QS = 0.08838834764831845f * LOG2E;
constexpr int NTHR = 512;

constexpr size_t al256(size_t x) { return (x + 255) / 256 * 256; }
constexpr size_t OFF_BAR = 0;
constexpr size_t OFF_ADA = 16384;
constexpr size_t OFF_ROPE = OFF_ADA + al256((2 * 12288 + 4096) * 4);
constexpr size_t OFF_TW = OFF_ROPE + 256 * 16 * 2 * 4;
constexpr size_t OFF_DFT1 = OFF_TW + 128 * 128 * 2 * 4;
constexpr size_t OFF_WA = OFF_DFT1 + 512 * 256 * 2;
constexpr size_t OFF_WB = OFF_WA + 256 * 256 * 2;
constexpr size_t OFF_ERR = OFF_WB + 256 * 256 * 2;
constexpr size_t OFF_WIN = OFF_ERR + 4096;
constexpr size_t OFF_WUQ = OFF_WIN + (size_t)INWP * DM * 2;
constexpr size_t OFF_WUKV = OFF_WUQ + (size_t)1536 * 512 * 2;
constexpr size_t OFF_WOUT = OFF_WUKV + (size_t)2048 * 256 * 2;
constexpr size_t OFF_WFOUT = OFF_WOUT + (size_t)DM * DM * 2;
constexpr size_t OFF_WGU = OFF_WFOUT + (size_t)DM * DM * 2;
constexpr size_t OFF_WD = OFF_WGU + (size_t)2 * NE * 4096 * DM * 2;
constexpr size_t OFF_H = OFF_WD + (size_t)2 * NE * DM * FF * 2;
constexpr size_t OFF_X1 = OFF_H + (size_t)NKEY * DM * 2;
constexpr size_t OFF_X2 = OFF_X1 + (size_t)NTOK * DM * 4;
constexpr size_t OFF_AFF = OFF_X2 + (size_t)NTOK * DM * 4;
constexpr size_t OFF_IDX = OFF_AFF + (size_t)NE * NTOK * 4;
constexpr size_t OFF_GATE = OFF_IDX + (size_t)NE * CAP * 4;
constexpr size_t OFF_SLOT = OFF_GATE + (size_t)NE * CAP * 4;
constexpr size_t OFF_ACT = OFF_SLOT + (size_t)NTOK * NE * 4;
constexpr size_t OFF_YE = OFF_ACT + (size_t)NE * CAP * FF * 2;
constexpr size_t OFF_OCAT = OFF_YE + (size_t)NE * CAP * DM * 2;
constexpr size_t OFF_CQ = OFF_OCAT + (size_t)NTOK * DM * 2;
constexpr size_t OFF_CKV = OFF_CQ + (size_t)NTOK * 512 * 2;
constexpr size_t OFF_PSQ = OFF_CKV + (size_t)NKEY * 256 * 2;
constexpr size_t OFF_KR = OFF_PSQ + al256((size_t)NKEY * 24 * 4);
constexpr size_t OFF_QNA = OFF_KR + (size_t)NKEY * 64 * 2;
constexpr size_t OFF_KNA = OFF_QNA + (size_t)NH * NTOK * 128 * 2;
constexpr size_t OFF_VNA = OFF_KNA + (size_t)NH * NKEY * 128 * 2;
constexpr size_t OFF_Q = OFF_VNA + (size_t)NH * NKEY * 128 * 2;
constexpr size_t OFF_KN = OFF_Q + (size_t)NH * NTOK * 192 * 2;
constexpr size_t OFF_V = OFF_KN + (size_t)NH * NKEY * 128 * 2;
constexpr size_t WS_END = OFF_V + (size_t)NH * NKEY * 128 * 2;

struct Params {
    const float *x, *c, *ctx, *c_ctx, *ada_w, *ada_b, *g_mix, *g_ffn, *g_final, *w_in, *g_qn, *w_uq, *g_kvn, *w_ukv,
        *na_bias, *w_out_attn, *w_out_fourier, *w_router, *w_gate, *w_up, *w_down;
    float* out;
    char* ws;
};

__device__ __forceinline__ unsigned cvtpk(float lo, float hi) {
    unsigned r; asm volatile("v_cvt_pk_bf16_f32 %0, %1, %2" : "=v"(r) : "v"(lo), "v"(hi)); return r;
}
__device__ __forceinline__ float bf2f(bf16_t b) { return __uint_as_float(((unsigned)b) << 16); }
__device__ __forceinline__ bf16_t f2bf(float f) { return (bf16_t)(cvtpk(f, 0.f) & 0xffffu); }
__device__ __forceinline__ float wave_sum(float v) {
#pragma unroll
    for (int o = 32; o > 0; o >>= 1) v += __shfl_xor(v, o, 64);
    return v;
}
extern __shared__ __attribute__((aligned(16))) char g_smem[];
constexpr int LDS_STAGE = 131072, LDS_XBW = LDS_STAGE, LDS_WTAB = LDS_STAGE + 16, LDS_BYTES = LDS_STAGE + 16 + 256;
__device__ __forceinline__ unsigned hw_slot() { return (unsigned)__builtin_amdgcn_s_getreg((5 << 11) | 4) & 63u; }
__device__ __forceinline__ void ltid_init() { const int t = threadIdx.x; if ((t & 63) == 0) ((volatile int*)(g_smem + LDS_WTAB))[hw_slot()] = t >> 6; __syncthreads(); }
__device__ __forceinline__ int ltid() {
    int w = ((volatile int*)(g_smem + LDS_WTAB))[hw_slot()];
    w = __builtin_amdgcn_readfirstlane(w);
    const int lane = __builtin_amdgcn_mbcnt_hi(~0u, __builtin_amdgcn_mbcnt_lo(~0u, 0u));
    int t = w * 64 + lane; asm volatile("" : "+v"(t)); return t;
}
__device__ __forceinline__ int lbid() { int t = blockIdx.x; asm volatile("" : "+s"(t)); return t; }
__device__ __forceinline__ float siluf(float v) { return v / (1.f + __expf(-v)); }

#define XB_TMO      128
#define XB_XCNT(j)  (256  + 64 * (j))
#define XB_XSUB(j)  (1280 + 64 * (j))
#define XB_XGEN(j)  (2304 + 64 * (j))
#define XB_TOP      3328
#define XB_TOPGEN   3392
#define XCD_BAR_WORDS 3456
#define XB_SPIN_CAP (1u << 18)
__device__ __forceinline__ unsigned xb_ld(unsigned* p)              { return __hip_atomic_load(p, __ATOMIC_RELAXED, __HIP_MEMORY_SCOPE_AGENT); }
__device__ __forceinline__ unsigned xb_add(unsigned* p, unsigned v) { return __hip_atomic_fetch_add(p, v, __ATOMIC_RELAXED, __HIP_MEMORY_SCOPE_AGENT); }
__device__ __forceinline__ unsigned xb_xcc_id() { return (unsigned)__builtin_amdgcn_s_getreg((3 << 11) | 20) & 0xFu; }
#define XB_SPIN(cond, bar) do { unsigned _sp = 0; while (cond) { __builtin_amdgcn_s_sleep(1); \
    if ((++_sp & 255u) == 0u) { if (xb_ld(&(bar)[XB_TMO])) break; if (_sp > XB_SPIN_CAP) { atomicAdd(&(bar)[XB_TMO], 1u); break; } } } } while (0)
struct XcdBarrier { unsigned* bar; unsigned x; volatile LAS unsigned* st; };
__device__ __forceinline__ XcdBarrier xcd_barrier_post(unsigned* bar, volatile LAS unsigned* st) {
    XcdBarrier b; b.bar = bar; b.x = xb_xcc_id(); b.st = st;
    if (ltid() == 0) (void)xb_add(&bar[XB_XCNT(b.x)], 1u);
    return b;
}
__device__ __forceinline__ void xcd_barrier_complete(unsigned* bar, unsigned x, unsigned& nloc, unsigned& nx) {
    const unsigned G = gridDim.x * gridDim.y * gridDim.z;
    unsigned sum, cnt, mine, sp = 0u;
    for (;;) {
        sum = 0u; cnt = 0u; mine = 0u;
#pragma unroll
        for (unsigned j = 0; j < 16; ++j) { const unsigned c = xb_ld(&bar[XB_XCNT(j)]); sum += c; cnt += (c > 0u) ? 1u : 0u; mine = (j == x) ? c : mine; }
        if (sum == G) break;
        __builtin_amdgcn_s_sleep(1);
        if ((++sp & 255u) == 0u) { if (xb_ld(&bar[XB_TMO])) break; if (sp > XB_SPIN_CAP) { atomicAdd(&bar[XB_TMO], 1u); break; } }
    }
    nloc = mine > 0u ? mine : 1u; nx = cnt > 0u ? cnt : 1u;
}
__device__ __forceinline__ void xcd_barrier(const XcdBarrier& b) {
    asm volatile("s_waitcnt vmcnt(0)" ::: "memory");
    __syncthreads();
    if (ltid() == 0) {
        unsigned* bar = b.bar;
        __builtin_amdgcn_s_waitcnt(0);
        unsigned nloc = b.st[0], nx = b.st[1];
        if (nloc == 0u) { xcd_barrier_complete(bar, b.x, nloc, nx); b.st[0] = nloc; b.st[1] = nx; }
        const unsigned old = xb_add(&bar[XB_XSUB(b.x)], 1u);
        const unsigned gen = old / nloc;
        if (old + 1u == (gen + 1u) * nloc) {
            __builtin_amdgcn_fence(__ATOMIC_RELEASE, "agent");
            asm volatile("s_waitcnt vmcnt(0)" ::: "memory");
            const unsigned og = xb_add(&bar[XB_TOP], 1u);
            const unsigned tg = og / nx;
            if (og + 1u == (tg + 1u) * nx) xb_add(&bar[XB_TOPGEN], 1u);
            else XB_SPIN(xb_ld(&bar[XB_TOPGEN]) == tg, bar);
            __builtin_amdgcn_fence(__ATOMIC_ACQUIRE, "agent");
            xb_add(&bar[XB_XGEN(b.x)], 1u);
            asm volatile("s_waitcnt vmcnt(0)" ::: "memory");
        } else {
            XB_SPIN(xb_ld(&bar[XB_XGEN(b.x)]) == gen, bar);
            __builtin_amdgcn_fence(__ATOMIC_ACQUIRE, "agent");
            asm volatile("s_waitcnt vmcnt(0)" ::: "memory");
        }
    }
    __syncthreads();
}

namespace pg8 {
constexpr int BM = 256, BK = 64, HALF = 128, HTB = HALF * BK * 2, STAGE_BYTES = 8 * HTB, NXCD = 8, WGM = 8;
__host__ __device__ __forceinline__ int lds_byte(int r, int c) { const int st = (r >> 4) * 2 + (c >> 5), rr = r & 15, cc = c & 31, ob = rr * 64 + cc * 2; return st * 1024 + (ob ^ (((ob >> 9) & 1) << 5)); }
__host__ __device__ __forceinline__ void stage_rc(int b, int& R, int& C) { const int st = b / 1024, sb = b % 1024, swz = sb ^ (((sb >> 9) & 1) << 5); R = (st >> 1) * 16 + swz / 64; C = (st & 1) * 32 + (swz % 64) / 2; }
__host__ __device__ __forceinline__ int perm32(int rho) { const int n = rho >> 4, i = rho & 15; return 8 * (i >> 2) + 4 * n + (i & 3); }
struct Unit { int pm, pn; };
struct StaticOrder {
    int nM, nN, nwg, G, c;
    __device__ void init(int nM_, int nN_, int G_, int c_) { nM = nM_; nN = nN_; nwg = nM * nN; G = G_; c = c_; }
    __device__ bool next(int i, Unit& u) const {
        const long L = (long)i * G + c; if (L >= nwg) return false;
        int wgid = (int)L; { const int q = nwg / NXCD, r = nwg % NXCD, xcd = wgid % NXCD, off = wgid / NXCD; wgid = (xcd < r ? xcd * (q + 1) : r * (q + 1) + (xcd - r) * q) + off; }
        const int nig = WGM * nN, gid = wgid / nig, fm = gid * WGM, gsz = (nM - fm) < WGM ? (nM - fm) : WGM;
        u.pm = fm + ((wgid % nig) % gsz); u.pn = (wgid % nig) / gsz; return true;
    }
};

template <class Desc, class Epi>
__device__ __forceinline__ void gemm_phase(LAS unsigned char* lds, const Desc& D, const StaticOrder& S, const Epi& E) {
    const int tid = ltid(), wid = __builtin_amdgcn_readfirstlane(tid >> 6), lane = tid & 63, wr = wid >> 2, wc = wid & 3, fr = lane & 15, fq = lane >> 4;
    const int K = D.K, nt = K / BK;
    int sR[2], sC[2];
    unsigned voffA[2][2], voffB[2][2], nvA[2][2];
#pragma unroll
    for (int i = 0; i < 2; ++i) { stage_rc(tid * 16 + i * 8192, sR[i], sC[i]);
        const int Rb = Epi::PERM ? ((sR[i] & ~31) + perm32(sR[i] & 31)) : sR[i];
#pragma unroll
        for (int h = 0; h < 2; ++h) { voffA[h][i] = D.arow(sR[i] + HALF * h) + (unsigned)sC[i] * 2u; voffB[h][i] = D.brow(Rb + HALF * h) + (unsigned)sC[i] * 2u; nvA[h][i] = voffA[h][i]; } }
    const size_t kstep = (size_t)(BK * 2);
    const unsigned ldsw = (unsigned)wid * 1024u;
    const int aoff = lds_byte(wr * 64 + fr, fq * 8), boff = lds_byte(wc * 32 + fr, fq * 8);
#define PG8_SA(b, h) (((b) * 2 + (h)) * HTB)
#define PG8_SB(b, h) ((4 + (b) * 2 + (h)) * HTB)
#define PG8_STAGE(bufoff, gbase, voff) do { _Pragma("unroll") for (int _i = 0; _i < 2; ++_i) \
        __builtin_amdgcn_global_load_lds((const unsigned*)((const char*)(gbase) + (voff)[_i]), (LAS unsigned*)(lds + (bufoff) + ldsw + _i * 8192), 16, 0, 0); } while (0)
#define PG8_LDA(dst, b, h) do { _Pragma("unroll") for (int m = 0; m < 4; ++m) _Pragma("unroll") for (int k = 0; k < 2; ++k) dst[m][k] = *(const LAS bf16x8*)(lds + PG8_SA(b, h) + aoff + m * 2048 + k * 1024); } while (0)
#define PG8_LDB(dst, b, h) do { _Pragma("unroll") for (int n = 0; n < 2; ++n) _Pragma("unroll") for (int k = 0; k < 2; ++k) dst[n][k] = *(const LAS bf16x8*)(lds + PG8_SB(b, h) + boff + n * 2048 + k * 1024); } while (0)
#define PG8_MMA(ai, bj, At, Bt) do { __builtin_amdgcn_s_setprio(1); _Pragma("unroll") for (int m = 0; m < 4; ++m) _Pragma("unroll") for (int n = 0; n < 2; ++n) _Pragma("unroll") for (int k = 0; k < 2; ++k) \
        acc[ai][bj][m][n] = __builtin_amdgcn_mfma_f32_16x16x32_bf16(Bt[n][k], At[m][k], acc[ai][bj][m][n], 0, 0, 0); __builtin_amdgcn_s_setprio(0); } while (0)
#define PG8_WAIT_V(n) asm volatile("s_waitcnt vmcnt(" #n ")" ::: "memory")
#define PG8_WAIT_L(n) asm volatile("s_waitcnt lgkmcnt(" #n ")" ::: "memory")
#define PG8_BAR __builtin_amdgcn_s_barrier()
#define PG8_SCHED __builtin_amdgcn_sched_barrier(0)
    Unit cur, nxt; int ui = 0;
    if (!S.next(0, cur)) return;
    f32x4 acc[2][2][4][2];
#pragma unroll
    for (int a = 0; a < 2; ++a)
#pragma unroll
        for (int b = 0; b < 2; ++b)
#pragma unroll
            for (int m = 0; m < 4; ++m)
#pragma unroll
                for (int n = 0; n < 2; ++n) acc[a][b][m][n] = (f32x4){0.f, 0.f, 0.f, 0.f};
    bf16x8 At[4][2], B0[2][2], B1[2][2];
    if constexpr (Desc::GATHER) {
#pragma unroll
        for (int i = 0; i < 2; ++i)
#pragma unroll
            for (int h = 0; h < 2; ++h) { voffA[h][i] = D.agather(cur, sR[i] + HALF * h) + (unsigned)sC[i] * 2u; nvA[h][i] = voffA[h][i]; }
    }
    const char* cA = D.A + D.abase(cur); const char* cB = D.B + D.bbase(cur);
    PG8_STAGE(PG8_SB(0, 0), cB, voffB[0]); PG8_STAGE(PG8_SA(0, 0), cA, voffA[0]); PG8_STAGE(PG8_SB(0, 1), cB, voffB[1]); PG8_STAGE(PG8_SA(0, 1), cA, voffA[1]);
    if (wr == 1) PG8_BAR;
    PG8_WAIT_V(4); PG8_BAR;
    PG8_STAGE(PG8_SB(1, 0), cB + kstep, voffB[0]); PG8_STAGE(PG8_SA(1, 0), cA + kstep, voffA[0]); PG8_STAGE(PG8_SB(1, 1), cB + kstep, voffB[1]);
    PG8_WAIT_V(6); PG8_BAR;
    for (;;) {
        const bool has_next = S.next(ui + 1, nxt);
        const char* nA = has_next ? D.A + D.abase(nxt) : cA; const char* nB = has_next ? D.B + D.bbase(nxt) : cB;
        for (int t = 0; t < nt; t += 2) {
            const bool last = (t == nt - 2);
            const char* a1 = cA + (size_t)(t + 1) * kstep;
            const char* a2 = last ? nA : cA + (size_t)(t + 2) * kstep; const char* b2 = last ? nB : cB + (size_t)(t + 2) * kstep;
            const char* a3 = a2 + kstep; const char* b3 = b2 + kstep;
            if constexpr (Desc::GATHER) {
                if (last && has_next) {
#pragma unroll
                    for (int i = 0; i < 2; ++i)
#pragma unroll
                        for (int h = 0; h < 2; ++h) nvA[h][i] = D.agather(nxt, sR[i] + HALF * h) + (unsigned)sC[i] * 2u;
                }
            }
            unsigned va2[2][2];
#pragma unroll
            for (int i = 0; i < 2; ++i)
#pragma unroll
                for (int h = 0; h < 2; ++h) va2[h][i] = (Desc::GATHER && last) ? nvA[h][i] : voffA[h][i];
            PG8_LDB(B0, 0, 0); PG8_SCHED; PG8_LDA(At, 0, 0); PG8_STAGE(PG8_SA(1, 1), a1, voffA[1]);
            PG8_WAIT_L(8); PG8_BAR; PG8_WAIT_L(0); PG8_MMA(0, 0, At, B0); PG8_BAR; PG8_SCHED;
            PG8_LDB(B1, 0, 1); PG8_STAGE(PG8_SB(0, 0), b2, voffB[0]);
            PG8_BAR; PG8_WAIT_L(0); PG8_MMA(0, 1, At, B1); PG8_BAR;
            PG8_LDA(At, 0, 1); PG8_STAGE(PG8_SA(0, 0), a2, va2[0]);
            PG8_BAR; PG8_WAIT_L(0); PG8_MMA(1, 0, At, B0); PG8_BAR; PG8_SCHED;
            PG8_STAGE(PG8_SB(0, 1), b2, voffB[1]);
            PG8_WAIT_V(6); PG8_BAR; PG8_MMA(1, 1, At, B1); PG8_BAR;
            PG8_LDB(B0, 1, 0); PG8_SCHED; PG8_LDA(At, 1, 0); PG8_STAGE(PG8_SA(0, 1), a2, va2[1]);
            PG8_WAIT_L(8); PG8_BAR; PG8_WAIT_L(0); PG8_MMA(0, 0, At, B0); PG8_BAR; PG8_SCHED;
            PG8_LDB(B1, 1, 1); PG8_STAGE(PG8_SB(1, 0), b3, voffB[0]);
            PG8_BAR; PG8_WAIT_L(0); PG8_MMA(0, 1, At, B1); PG8_BAR;
            PG8_LDA(At, 1, 1); PG8_STAGE(PG8_SA(1, 0), a3, va2[0]);
            PG8_BAR; PG8_WAIT_L(0); PG8_MMA(1, 0, At, B0); PG8_BAR; PG8_SCHED;
            PG8_STAGE(PG8_SB(1, 1), b3, voffB[1]);
            PG8_WAIT_V(6); PG8_BAR; PG8_MMA(1, 1, At, B1); PG8_BAR;
        }
        E(acc, cur, wr, wc, fr, fq);
        if (!has_next) break;
#pragma unroll
        for (int a = 0; a < 2; ++a)
#pragma unroll
            for (int b = 0; b < 2; ++b)
#pragma unroll
                for (int m = 0; m < 4; ++m)
#pragma unroll
                    for (int n = 0; n < 2; ++n) acc[a][b][m][n] = (f32x4){0.f, 0.f, 0.f, 0.f};
        cur = nxt; cA = nA; cB = nB; ++ui;
        if constexpr (Desc::GATHER) {
#pragma unroll
            for (int i = 0; i < 2; ++i)
#pragma unroll
                for (int h = 0; h < 2; ++h) voffA[h][i] = nvA[h][i];
        }
    }
    PG8_WAIT_V(0);
    if (wr == 0) PG8_BAR;
    PG8_BAR;
#undef PG8_SA
#undef PG8_SB
#undef PG8_STAGE
#undef PG8_LDA
#undef PG8_LDB
#undef PG8_MMA
#undef PG8_WAIT_V
#undef PG8_WAIT_L
#undef PG8_BAR
#undef PG8_SCHED
}
}
using pg8::Unit;

struct DescPlain {
    static constexpr bool GATHER = false;
    const char* A; const char* B; int K; int lda, ldb;
    __device__ __forceinline__ size_t abase(const Unit& u) const { return (size_t)u.pm * 256 * lda * 2; }
    __device__ __forceinline__ size_t bbase(const Unit& u) const { return (size_t)u.pn * 256 * ldb * 2; }
    __device__ __forceinline__ unsigned arow(int r) const { return (unsigned)(r * lda) * 2u; }
    __device__ __forceinline__ unsigned brow(int r) const { return (unsigned)(r * ldb) * 2u; }
    __device__ __forceinline__ unsigned agather(const Unit&, int) const { return 0u; }
};
struct DescMoe1 {
    static constexpr bool GATHER = true;
    const char* A; const char* B; int K; const int* idx;
    __device__ __forceinline__ size_t abase(const Unit&) const { return 0; }
    __device__ __forceinline__ size_t bbase(const Unit& u) const { return ((size_t)(u.pm >> 3) * 4096 + (size_t)u.pn * 256) * DM * 2; }
    __device__ __forceinline__ unsigned arow(int) const { return 0u; }
    __device__ __forceinline__ unsigned brow(int r) const { return (unsigned)(r * DM) * 2u; }
    __device__ __forceinline__ unsigned agather(const Unit& u, int r) const { return (unsigned)idx[u.pm * 256 + r] * (unsigned)(DM * 2); }
};
struct DescMoe2 {
    static constexpr bool GATHER = false;
    const char* A; const char* B; int K;
    __device__ __forceinline__ size_t abase(const Unit& u) const { return (size_t)u.pm * 256 * FF * 2; }
    __device__ __forceinline__ size_t bbase(const Unit& u) const { return ((size_t)(u.pm >> 3) * 2048 + (size_t)u.pn * 256) * FF * 2; }
    __device__ __forceinline__ unsigned arow(int r) const { return (unsigned)(r * FF) * 2u; }
    __device__ __forceinline__ unsigned brow(int r) const { return (unsigned)(r * FF) * 2u; }
    __device__ __forceinline__ unsigned agather(const Unit&, int) const { return 0u; }
};
struct DescF1 {
    static constexpr bool GATHER = false;
    const char* A; const char* B; int K;
    __device__ __forceinline__ size_t abase(const Unit& u) const { return (size_t)u.pm * 256 * 256 * 2; }
    __device__ __forceinline__ size_t bbase(const Unit& u) const { const int g = u.pn >> 6, pp = u.pn & 63; return ((size_t)(2 * pp) * DM + (size_t)g * 256) * 2; }
    __device__ __forceinline__ unsigned arow(int r) const { return (unsigned)(r * 256) * 2u; }
    __device__ __forceinline__ unsigned brow(int r) const { return (unsigned)((128 * (r & 127) + (r >> 7)) * DM) * 2u; }
    __device__ __forceinline__ unsigned agather(const Unit&, int) const { return 0u; }
};

__device__ __forceinline__ u32x4 pack8(const f32x4& a, const f32x4& b, float s) {
    u32x4 w; w.x = cvtpk(a[0] * s, a[1] * s); w.y = cvtpk(a[2] * s, a[3] * s); w.z = cvtpk(b[0] * s, b[1] * s); w.w = cvtpk(b[2] * s, b[3] * s); return w;
}
struct EpiInproj {
    static constexpr bool PERM = true;
    bf16_t *cq, *ckv, *kr, *qna, *kna, *vna; float* psq; const float* rope;
    __device__ __forceinline__ void operator()(const f32x4 (&acc)[2][2][4][2], const Unit& u, int wr, int wc, int fr, int fq) const {
        const int pn = u.pn;
#pragma unroll
        for (int ai = 0; ai < 2; ++ai)
#pragma unroll
            for (int m = 0; m < 4; ++m) {
                const int row = u.pm * 256 + ai * 128 + wr * 64 + m * 16 + fr;
                const bool lat = row >= NCTX;
#pragma unroll
                for (int bj = 0; bj < 2; ++bj) {
                    const f32x4 v0 = acc[ai][bj][m][0], v1 = acc[ai][bj][m][1];
                    const int cl = bj * 128 + wc * 32 + fq * 8;
                    if (pn <= 2) {
                        float ss = v0[0] * v0[0] + v0[1] * v0[1] + v0[2] * v0[2] + v0[3] * v0[3] + v1[0] * v1[0] + v1[1] * v1[1] + v1[2] * v1[2] + v1[3] * v1[3];
                        ss += __shfl_xor(ss, 16, 64); ss += __shfl_xor(ss, 32, 64);
                        if (fq == 0) psq[(size_t)row * 24 + pn * 8 + bj * 4 + wc] = ss;
                        if (pn < 2) { if (lat) *(u32x4*)(cq + (size_t)(row - NCTX) * 512 + pn * 256 + cl) = pack8(v0, v1, 1.f); }
                        else *(u32x4*)(ckv + (size_t)row * 256 + cl) = pack8(v0, v1, 1.f);
                    } else if (pn <= 6) {
                        const int h = 2 * (pn - 3) + bj, d = wc * 32 + fq * 8;
                        if (lat) *(u32x4*)(qna + ((size_t)h * NTOK + (row - NCTX)) * 128 + d) = pack8(v0, v1, NA_QS);
                    } else if (pn <= 10) {
                        const int h = 2 * (pn - 7) + bj, d = wc * 32 + fq * 8;
                        *(u32x4*)(kna + ((size_t)h * NKEY + row) * 128 + d) = pack8(v0, v1, 1.f);
                    } else if (pn <= 14) {
                        const int h = 2 * (pn - 11) + bj, d = wc * 32 + fq * 8;
                        *(u32x4*)(vna + ((size_t)h * NKEY + row) * 128 + d) = pack8(v0, v1, 1.f);
                    } else if (bj == 0 && wc < 2) {
                        f32x4 o0 = v0, o1 = v1;
                        if (lat) {
                            const int n = row - NCTX, pos = wc == 0 ? (n >> 6) : (n & 63);
                            const f32x4 cs0 = *(const f32x4*)(rope + (pos * 16 + fq * 4) * 2), cs1 = *(const f32x4*)(rope + (pos * 16 + fq * 4 + 2) * 2);
                            o0[0] = v0[0] * cs0[0] - v0[1] * cs0[1]; o0[1] = v0[1] * cs0[0] + v0[0] * cs0[1];
                            o0[2] = v0[2] * cs0[2] - v0[3] * cs0[3]; o0[3] = v0[3] * cs0[2] + v0[2] * cs0[3];
                            o1[0] = v1[0] * cs1[0] - v1[1] * cs1[1]; o1[1] = v1[1] * cs1[0] + v1[0] * cs1[1];
                            o1[2] = v1[2] * cs1[2] - v1[3] * cs1[3]; o1[3] = v1[3] * cs1[2] + v1[2] * cs1[3];
                        }
                        *(u32x4*)(kr + (size_t)row * 64 + wc * 32 + fq * 8) = pack8(o0, o1, 1.f);
                    }
                }
            }
    }
};
__device__ __forceinline__ float rstd_from_psq(const float* p, int cnt, float inv_n) {
    float s = 0.f;
    for (int i = 0; i < cnt; i += 4) { const f32x4 v = *(const f32x4*)(p + i); s += v[0] + v[1] + v[2] + v[3]; }
    return rsqrtf(s * inv_n + EPS);
}
struct EpiUq {
    static constexpr bool PERM = true;
    bf16_t* q; const float* psq; const float* rope;
    __device__ __forceinline__ void operator()(const f32x4 (&acc)[2][2][4][2], const Unit& u, int wr, int wc, int fr, int fq) const {
        const int pn = u.pn;
#pragma unroll
        for (int ai = 0; ai < 2; ++ai)
#pragma unroll
            for (int m = 0; m < 4; ++m) {
                const int row = u.pm * 256 + ai * 128 + wr * 64 + m * 16 + fr;
                const float rs = rstd_from_psq(psq + (size_t)(row + NCTX) * 24, 16, 1.f / 512.f);
#pragma unroll
                for (int bj = 0; bj < 2; ++bj) {
                    const f32x4 v0 = acc[ai][bj][m][0] * rs, v1 = acc[ai][bj][m][1] * rs;
                    if (pn < 4) {
                        const int h = 2 * pn + bj, d = wc * 32 + fq * 8;
                        *(u32x4*)(q + ((size_t)h * NTOK + row) * 192 + d) = pack8(v0, v1, MLA_QS);
                    } else {
                        const int h = 4 * (pn - 4) + 2 * bj + (wc >> 1), ax = wc & 1;
                        const int pos = ax == 0 ? (row >> 6) : (row & 63);
                        const f32x4 cs0 = *(const f32x4*)(rope + (pos * 16 + fq * 4) * 2), cs1 = *(const f32x4*)(rope + (pos * 16 + fq * 4 + 2) * 2);
                        f32x4 o0, o1;
                        o0[0] = v0[0] * cs0[0] - v0[1] * cs0[1]; o0[1] = v0[1] * cs0[0] + v0[0] * cs0[1];
                        o0[2] = v0[2] * cs0[2] - v0[3] * cs0[3]; o0[3] = v0[3] * cs0[2] + v0[2] * cs0[3];
                        o1[0] = v1[0] * cs1[0] - v1[1] * cs1[1]; o1[1] = v1[1] * cs1[0] + v1[0] * cs1[1];
                        o1[2] = v1[2] * cs1[2] - v1[3] * cs1[3]; o1[3] = v1[3] * cs1[2] + v1[2] * cs1[3];
                        *(u32x4*)(q + ((size_t)h * NTOK + row) * 192 + 128 + ax * 32 + fq * 8) = pack8(o0, o1, MLA_QS);
                    }
                }
            }
    }
};
struct EpiUkv {
    static constexpr bool PERM = true;
    bf16_t *kn, *v; const float* psq;
    __device__ __forceinline__ void operator()(const f32x4 (&acc)[2][2][4][2], const Unit& u, int wr, int wc, int fr, int fq) const {
        const int pn = u.pn;
#pragma unroll
        for (int ai = 0; ai < 2; ++ai)
#pragma unroll
            for (int m = 0; m < 4; ++m) {
                const int row = u.pm * 256 + ai * 128 + wr * 64 + m * 16 + fr;
                const float rs = rstd_from_psq(psq + (size_t)row * 24 + 16, 8, 1.f / 256.f);
#pragma unroll
                for (int bj = 0; bj < 2; ++bj) {
                    const int h = 2 * (pn & 3) + bj, d = wc * 32 + fq * 8;
                    bf16_t* dst = (pn < 4 ? kn : v) + ((size_t)h * NKEY + row) * 128 + d;
                    *(u32x4*)dst = pack8(acc[ai][bj][m][0], acc[ai][bj][m][1], rs);
                }
            }
    }
};
struct EpiResid {
    static constexpr bool PERM = false;
    float* out; const float* base; const float* gate;
    __device__ __forceinline__ void operator()(const f32x4 (&acc)[2][2][4][2], const Unit& u, int wr, int wc, int fr, int fq) const {
        const int row0 = u.pm * 256 + wr * 64 + fr, col0 = u.pn * 256 + wc * 32 + 4 * fq;
        f32x4 gv[2][2];
#pragma unroll
        for (int bj = 0; bj < 2; ++bj)
#pragma unroll
            for (int n = 0; n < 2; ++n) gv[bj][n] = *(const f32x4*)(gate + col0 + bj * 128 + n * 16);
#pragma unroll
        for (int ai = 0; ai < 2; ++ai)
#pragma unroll
            for (int m = 0; m < 4; ++m) { const size_t ro = (size_t)(row0 + ai * 128 + m * 16) * DM + col0;
#pragma unroll
                for (int bj = 0; bj < 2; ++bj)
#pragma unroll
                    for (int n = 0; n < 2; ++n) { const f32x4 b = *(const f32x4*)(base + ro + bj * 128 + n * 16);
                        *(f32x4*)(out + ro + bj * 128 + n * 16) = b + gv[bj][n] * acc[ai][bj][m][n]; } }
    }
};
struct EpiMoe1 {
    static constexpr bool PERM = true;
    bf16_t* act;
    __device__ __forceinline__ void operator()(const f32x4 (&acc)[2][2][4][2], const Unit& u, int wr, int wc, int fr, int fq) const {
#pragma unroll
        for (int ai = 0; ai < 2; ++ai)
#pragma unroll
            for (int m = 0; m < 4; ++m) {
                const int row = u.pm * 256 + ai * 128 + wr * 64 + m * 16 + fr;
                f32x4 o[2];
#pragma unroll
                for (int n = 0; n < 2; ++n)
#pragma unroll
                    for (int j = 0; j < 4; ++j) { const float g = acc[ai][0][m][n][j], up = acc[ai][1][m][n][j];
                        o[n][j] = g * up * __builtin_amdgcn_rcpf(1.f + __builtin_amdgcn_exp2f(-g * LOG2E)); }
                *(u32x4*)(act + (size_t)row * FF + u.pn * 128 + wc * 32 + fq * 8) = pack8(o[0], o[1], 1.f);
            }
    }
};
struct EpiMoe2 {
    static constexpr bool PERM = true;
    bf16_t* ye; const float* gate;
    __device__ __forceinline__ void operator()(const f32x4 (&acc)[2][2][4][2], const Unit& u, int wr, int wc, int fr, int fq) const {
#pragma unroll
        for (int ai = 0; ai < 2; ++ai)
#pragma unroll
            for (int m = 0; m < 4; ++m) {
                const int row = u.pm * 256 + ai * 128 + wr * 64 + m * 16 + fr;
                const float g = gate[row];
#pragma unroll
                for (int bj = 0; bj < 2; ++bj)
                    *(u32x4*)(ye + (size_t)row * DM + u.pn * 256 + bj * 128 + wc * 32 + fq * 8) = pack8(acc[ai][bj][m][0], acc[ai][bj][m][1], g);
            }
    }
};
struct EpiF1 {
    static constexpr bool PERM = true;
    bf16_t* g1;
    __device__ __forceinline__ void operator()(const f32x4 (&acc)[2][2][4][2], const Unit& u, int wr, int wc, int fr, int fq) const {
        const int g = u.pn >> 6, pp = u.pn & 63, ri = u.pm;
#pragma unroll
        for (int ai = 0; ai < 2; ++ai)
#pragma unroll
            for (int m = 0; m < 4; ++m) {
                const int mm = ai * 128 + wr * 64 + m * 16 + fr;
#pragma unroll
                for (int bj = 0; bj < 2; ++bj) { const int b = 2 * pp + bj;
                    *(u32x4*)(g1 + ((((size_t)(g * 256 + mm) * 128 + b) * 2 + ri) * 128) + wc * 32 + fq * 8) = pack8(acc[ai][bj][m][0], acc[ai][bj][m][1], 1.f); }
            }
    }
};
struct EpiF2A {
    static constexpr bool PERM = true;
    bf16_t* tp; const float* tw;
    __device__ __forceinline__ void operator()(const f32x4 (&acc)[2][2][4][2], const Unit& u, int wr, int wc, int fr, int fq) const {
#pragma unroll
        for (int m = 0; m < 4; ++m) {
            const int k1 = wr * 64 + m * 16 + fr, b0 = wc * 32 + fq * 8;
            const float* t = tw + ((size_t)k1 * 128 + b0) * 2;
            f32x4 cs[4];
#pragma unroll
            for (int j = 0; j < 4; ++j) cs[j] = *(const f32x4*)(t + 4 * j);
#pragma unroll
            for (int bj = 0; bj < 2; ++bj) {
                const int gm = 2 * u.pn + bj;
                f32x4 r0, r1, i0, i1;
#pragma unroll
                for (int j = 0; j < 4; ++j) {
                    const float c_a = cs[j >> 1][(j & 1) * 2], s_a = cs[j >> 1][(j & 1) * 2 + 1];
                    const float c_b = cs[2 + (j >> 1)][(j & 1) * 2], s_b = cs[2 + (j >> 1)][(j & 1) * 2 + 1];
                    const float tr0 = acc[0][bj][m][0][j], ti0 = acc[1][bj][m][0][j], tr1 = acc[0][bj][m][1][j], ti1 = acc[1][bj][m][1][j];
                    r0[j] = c_a * tr0 + s_a * ti0; i0[j] = c_a * ti0 - s_a * tr0;
                    r1[j] = c_b * tr1 + s_b * ti1; i1[j] = c_b * ti1 - s_b * tr1;
                }
                bf16_t* dst = tp + (((size_t)k1 * 2048 + gm) * 2) * 128 + b0;
                *(u32x4*)dst = pack8(r0, r1, 1.f); *(u32x4*)(dst + 128) = pack8(i0, i1, 1.f);
            }
        }
    }
};
struct EpiF2B {
    static constexpr bool PERM = true;
    bf16_t* f;
    __device__ __forceinline__ void operator()(const f32x4 (&acc)[2][2][4][2], const Unit& u, int wr, int wc, int fr, int fq) const {
        const int k1 = u.pn >> 3;
#pragma unroll
        for (int m = 0; m < 4; ++m) {
            const int k2 = wr * 64 + m * 16 + fr;
#pragma unroll
            for (int bj = 0; bj < 2; ++bj)
                *(u32x4*)(f + (size_t)(k1 + 128 * k2) * DM + (u.pn & 7) * 256 + bj * 128 + wc * 32 + fq * 8) = pack8(acc[0][bj][m][0], acc[0][bj][m][1], 1.f);
        }
    }
};

namespace att {
constexpr int QBLK = 32, KVBLK = 64;
constexpr float THR2 = 11.0f;
#define SBAR() __builtin_amdgcn_sched_barrier(0)
__device__ __forceinline__ int crow(int r, int hi) { return (r & 3) + 8 * (r >> 2) + 4 * hi; }
template <int DQK> __device__ __forceinline__ int kswz(int row, int colB) { return row * (DQK * 2 + 16) + colB; }
__device__ __forceinline__ void partialSM(f32x16& p0, f32x16& p1, float& m_reg, float& mn, float& alpha) {
    float pmax = p0[0];
#pragma unroll
    for (int r = 1; r < 16; ++r) pmax = fmaxf(pmax, p0[r]);
#pragma unroll
    for (int r = 0; r < 16; ++r) pmax = fmaxf(pmax, p1[r]);
    { auto rr = __builtin_amdgcn_permlane32_swap(__float_as_uint(pmax), __float_as_uint(pmax), false, false);
      pmax = fmaxf(__uint_as_float(rr[0]), __uint_as_float(rr[1])); }
    if (__builtin_expect(__all(pmax - m_reg <= THR2), 1)) { mn = m_reg; alpha = 1.f; }
    else { mn = fmaxf(m_reg, pmax); alpha = __builtin_amdgcn_exp2f(m_reg - mn); m_reg = mn; }
#pragma unroll
    for (int r = 0; r < 16; ++r) p0[r] = p0[r] - mn;
#pragma unroll
    for (int r = 0; r < 16; ++r) p1[r] = p1[r] - mn;
#pragma unroll
    for (int r = 0; r < 16; ++r) p0[r] = __builtin_amdgcn_exp2f(p0[r]);
}
__device__ __forceinline__ void finishSM(f32x16& p0, f32x16& p1, float alpha, float& l_reg, bf16x8& pa0, bf16x8& pa1, bf16x8& pa2, bf16x8& pa3) {
#pragma unroll
    for (int r = 0; r < 16; ++r) p1[r] = __builtin_amdgcn_exp2f(p1[r]);
    float ps = 0;
#pragma unroll
    for (int r = 0; r < 16; ++r) ps += p0[r];
#pragma unroll
    for (int r = 0; r < 16; ++r) ps += p1[r];
    { auto rr = __builtin_amdgcn_permlane32_swap(__float_as_uint(ps), __float_as_uint(ps), false, false);
      ps = __uint_as_float(rr[0]) + __uint_as_float(rr[1]); }
    l_reg = l_reg * alpha + ps;
#define PK4(P, BASE, OUT) do { unsigned a0 = cvtpk(P[BASE + 0], P[BASE + 1]), a1 = cvtpk(P[BASE + 2], P[BASE + 3]);   \
    unsigned b0 = cvtpk(P[BASE + 4], P[BASE + 5]), b1 = cvtpk(P[BASE + 6], P[BASE + 7]);                              \
    auto r0 = __builtin_amdgcn_permlane32_swap(a0, b0, false, false); auto r1 = __builtin_amdgcn_permlane32_swap(a1, b1, false, false); \
    u32x4 w = {r0[0], r1[0], r0[1], r1[1]}; OUT = *reinterpret_cast<bf16x8*>(&w); } while (0)
    PK4(p0, 0, pa0); PK4(p0, 8, pa1); PK4(p1, 0, pa2); PK4(p1, 8, pa3);
#undef PK4
}
template <int DQK>
__device__ __forceinline__ void qkt(f32x16& p0, f32x16& p1, const char* Ks, const bf16x8* qr, const char* qx, int r32, int hi) {
    p0 = f32x16{}; p1 = f32x16{};
    const char* kb_ = Ks + r32 * (DQK * 2 + 16) + hi * 16;
#pragma unroll
    for (int d0 = 0; d0 < DQK / 16; ++d0) {
        bf16x8 b0 = *reinterpret_cast<const bf16x8*>(kb_ + d0 * 32);
        bf16x8 b1 = *reinterpret_cast<const bf16x8*>(kb_ + 32 * (DQK * 2 + 16) + d0 * 32);
        const bf16x8 q = d0 < 8 ? qr[d0 < 8 ? d0 : 0] : *reinterpret_cast<const bf16x8*>(qx + (d0 - 8) * 1024);
        p0 = __builtin_amdgcn_mfma_f32_32x32x16_bf16(b0, q, p0, 0, 0, 0);
        p1 = __builtin_amdgcn_mfma_f32_32x32x16_bf16(b1, q, p1, 0, 0, 0); }
}
__device__ __forceinline__ int v_st(int k, int c) { const int kk = (k & ~0xC) | ((k & 4) << 1) | ((k & 8) >> 1); return ((kk >> 3) * 4 + (c >> 5)) * 512 + ((kk & 7) * 32 + (c & 31)) * 2; }
__device__ __forceinline__ int v_rd_base(int lane) { return ((lane & 3) << 3) | (((lane >> 2) & 3) << 6) | (((lane >> 4) & 1) << 5) | (((lane >> 5) & 1) << 8); }
constexpr int v_rd_off(int d0, int ks, int half) { return d0 * 512 + ks * 4096 + half * 2048; }
template <int OFF> __device__ __forceinline__ s16x4 tr_read(int vb) {
    s16x4 r; asm volatile("ds_read_b64_tr_b16 %0, %1 offset:%2" : "=&v"(r) : "v"(vb), "i"(OFF) : "memory"); return r;
}
template <int D0> __device__ __forceinline__ void pv_one(f32x16& od, int vb, bf16x8 pa0, bf16x8 pa1, bf16x8 pa2, bf16x8 pa3) {
    const s16x4 l0 = tr_read<v_rd_off(D0, 0, 0)>(vb), h0 = tr_read<v_rd_off(D0, 0, 1)>(vb), l1 = tr_read<v_rd_off(D0, 1, 0)>(vb), h1 = tr_read<v_rd_off(D0, 1, 1)>(vb);
    const s16x4 l2 = tr_read<v_rd_off(D0, 2, 0)>(vb), h2 = tr_read<v_rd_off(D0, 2, 1)>(vb), l3 = tr_read<v_rd_off(D0, 3, 0)>(vb), h3 = tr_read<v_rd_off(D0, 3, 1)>(vb);
    asm volatile("s_waitcnt lgkmcnt(0)" ::: "memory"); SBAR();
#define PK(L, H) (bf16x8){L[0], L[1], L[2], L[3], H[0], H[1], H[2], H[3]}
    od = __builtin_amdgcn_mfma_f32_32x32x16_bf16(pa0, PK(l0, h0), od, 0, 0, 0);
    od = __builtin_amdgcn_mfma_f32_32x32x16_bf16(pa1, PK(l1, h1), od, 0, 0, 0);
    od = __builtin_amdgcn_mfma_f32_32x32x16_bf16(pa2, PK(l2, h2), od, 0, 0, 0);
    od = __builtin_amdgcn_mfma_f32_32x32x16_bf16(pa3, PK(l3, h3), od, 0, 0, 0);
#undef PK
}
__device__ __forceinline__ void pv_d0(f32x16* o, int vb, bf16x8 pa0, bf16x8 pa1, bf16x8 pa2, bf16x8 pa3) {
    pv_one<0>(o[0], vb, pa0, pa1, pa2, pa3); pv_one<1>(o[1], vb, pa0, pa1, pa2, pa3); pv_one<2>(o[2], vb, pa0, pa1, pa2, pa3); pv_one<3>(o[3], vb, pa0, pa1, pa2, pa3);
}
template <int DQK> struct Lds {
    static constexpr int SHM_V = KVBLK * 128 * 2, SHM_K = KVBLK * (DQK * 2 + 16);
    static constexpr int OFF_K = 2 * SHM_V, OFF_WS = OFF_K + 2 * SHM_K, OFF_BT = OFF_WS + 8 * 64 * 4, OFF_QX = OFF_BT + 640 * 4, TOTAL = OFF_QX + 8 * 4096;
};
struct NaCtx { int u0; int rq; int rs; int cq; int cs; const LAS float* bt; };

template <int DQK, bool NA>
__device__ __forceinline__ void attn_body(const bf16_t* __restrict__ Qb, const bf16_t* __restrict__ Kh, const bf16_t* __restrict__ Krope, const bf16_t* __restrict__ Vh,
                                          bf16_t* __restrict__ Ob, int NT, int u0, int qrow0, const float* __restrict__ bias_h, char* lds) {
    using L = Lds<DQK>;
    constexpr int SHM_V = L::SHM_V, SHM_K = L::SHM_K;
    const int tid = ltid(), wid = tid >> 6, lane = tid & 63, r32 = lane & 31, hi = lane >> 5;
    char* V_lds = lds; char* K_lds = lds + L::OFF_K;
    float* ws = (float*)(lds + L::OFF_WS) + wid * 64; float* li_l = ws; float* al_l = ws + 32;
    float* bt = (float*)(lds + L::OFF_BT);
    __syncthreads();
    if constexpr (NA) { if (tid < 15 * 31) bt[48 + (tid / 31) * 32 + (tid % 31)] = bias_h[tid] * LOG2E; }
    float m_reg = -1e30f, l_reg = 0; f32x16 o[4] = {}; bf16x8 qr[8];
    const bf16_t* Qw = Qb + (size_t)(wid * QBLK + r32) * DQK + hi * 8;
    char* qx = lds + L::OFF_QX + wid * 4096 + lane * 16;
#pragma unroll
    for (int d0 = 0; d0 < 8; ++d0) qr[d0] = *reinterpret_cast<const bf16x8*>(Qw + d0 * 16);
    if constexpr (DQK == 192) {
#pragma unroll
        for (int d0 = 8; d0 < 12; ++d0) *reinterpret_cast<bf16x8*>(qx + (d0 - 8) * 1024) = *reinterpret_cast<const bf16x8*>(Qw + d0 * 16);
    }
    const int sr = tid >> 4, sc = (tid & 15) * 8, vst0 = v_st(sr, sc), vst1 = v_st(32 + sr, sc);
    const int rr_ = tid >> 3, rc_ = (tid & 7) * 8;
    const unsigned offKV = (unsigned)(sr * 128 + sc) * 2u, offR = (unsigned)(rr_ * 64 + rc_) * 2u;
    const int vb0 = (int)(uintptr_t)V_lds + v_rd_base(lane);
    const int rq = NA ? (wid >> 1) : 0;
    const int cq = 32 * (wid & 1) + r32;
    const int cs = cq < 8 ? 0 : (cq > 56 ? 48 : cq - 8);
    constexpr int SD = (DQK == 192) ? 1 : 2, SE = 0, SO = SD - 1;
    struct Slot { bf16x8 vs0, vs1, ks0, ks1, kr; } s_[SD];
    auto keyof = [&](int t) -> int { if constexpr (!NA) return t * KVBLK; else { if (t < 4) return t * KVBLK; int kr = u0 + t - 4; kr = kr > 255 ? 255 : kr; return NCTX + kr * KVBLK; } };
#define SLOAD(i, t) do { const size_t k0_ = (size_t)__builtin_amdgcn_readfirstlane(keyof(t)); const char* vp_ = (const char*)Vh + k0_ * 256; const char* kp_ = (const char*)Kh + k0_ * 256; \
    s_[i].vs0 = *(const bf16x8*)(vp_ + offKV); s_[i].vs1 = *(const bf16x8*)(vp_ + offKV + 8192u); \
    s_[i].ks0 = *(const bf16x8*)(kp_ + offKV); s_[i].ks1 = *(const bf16x8*)(kp_ + offKV + 8192u); \
    if constexpr (DQK == 192) s_[i].kr = *(const bf16x8*)((const char*)Krope + k0_ * 128 + offR); } while (0)
#define SWRITE(b, i) do { *(bf16x8*)(V_lds + (b) * SHM_V + vst0) = s_[i].vs0; *(bf16x8*)(V_lds + (b) * SHM_V + vst1) = s_[i].vs1; \
    *(bf16x8*)(K_lds + (b) * SHM_K + kswz<DQK>(sr, sc * 2)) = s_[i].ks0; *(bf16x8*)(K_lds + (b) * SHM_K + kswz<DQK>(32 + sr, sc * 2)) = s_[i].ks1; \
    if constexpr (DQK == 192) *(bf16x8*)(K_lds + (b) * SHM_K + kswz<DQK>(rr_, 256 + rc_ * 2)) = s_[i].kr; } while (0)
#define SWAIT() do { if constexpr (SD == 1) asm volatile("s_waitcnt vmcnt(0)" ::: "memory"); else asm volatile("s_waitcnt vmcnt(4)" ::: "memory"); } while (0)
#define RESC(a) do { if (__any((a) < 1.f)) { if (hi == 0) al_l[r32] = (a); asm volatile("s_waitcnt lgkmcnt(0)" ::: "memory"); \
    _Pragma("unroll") for (int d = 0; d < 4; ++d) _Pragma("unroll") for (int r = 0; r < 16; ++r) o[d][r] *= al_l[crow(r, hi)]; } } while (0)
#define NAHOOK(P0, P1, t) do { if constexpr (NA) { if ((t) >= 4) { const int kr_ = u0 + (t) - 4; const int rabs = qrow0 + rq; \
        const int rs_ = rabs < 4 ? 0 : (rabs > 252 ? 248 : rabs - 4); const bool tv = (kr_ >= rs_) && (kr_ < rs_ + 8) && (kr_ <= 255); \
        int ro = kr_ - rabs + 7; ro = ro < 0 ? 0 : (ro > 14 ? 14 : ro); \
        const float* bp = bt + 48 + ro * 32 + 15 - cq + 4 * hi; \
        _Pragma("unroll") for (int r = 0; r < 16; ++r) { const int ckc = (r & 3) + 8 * (r >> 2); const int ck0 = ckc + 4 * hi; \
            const bool v0_ = tv && ((unsigned)(ck0 - cs) < 16u), v1_ = tv && ((unsigned)(ck0 + 32 - cs) < 16u); \
            P0[r] = v0_ ? P0[r] + bp[ckc] : -1e30f; P1[r] = v1_ ? P1[r] + bp[ckc + 32] : -1e30f; } } } } while (0)
    f32x16 pA0, pA1, pB0, pB1; float mnA, mnB, alA, alB; bf16x8 pa0, pa1, pa2, pa3;
    SLOAD(SE, 0); asm volatile("s_waitcnt vmcnt(0)" ::: "memory"); SWRITE(0, SE); __syncthreads();
    qkt<DQK>(pA0, pA1, K_lds, qr, qx, r32, hi); partialSM(pA0, pA1, m_reg, mnA, alA);
    SLOAD(SO, 1); if constexpr (SD == 2) { if (2 < NT) SLOAD(SE, 2); }
    SWAIT(); SWRITE(1, SO); __syncthreads();
    for (int j = 1; j + 1 < NT; j += 2) {
        SBAR(); qkt<DQK>(pB0, pB1, K_lds + SHM_K, qr, qx, r32, hi);
        finishSM(pA0, pA1, alA, l_reg, pa0, pa1, pa2, pa3); SBAR();
        SLOAD(SO, j + SD); SBAR();
        pv_d0(o, vb0, pa0, pa1, pa2, pa3); NAHOOK(pB0, pB1, j); partialSM(pB0, pB1, m_reg, mnB, alB);
        __syncthreads(); SWAIT(); SWRITE(0, SE);
        RESC(alB); __syncthreads();
        SBAR(); qkt<DQK>(pA0, pA1, K_lds, qr, qx, r32, hi);
        finishSM(pB0, pB1, alB, l_reg, pa0, pa1, pa2, pa3); SBAR();
        if (SD == 1 || j + 3 < NT) SLOAD(SE, j + 1 + SD); SBAR();
        pv_d0(o, vb0 + SHM_V, pa0, pa1, pa2, pa3); NAHOOK(pA0, pA1, j + 1); partialSM(pA0, pA1, m_reg, mnA, alA);
        __syncthreads(); SWAIT(); SWRITE(1, SO);
        RESC(alA); __syncthreads();
    }
    SBAR(); qkt<DQK>(pB0, pB1, K_lds + SHM_K, qr, qx, r32, hi);
    finishSM(pA0, pA1, alA, l_reg, pa0, pa1, pa2, pa3); SBAR();
    pv_d0(o, vb0, pa0, pa1, pa2, pa3); NAHOOK(pB0, pB1, NT - 1); partialSM(pB0, pB1, m_reg, mnB, alB);
    __syncthreads(); RESC(alB);
    finishSM(pB0, pB1, alB, l_reg, pa0, pa1, pa2, pa3); SBAR();
    pv_d0(o, vb0 + SHM_V, pa0, pa1, pa2, pa3);
    if (hi == 0) li_l[r32] = l_reg; asm volatile("s_waitcnt lgkmcnt(0)" ::: "memory");
    float rli[16];
#pragma unroll
    for (int r = 0; r < 16; ++r) rli[r] = __builtin_amdgcn_rcpf(li_l[crow(r, hi)]);
    bf16_t* Ow = Ob + (size_t)(wid * QBLK) * DM;
#pragma unroll
    for (int r = 0; r < 16; ++r) { const int orow = crow(r, hi);
#pragma unroll
        for (int d0 = 0; d0 < 4; ++d0) Ow[(size_t)orow * DM + d0 * 32 + r32] = f2bf(o[d0][r] * rli[r]); }
#undef SLOAD
#undef SWRITE
#undef SWAIT
#undef RESC
#undef NAHOOK
}
}

#define WSP(T, off) ((T*)(p.ws + (off)))
constexpr float TWO_PI = 6.283185307179586f;

constexpr int P0_ADA = 112, P0_TAB = 72;
constexpr int P0_SLOW_WIN = 64 * 32, P0_SLOW_WUQ = 24 * 8, P0_SLOW_WUKV = 32 * 4;
constexpr int P0_SLOW = P0_SLOW_WIN + P0_SLOW_WUQ + P0_SLOW_WUKV;
constexpr int P0_FAST_SQ = 256;
constexpr int P0_FAST_GU = 2 * NE * 32 * 16, P0_FAST_D = 2 * NE * 16 * 16;
constexpr int P0_FAST = 2 * P0_FAST_SQ + P0_FAST_GU + P0_FAST_D;
constexpr int P0_UNITS = P0_ADA + P0_TAB + P0_SLOW + P0_FAST;

__device__ __forceinline__ int rope_src(int jj) { const int pp = jj >> 1, wh = jj & 1; return (pp < 16 ? 0 : 32) + (pp & 15) + 16 * wh; }

__device__ __forceinline__ void p0_slow_tile(const float* src, int lds_, const float* scale, bf16_t* dst, int K, int n0, int k0, int tid) {
    const int kg = tid >> 6, k = k0 + kg * 8;
    float v[8];
#pragma unroll
    for (int i = 0; i < 8; ++i) v[i] = src ? src[(size_t)(k + i) * lds_] * (scale ? scale[k + i] : 1.f) : 0.f;
    u32x4 w; w.x = cvtpk(v[0], v[1]); w.y = cvtpk(v[2], v[3]); w.z = cvtpk(v[4], v[5]); w.w = cvtpk(v[6], v[7]);
    *(u32x4*)(dst + (size_t)(n0 + (tid & 63)) * K + k) = w;
}
__device__ __forceinline__ void p0_fast_tile(const float* src  , int lds_, bf16_t* dst  , int K, int tid) {
    const int n4 = tid & 31, kg = tid >> 5;
    f32x4 v[8];
#pragma unroll
    for (int i = 0; i < 8; ++i) v[i] = *(const f32x4*)(src + (size_t)(kg * 8 + i) * lds_ + n4 * 4);
#pragma unroll
    for (int j = 0; j < 4; ++j) {
        u32x4 w; w.x = cvtpk(v[0][j], v[1][j]); w.y = cvtpk(v[2][j], v[3][j]); w.z = cvtpk(v[4][j], v[5][j]); w.w = cvtpk(v[6][j], v[7][j]);
        *(u32x4*)(dst + (size_t)(n4 * 4 + j) * K + kg * 8) = w;
    }
}

__device__ __forceinline__ void phase_prep(const Params& p, char* smem) {
    const int tid = ltid(), wid = tid >> 6, lane = tid & 63;
    float* sl = (float*)smem;
    for (int u = blockIdx.x; u < P0_UNITS; u += gridDim.x) {
        if (u < P0_ADA) {
            const bool isctx = u >= 96; const int layer = (u >= 48 && u < 96) ? 1 : 0; const int j0 = isctx ? (u - 96) * 256 : (u % 48) * 256;
            const float* cv = isctx ? p.c_ctx : p.c; const float* W = p.ada_w + (size_t)layer * DM * 12288;
            __syncthreads();
            for (int k = tid; k < DM; k += NTHR) { const float v = cv[k]; sl[k] = v / (1.f + expf(-v)); }
            __syncthreads();
            f32x4 acc = {0.f, 0.f, 0.f, 0.f};
            const float* wp = W + (size_t)(wid * 256) * 12288 + j0 + lane * 4;
#pragma unroll 8
            for (int k = 0; k < 256; ++k) { const f32x4 w = *(const f32x4*)(wp + (size_t)k * 12288); const float s = sl[wid * 256 + k]; acc += w * s; }
            float* red = sl + 2048;
            *(f32x4*)(red + wid * 256 + lane * 4) = acc;
            __syncthreads();
            if (tid < 256) { float s = 0.f;
#pragma unroll
                for (int w = 0; w < 8; ++w) s += red[w * 256 + tid];
                s += p.ada_b[(size_t)layer * 12288 + j0 + tid];
                float* dst = isctx ? WSP(float, OFF_ADA) + 2 * 12288 : WSP(float, OFF_ADA) + layer * 12288;
                dst[j0 + tid] = s; }
        } else if (u < P0_ADA + P0_TAB) {
            const int base = (u - P0_ADA) * 4096;
            for (int e = base + tid; e < base + 4096; e += NTHR) {
                if (e < 4096) { const int pos = e >> 4, i = e & 15; const float inv = powf(10000.f, -(float)i / 16.f); const float a = (float)pos * inv;
                    float* d = WSP(float, OFF_ROPE) + e * 2; d[0] = cosf(a); d[1] = sinf(a); }
                else if (e < 4096 + 16384) { const int q = e - 4096, k1 = q >> 7, b = q & 127; float s, c; sincospif((float)(k1 * b) / 8192.f, &s, &c);
                    float* d = WSP(float, OFF_TW) + q * 2; d[0] = c; d[1] = s; }
                else if (e < 4096 + 16384 + 131072) { const int q = e - 20480, row = q >> 8, cc = q & 255, ri = row >> 8, m = row & 255; float s, c; sincospif((float)((m * cc) & 255) / 128.f, &s, &c);
                    WSP(bf16_t, OFF_DFT1)[q] = f2bf(ri == 0 ? c * 0.0625f : -s * 0.0625f); }
                else if (e < 4096 + 16384 + 131072 + 65536) { const int q = e - 151552, row = q >> 8, col = q & 255, rip = row >> 7, k1 = row & 127, ri = col >> 7, a = col & 127;
                    float s, c; sincospif((float)((k1 * a) & 127) / 64.f, &s, &c); const float sc_ = 0.08838834764831845f; c *= sc_; s *= sc_;
                    const float v = (rip == ri) ? c : (rip == 0 ? s : -s);
                    WSP(bf16_t, OFF_WA)[q] = f2bf(v); }
                else if (e < 4096 + 16384 + 131072 + 131072) { const int q = e - 217088, row = q >> 8, col = q & 255, ri = col >> 7, b = col & 127;
                    float v = 0.f; if (row < 128) { float s, c; sincospif((float)((row * b) & 127) / 64.f, &s, &c); v = (ri == 0 ? c : s) * 0.08838834764831845f; }
                    WSP(bf16_t, OFF_WB)[q] = f2bf(v); }
            }
        } else if (u < P0_ADA + P0_TAB + P0_SLOW) {
            int s = u - P0_ADA - P0_TAB;
            if (s < P0_SLOW_WIN) {
                const int n0 = (s >> 5) * 64, k0 = (s & 31) * 64, n = n0 + (tid & 63);
                int col;
                if (n < 768) col = n; else if (n < 1792) col = 832 + (n - 768); else if (n < 2816) col = 1856 + (n - 1792); else if (n < 3840) col = 2880 + (n - 2816);
                else if (n < 3904) col = 768 + rope_src(n - 3840); else col = -1;
                p0_slow_tile(col >= 0 ? p.w_in + col : nullptr, INW, nullptr, WSP(bf16_t, OFF_WIN), DM, n0, k0, tid);
            } else if (s < P0_SLOW_WIN + P0_SLOW_WUQ) {
                s -= P0_SLOW_WIN; const int n0 = (s >> 3) * 64, k0 = (s & 7) * 64, n = n0 + (tid & 63);
                int col; if (n < 1024) col = (n >> 7) * 192 + (n & 127); else { const int j = n - 1024; col = (j >> 6) * 192 + 128 + rope_src(j & 63); }
                p0_slow_tile(p.w_uq + col, 1536, p.g_qn, WSP(bf16_t, OFF_WUQ), 512, n0, k0, tid);
            } else {
                s -= P0_SLOW_WIN + P0_SLOW_WUQ; const int n0 = (s >> 2) * 64, k0 = (s & 3) * 64, n = n0 + (tid & 63);
                const int col = n < 1024 ? (n >> 7) * 256 + (n & 127) : ((n - 1024) >> 7) * 256 + 128 + (n & 127);
                p0_slow_tile(p.w_ukv + col, 2048, p.g_kvn, WSP(bf16_t, OFF_WUKV), 256, n0, k0, tid);
            }
        } else {
            int s = u - P0_ADA - P0_TAB - P0_SLOW;
            if (s < 2 * P0_FAST_SQ) {
                const float* W = s < P0_FAST_SQ ? p.w_out_attn : p.w_out_fourier; bf16_t* dst = WSP(bf16_t, s < P0_FAST_SQ ? OFF_WOUT : OFF_WFOUT);
                s &= 255; const int n0 = (s >> 4) * 128, k0 = (s & 15) * 128;
                p0_fast_tile(W + (size_t)k0 * DM + n0, DM, dst + (size_t)n0 * DM + k0, DM, tid);
            } else if (s < 2 * P0_FAST_SQ + P0_FAST_GU) {
                s -= 2 * P0_FAST_SQ; const int le = s >> 9, t = s & 511, nt_ = t >> 4, k0 = (t & 15) * 128;
                const int pn = nt_ >> 1, bj = nt_ & 1;
                const float* W = (bj ? p.w_up : p.w_gate) + (size_t)le * DM * FF;
                p0_fast_tile(W + (size_t)k0 * FF + pn * 128, FF, WSP(bf16_t, OFF_WGU) + ((size_t)le * 4096 + nt_ * 128) * DM + k0, DM, tid);
            } else {
                s -= 2 * P0_FAST_SQ + P0_FAST_GU; const int le = s >> 8, t = s & 255, n0 = (t >> 4) * 128, k0 = (t & 15) * 128;
                const float* W = p.w_down + (size_t)le * FF * DM;
                p0_fast_tile(W + (size_t)k0 * DM + n0, DM, WSP(bf16_t, OFF_WD) + ((size_t)le * 2048 + n0) * FF + k0, FF, tid);
            }
        }
    }
}

__device__ __forceinline__ void modulate_row(const float* __restrict__ src, const float* __restrict__ g, const float* __restrict__ sh, const float* __restrict__ sc,
                                             bf16_t* __restrict__ dst, int lane) {
    f32x4 v[8]; float ss = 0.f;
#pragma unroll
    for (int j = 0; j < 8; ++j) { v[j] = *(const f32x4*)(src + j * 256 + lane * 4); ss += v[j][0] * v[j][0] + v[j][1] * v[j][1] + v[j][2] * v[j][2] + v[j][3] * v[j][3]; }
    ss = wave_sum(ss); const float rs = rsqrtf(ss * (1.f / DM) + EPS);
#pragma unroll
    for (int j = 0; j < 8; ++j) { const int c = j * 256 + lane * 4; const f32x4 gv = *(const f32x4*)(g + c), sv = *(const f32x4*)(sc + c), hv = *(const f32x4*)(sh + c);
        const f32x4 o = v[j] * rs * gv * (sv + 1.f) + hv;
        u32x2 w; w.x = cvtpk(o[0], o[1]); w.y = cvtpk(o[2], o[3]); *(u32x2*)(dst + c) = w; }
}
__device__ __forceinline__ void phase_mod0(const Params& p) {
    const int tid = ltid(), wid = tid >> 6, lane = tid & 63;
    const float* ada = WSP(float, OFF_ADA); const float* adac = ada + 2 * 12288;
    for (int row = blockIdx.x * 8 + wid; row < NKEY; row += gridDim.x * 8) {
        if (row < NCTX) modulate_row(p.ctx + (size_t)row * DM, p.g_mix, adac, adac + DM, WSP(bf16_t, OFF_H) + (size_t)row * DM, lane);
        else modulate_row(p.x + (size_t)(row - NCTX) * DM, p.g_mix, ada, ada + DM, WSP(bf16_t, OFF_H) + (size_t)row * DM, lane);
    }
}

__device__ __forceinline__ void phase_router(const Params& p, int layer, const float* __restrict__ xin, bf16_t* __restrict__ h2, char* smem) {
    const int tid = ltid(), wid = tid >> 6, lane = tid & 63;
    float* wr = (float*)smem;
    const float* W = p.w_router + (size_t)layer * DM * NE;
    __syncthreads();
    for (int i = tid; i < DM * NE; i += NTHR) { const int k = i >> 4, e = i & 15; wr[e * DM + k] = W[i]; }
    __syncthreads();
    const float* ada = WSP(float, OFF_ADA) + layer * 12288; const float* g = p.g_ffn + layer * DM; const float* sh = ada + 3 * DM; const float* sc = ada + 4 * DM;
    float* aff = WSP(float, OFF_AFF);
    for (int row = blockIdx.x * 8 + wid; row < NTOK; row += gridDim.x * 8) {
        const float* src = xin + (size_t)row * DM;
        f32x4 v[8]; float ss = 0.f;
#pragma unroll
        for (int j = 0; j < 8; ++j) { v[j] = *(const f32x4*)(src + j * 256 + lane * 4); ss += v[j][0] * v[j][0] + v[j][1] * v[j][1] + v[j][2] * v[j][2] + v[j][3] * v[j][3]; }
        ss = wave_sum(ss); const float rs = rsqrtf(ss * (1.f / DM) + EPS);
        float lg[16];
#pragma unroll
        for (int e = 0; e < 16; ++e) lg[e] = 0.f;
#pragma unroll
        for (int j = 0; j < 8; ++j) { const int c = j * 256 + lane * 4; const f32x4 gv = *(const f32x4*)(g + c), sv = *(const f32x4*)(sc + c), hv = *(const f32x4*)(sh + c);
            const f32x4 o = v[j] * rs * gv * (sv + 1.f) + hv;
            u32x2 w; w.x = cvtpk(o[0], o[1]); w.y = cvtpk(o[2], o[3]); *(u32x2*)(h2 + (size_t)row * DM + c) = w;
#pragma unroll
            for (int e = 0; e < 16; ++e) { const f32x4 wv = *(const f32x4*)(wr + e * DM + c); lg[e] += o[0] * wv[0] + o[1] * wv[1] + o[2] * wv[2] + o[3] * wv[3]; } }
        float mx = -1e30f;
#pragma unroll
        for (int e = 0; e < 16; ++e) { lg[e] = wave_sum(lg[e]); mx = fmaxf(mx, lg[e]); }
        float sum = 0.f;
#pragma unroll
        for (int e = 0; e < 16; ++e) { lg[e] = expf(lg[e] - mx); sum += lg[e]; }
        const float inv = 1.f / sum;
        float mine = 0.f;
#pragma unroll
        for (int e = 0; e < 16; ++e) mine = (lane == e) ? lg[e] * inv : mine;
        if (lane < 16) aff[(size_t)lane * NTOK + row] = mine;
    }
}

__device__ __forceinline__ void phase_topk(const Params& p, char* smem) {
    const int tid = ltid(), wid = tid >> 6, lane = tid & 63;
    unsigned* vals = (unsigned*)smem;
    unsigned* hist = vals + NTOK;
    unsigned* sh = hist + 256;
    for (int e = blockIdx.x; e < NE; e += gridDim.x) {
        const float* aff = WSP(float, OFF_AFF) + (size_t)e * NTOK;
        __syncthreads();
        for (int i = tid; i < NTOK; i += NTHR) vals[i] = __float_as_uint(aff[i]);
        if (tid == 0) { sh[0] = 0u; sh[1] = CAP; }
        __syncthreads();
        unsigned mask = 0u;
        for (int shift = 24; shift >= 0; shift -= 8) {
            if (tid < 256) hist[tid] = 0u;
            __syncthreads();
            const unsigned prefix = sh[0];
            for (int i = tid; i < NTOK; i += NTHR) { const unsigned v = vals[i]; if ((v & mask) == prefix) atomicAdd(&hist[(v >> shift) & 255u], 1u); }
            __syncthreads();
            if (tid == 0) { unsigned k = sh[1], cum = 0u; int b = 255; for (; b > 0; --b) { const unsigned h = hist[b]; if (cum + h >= k) break; cum += h; }
                sh[0] = prefix | ((unsigned)b << shift); sh[1] = k - cum; }
            mask |= 255u << shift;
            __syncthreads();
        }
        const unsigned T = sh[0], krem = sh[1];
        unsigned gt = 0u, eq = 0u;
        for (int i = 0; i < 32; ++i) { const unsigned v = vals[tid * 32 + i]; gt += v > T; eq += v == T; }
        unsigned sg = gt, se = eq;
#pragma unroll
        for (int o = 1; o < 64; o <<= 1) { const unsigned a = __shfl_up(sg, o, 64), b = __shfl_up(se, o, 64); if (lane >= o) { sg += a; se += b; } }
        __syncthreads();
        if (lane == 63) { sh[16 + wid] = sg; sh[32 + wid] = se; }
        __syncthreads();
        unsigned og = 0u, oe = 0u;
        for (int w = 0; w < wid; ++w) { og += sh[16 + w]; oe += sh[32 + w]; }
        unsigned pg = og + sg - gt, pe = oe + se - eq;
        int* idx = WSP(int, OFF_IDX) + e * CAP; float* gate = WSP(float, OFF_GATE) + e * CAP; int* slot = WSP(int, OFF_SLOT);
        for (int i = 0; i < 32; ++i) { const int t = tid * 32 + i; const unsigned v = vals[t]; int s = -1;
            if (v > T) { s = (int)(pg + (pe < krem ? pe : krem)); ++pg; }
            else if (v == T) { if (pe < krem) s = (int)(pg + pe); ++pe; }
            slot[(size_t)t * NE + e] = s;
            if (s >= 0) { idx[s] = t; gate[s] = __uint_as_float(v); } }
    }
}

template <bool FINAL>
__device__ __forceinline__ void phase_combine(const Params& p, int layer, const float* __restrict__ xin, float* __restrict__ xout) {
    const int tid = ltid(), wid = tid >> 6, lane = tid & 63;
    const float* ada = WSP(float, OFF_ADA) + layer * 12288; const float* gf = ada + 5 * DM;
    const float* ada1 = WSP(float, OFF_ADA) + 12288;
    const bf16_t* ye = WSP(bf16_t, OFF_YE); const int* slot = WSP(int, OFF_SLOT);
    for (int row = blockIdx.x * 8 + wid; row < NTOK; row += gridDim.x * 8) {
        const int sv = lane < 16 ? slot[(size_t)row * NE + lane] : -1;
        f32x4 acc[8];
#pragma unroll
        for (int j = 0; j < 8; ++j) acc[j] = (f32x4){0.f, 0.f, 0.f, 0.f};
        for (int e = 0; e < NE; ++e) { const int s = __shfl(sv, e, 64);
            if (s >= 0) { const bf16_t* yr = ye + ((size_t)e * CAP + s) * DM;
#pragma unroll
                for (int j = 0; j < 8; ++j) { const u32x2 w = *(const u32x2*)(yr + j * 256 + lane * 4);
                    acc[j][0] += __uint_as_float(w.x << 16); acc[j][1] += __uint_as_float(w.x & 0xffff0000u); acc[j][2] += __uint_as_float(w.y << 16); acc[j][3] += __uint_as_float(w.y & 0xffff0000u); } } }
        float ss = 0.f; f32x4 v[8];
#pragma unroll
        for (int j = 0; j < 8; ++j) { const int c = j * 256 + lane * 4; v[j] = *(const f32x4*)(xin + (size_t)row * DM + c) + *(const f32x4*)(gf + c) * acc[j];
            ss += v[j][0] * v[j][0] + v[j][1] * v[j][1] + v[j][2] * v[j][2] + v[j][3] * v[j][3]; }
        ss = wave_sum(ss); const float rs = rsqrtf(ss * (1.f / DM) + EPS);
#pragma unroll
        for (int j = 0; j < 8; ++j) { const int c = j * 256 + lane * 4;
            if constexpr (FINAL) { *(f32x4*)(p.out + (size_t)row * DM + c) = v[j] * rs * *(const f32x4*)(p.g_final + c); }
            else { *(f32x4*)(xout + (size_t)row * DM + c) = v[j];
                const f32x4 o = v[j] * rs * *(const f32x4*)(p.g_mix + DM + c) * (*(const f32x4*)(ada1 + DM + c) + 1.f) + *(const f32x4*)(ada1 + c);
                u32x2 w; w.x = cvtpk(o[0], o[1]); w.y = cvtpk(o[2], o[3]); *(u32x2*)(WSP(bf16_t, OFF_H) + (size_t)row * DM + c) = w; } }
    }
}

enum { PH_PREP = 0, PH_MOD0, PH_INPROJ, PH_UP, PH_ATTN, PH_OUT, PH_ROUTER0, PH_TOPK0, PH_MOE1_0, PH_MOE2_0, PH_COMB0,
       PH_F1, PH_F2A, PH_F2B, PH_FOUT, PH_ROUTER1, PH_TOPK1, PH_MOE1_1, PH_MOE2_1, PH_COMB1, PH_COUNT };

template <int PH>
__device__ __forceinline__ void run_phase(char* smem) {
    typedef __attribute__((address_space(4))) const unsigned long long* KargPtr;
    KargPtr pp = (KargPtr)__builtin_amdgcn_kernarg_segment_ptr();
    asm volatile("; phase %1 begin" : "+s"(pp) : "n"(PH));
    union { Params p; unsigned long long w[sizeof(Params) / 8]; } pu;
#pragma unroll
    for (unsigned i = 0; i < sizeof(Params) / 8; ++i) pu.w[i] = pp[i];
    const Params& p = pu.p;
    LAS unsigned char* lds = (LAS unsigned char*)smem;
    pg8::StaticOrder S;
    const int G = gridDim.x, c = lbid();
    if constexpr (PH == PH_PREP) phase_prep(p, smem);
    else if constexpr (PH == PH_MOD0) phase_mod0(p);
    else if constexpr (PH == PH_INPROJ) {
        DescPlain d{WSP(char, OFF_H), WSP(char, OFF_WIN), DM, DM, DM};
        EpiInproj e{WSP(bf16_t, OFF_CQ), WSP(bf16_t, OFF_CKV), WSP(bf16_t, OFF_KR), WSP(bf16_t, OFF_QNA), WSP(bf16_t, OFF_KNA), WSP(bf16_t, OFF_VNA), WSP(float, OFF_PSQ), WSP(float, OFF_ROPE)};
        S.init(NKEY / 256, INWP / 256, G, c); pg8::gemm_phase(lds, d, S, e);
    } else if constexpr (PH == PH_UP) {
        { DescPlain d{WSP(char, OFF_CQ), WSP(char, OFF_WUQ), 512, 512, 512};
          EpiUq e{WSP(bf16_t, OFF_Q), WSP(float, OFF_PSQ), WSP(float, OFF_ROPE)};
          S.init(NTOK / 256, 1536 / 256, G, c); pg8::gemm_phase(lds, d, S, e); }
        { DescPlain d{WSP(char, OFF_CKV), WSP(char, OFF_WUKV), 256, 256, 256};
          EpiUkv e{WSP(bf16_t, OFF_KN), WSP(bf16_t, OFF_V), WSP(float, OFF_PSQ)};
          S.init(NKEY / 256, 2048 / 256, G, G - 1 - c); pg8::gemm_phase(lds, d, S, e); }
    } else if constexpr (PH == PH_ATTN) {
        for (int L = c; L < 512; L += G) {
            const int h = L & 7, qb = L >> 3;
            att::attn_body<192, false>(WSP(bf16_t, OFF_Q) + ((size_t)h * NTOK + qb * 256) * 192, WSP(bf16_t, OFF_KN) + (size_t)h * NKEY * 128, WSP(bf16_t, OFF_KR),
                                       WSP(bf16_t, OFF_V) + (size_t)h * NKEY * 128, WSP(bf16_t, OFF_OCAT) + (size_t)(qb * 256) * DM + h * 128, NKEY / 64, 0, 0, nullptr, smem);
        }
        for (int L = c; L < 512; L += G) {
            const int h = L & 7, qb = L >> 3;
            const int r0 = qb * 4; const int u0 = r0 < 4 ? 0 : (r0 - 4 > 248 ? 248 : r0 - 4);
            const int r3 = r0 + 3; const int ulast = (r3 < 4 ? 0 : (r3 - 4 > 248 ? 248 : r3 - 4)) + 7;
            int nt = 4 + (ulast - u0 + 1); nt += nt & 1;
            att::attn_body<128, true>(WSP(bf16_t, OFF_QNA) + ((size_t)h * NTOK + qb * 256) * 128, WSP(bf16_t, OFF_KNA) + (size_t)h * NKEY * 128, nullptr,
                                      WSP(bf16_t, OFF_VNA) + (size_t)h * NKEY * 128, WSP(bf16_t, OFF_OCAT) + (size_t)(qb * 256) * DM + 1024 + h * 128, nt, u0, r0,
                                      p.na_bias + h * 15 * 31, smem);
        }
    } else if constexpr (PH == PH_OUT) {
        DescPlain d{WSP(char, OFF_OCAT), WSP(char, OFF_WOUT), DM, DM, DM};
        EpiResid e{WSP(float, OFF_X1), p.x, WSP(float, OFF_ADA) + 2 * DM};
        S.init(NTOK / 256, DM / 256, G, c); pg8::gemm_phase(lds, d, S, e);
    } else if constexpr (PH == PH_ROUTER0) phase_router(p, 0, WSP(float, OFF_X1), WSP(bf16_t, OFF_H), smem);
    else if constexpr (PH == PH_ROUTER1) phase_router(p, 1, WSP(float, OFF_X1), WSP(bf16_t, OFF_H), smem);
    else if constexpr (PH == PH_TOPK0 || PH == PH_TOPK1) phase_topk(p, smem);
    else if constexpr (PH == PH_MOE1_0 || PH == PH_MOE1_1) {
        constexpr int l = PH == PH_MOE1_1;
        DescMoe1 d{WSP(char, OFF_H), WSP(char, OFF_WGU) + (size_t)l * NE * 4096 * DM * 2, DM, WSP(int, OFF_IDX)};
        EpiMoe1 e{WSP(bf16_t, OFF_ACT)};
        S.init(NE * CAP / 256, 4096 / 256, G, c); pg8::gemm_phase(lds, d, S, e);
    } else if constexpr (PH == PH_MOE2_0 || PH == PH_MOE2_1) {
        constexpr int l = PH == PH_MOE2_1;
        DescMoe2 d{WSP(char, OFF_ACT), WSP(char, OFF_WD) + (size_t)l * NE * DM * FF * 2, FF};
        EpiMoe2 e{WSP(bf16_t, OFF_YE), WSP(float, OFF_GATE)};
        S.init(NE * CAP / 256, DM / 256, G, c); pg8::gemm_phase(lds, d, S, e);
    } else if constexpr (PH == PH_COMB0) phase_combine<false>(p, 0, WSP(float, OFF_X1), WSP(float, OFF_X2));
    else if constexpr (PH == PH_COMB1) phase_combine<true>(p, 1, WSP(float, OFF_X1), nullptr);
    else if constexpr (PH == PH_F1) {
        DescF1 d{WSP(char, OFF_DFT1), WSP(char, OFF_H), 256};
        EpiF1 e{WSP(bf16_t, OFF_ACT)};
        S.init(2, 512, G, c); pg8::gemm_phase(lds, d, S, e);
    } else if constexpr (PH == PH_F2A) {
        DescPlain d{WSP(char, OFF_WA), WSP(char, OFF_ACT), 256, 256, 256};
        EpiF2A e{WSP(bf16_t, OFF_YE), WSP(float, OFF_TW)};
        S.init(1, 1024, G, c); pg8::gemm_phase(lds, d, S, e);
    } else if constexpr (PH == PH_F2B) {
        DescPlain d{WSP(char, OFF_WB), WSP(char, OFF_YE), 256, 256, 256};
        EpiF2B e{WSP(bf16_t, OFF_OCAT)};
        S.init(1, 1024, G, c); pg8::gemm_phase(lds, d, S, e);
    } else if constexpr (PH == PH_FOUT) {
        DescPlain d{WSP(char, OFF_OCAT), WSP(char, OFF_WFOUT), DM, DM, DM};
        EpiResid e{WSP(float, OFF_X1), WSP(float, OFF_X2), WSP(float, OFF_ADA) + 12288 + 2 * DM};
        S.init(NTOK / 256, DM / 256, G, c); pg8::gemm_phase(lds, d, S, e);
    }
}

template <int PH>
__global__ __launch_bounds__(NTHR, 2) void k_phase(Params p) {
    ltid_init();
    run_phase<PH>(g_smem);
}

#ifndef MEGA_NOINLINE
#define MEGA_NOINLINE 0
#endif
template <int PH> __device__ __forceinline__ void run_all(char* smem, const XcdBarrier& bar) {
#ifdef MEGA_MASK
    if constexpr ((MEGA_MASK >> PH) & 1)
#endif
    run_phase<PH>(smem);
    if constexpr (PH + 1 < PH_COUNT) { xcd_barrier(bar); run_all<PH + 1>(smem, bar); }
}
#if N_LAUNCH_MODE == 0 && !DEBUG_CHECK
__global__ __launch_bounds__(NTHR, 2) void k_mega(Params p) {
    uint4* xbw = (uint4*)(g_smem + LDS_XBW);
    if (threadIdx.x == 0) *xbw = make_uint4(0u, 0u, 0u, 0u);
    ltid_init();
    XcdBarrier bar = xcd_barrier_post((unsigned*)(p.ws + OFF_BAR), (volatile LAS unsigned*)xbw);
    run_all<0>(g_smem, bar);
}
#endif


#if DEBUG_CHECK
__device__ __forceinline__ unsigned dhash(unsigned x) { x ^= x >> 16; x *= 0x7feb352dU; x ^= x >> 15; x *= 0x846ca68bU; x ^= x >> 16; return x; }
__device__ __forceinline__ void dreport(const Params& p, int slot, float ref, float mine, float scale) {
    float e = fabsf(ref - mine) / (fabsf(ref) + scale); if (!(e == e) || e > 1e9f) e = 1e9f;
    atomicMax((unsigned*)(p.ws + OFF_ERR) + slot, __float_as_uint(e));
}
__device__ __forceinline__ float drope(float x1, float x2, int i  , int pos) {
    const int f = i & 15; const float inv = powf(10000.f, -(float)f / 16.f), a = (float)pos * inv, c = cosf(a), s = sinf(a);
    return i < 16 ? x1 * c - x2 * s : x2 * c + x1 * s;
}
__global__ void dbg_ada(Params p) {
    const unsigned i = blockIdx.x * blockDim.x + threadIdx.x, h = dhash(i), w = h % 3;
    const int j = (int)(dhash(h) % (w == 2 ? 4096u : 12288u)); const int layer = w == 1;
    const float* cv = w == 2 ? p.c_ctx : p.c; const float* W = p.ada_w + (size_t)layer * DM * 12288;
    float s = 0.f; for (int k = 0; k < DM; ++k) { const float v = cv[k]; s += v / (1.f + expf(-v)) * W[(size_t)k * 12288 + j]; }
    s += p.ada_b[layer * 12288 + j];
    const float mine = (w == 2 ? WSP(float, OFF_ADA) + 2 * 12288 : WSP(float, OFF_ADA) + layer * 12288)[j];
    dreport(p, 0, s, mine, 0.05f);
}
__global__ void dbg_mod0(Params p) {
    const unsigned i = blockIdx.x * blockDim.x + threadIdx.x, h = dhash(i + 77u);
    const int row = h % NKEY, col = dhash(h) % DM;
    const float* src = row < NCTX ? p.ctx + (size_t)row * DM : p.x + (size_t)(row - NCTX) * DM;
    const float* ad = row < NCTX ? WSP(float, OFF_ADA) + 2 * 12288 : WSP(float, OFF_ADA);
    float ss = 0.f; for (int k = 0; k < DM; ++k) ss += src[k] * src[k];
    const float ref = src[col] * rsqrtf(ss / DM + EPS) * p.g_mix[col] * (1.f + ad[DM + col]) + ad[col];
    dreport(p, 1, ref, bf2f(WSP(bf16_t, OFF_H)[(size_t)row * DM + col]), 0.5f);
}
__device__ __forceinline__ float dbg_indot(const Params& p, int row, int col) {
    const bf16_t* hr = WSP(bf16_t, OFF_H) + (size_t)row * DM; float s = 0.f;
    for (int k = 0; k < DM; ++k) s += bf2f(hr[k]) * p.w_in[(size_t)k * INW + col];
    return s;
}
__global__ void dbg_inproj(Params p) {
    const unsigned i = blockIdx.x * blockDim.x + threadIdx.x, h = dhash(i + 1234u);
    const int row = h % NKEY; int col = dhash(h) % INW; const bool lat = row >= NCTX; const int n = row - NCTX;
    if (i & 1) col = 768 + (int)(dhash(h + 5u) % 64u);
    float ref, mine;
    if (col < 512) { if (!lat) return; ref = dbg_indot(p, row, col); mine = bf2f(WSP(bf16_t, OFF_CQ)[(size_t)n * 512 + col]); }
    else if (col < 768) { ref = dbg_indot(p, row, col); mine = bf2f(WSP(bf16_t, OFF_CKV)[(size_t)row * 256 + col - 512]); }
    else if (col < 832) { const int ridx = col - 768, half = ridx >> 5, ii = ridx & 31, f = ii & 15;
        const float x1 = dbg_indot(p, row, 768 + 32 * half + f), x2 = dbg_indot(p, row, 768 + 32 * half + 16 + f);
        ref = lat ? drope(x1, x2, ii, half == 0 ? (n >> 6) : (n & 63)) : (ii < 16 ? x1 : x2);
        mine = bf2f(WSP(bf16_t, OFF_KR)[(size_t)row * 64 + 2 * (16 * half + f) + (ii >> 4)]); }
    else if (col < 1856) { if (!lat) return; const int j = col - 832; ref = dbg_indot(p, row, col) * NA_QS; mine = bf2f(WSP(bf16_t, OFF_QNA)[((size_t)(j >> 7) * NTOK + n) * 128 + (j & 127)]); }
    else if (col < 2880) { const int j = col - 1856; ref = dbg_indot(p, row, col); mine = bf2f(WSP(bf16_t, OFF_KNA)[((size_t)(j >> 7) * NKEY + row) * 128 + (j & 127)]); }
    else { const int j = col - 2880; ref = dbg_indot(p, row, col); mine = bf2f(WSP(bf16_t, OFF_VNA)[((size_t)(j >> 7) * NKEY + row) * 128 + (j & 127)]); }
    dreport(p, 2, ref, mine, 0.3f);
}
__device__ __forceinline__ float dbg_uqdot(const Params& p, int n, int col) {
    const bf16_t* r = WSP(bf16_t, OFF_CQ) + (size_t)n * 512; float s = 0.f;
    for (int k = 0; k < 512; ++k) s += bf2f(r[k]) * p.g_qn[k] * p.w_uq[(size_t)k * 1536 + col];
    return s;
}
__global__ void dbg_up(Params p) {
    const unsigned i = blockIdx.x * blockDim.x + threadIdx.x, h = dhash(i + 999u);
    if (i & 1) {
        const int n = h % NTOK, hd = dhash(h) % 8, d = dhash(h + 3u) % 192;
        const bf16_t* r = WSP(bf16_t, OFF_CQ) + (size_t)n * 512; float ss = 0.f; for (int k = 0; k < 512; ++k) ss += bf2f(r[k]) * bf2f(r[k]);
        const float rs = rsqrtf(ss / 512.f + EPS); float ref, mine;
        if (d < 128) { ref = dbg_uqdot(p, n, hd * 192 + d) * rs * MLA_QS; mine = bf2f(WSP(bf16_t, OFF_Q)[((size_t)hd * NTOK + n) * 192 + d]); }
        else { const int ridx = d - 128, half = ridx >> 5, ii = ridx & 31, f = ii & 15;
            const float x1 = dbg_uqdot(p, n, hd * 192 + 128 + 32 * half + f) * rs, x2 = dbg_uqdot(p, n, hd * 192 + 128 + 32 * half + 16 + f) * rs;
            ref = drope(x1, x2, ii, half == 0 ? (n >> 6) : (n & 63)) * MLA_QS;
            mine = bf2f(WSP(bf16_t, OFF_Q)[((size_t)hd * NTOK + n) * 192 + 128 + 2 * (16 * half + f) + (ii >> 4)]); }
        dreport(p, 3, ref, mine, 0.1f);
    } else {
        const int key = h % NKEY, hd = dhash(h) % 8, d = dhash(h + 3u) % 256;
        const bf16_t* r = WSP(bf16_t, OFF_CKV) + (size_t)key * 256; float ss = 0.f, s = 0.f;
        for (int k = 0; k < 256; ++k) { const float v = bf2f(r[k]); ss += v * v; s += v * p.g_kvn[k] * p.w_ukv[(size_t)k * 2048 + hd * 256 + d]; }
        const float ref = s * rsqrtf(ss / 256.f + EPS);
        const float mine = bf2f((d < 128 ? WSP(bf16_t, OFF_KN) : WSP(bf16_t, OFF_V))[((size_t)hd * NKEY + key) * 128 + (d & 127)]);
        dreport(p, 3, ref, mine, 0.3f);
    }
}
__global__ void dbg_mla(Params p) {
    extern __shared__ float sc[];
    __shared__ float red[256];
    const unsigned hh = dhash(blockIdx.x + 4242u); const int n = blockIdx.x < 4 ? (blockIdx.x * 5461 + (blockIdx.x & 1) * 255) % NTOK : hh % NTOK, h = dhash(hh) % 8, tid = threadIdx.x;
    const bf16_t* q = WSP(bf16_t, OFF_Q) + ((size_t)h * NTOK + n) * 192;
    float mx = -1e30f;
    for (int key = tid; key < NKEY; key += 256) { const bf16_t* kn = WSP(bf16_t, OFF_KN) + ((size_t)h * NKEY + key) * 128; const bf16_t* kr = WSP(bf16_t, OFF_KR) + (size_t)key * 64;
        float s = 0.f; for (int d = 0; d < 128; ++d) s += bf2f(q[d]) * bf2f(kn[d]); for (int d = 0; d < 64; ++d) s += bf2f(q[128 + d]) * bf2f(kr[d]);
        sc[key] = s; mx = fmaxf(mx, s); }
    red[tid] = mx; __syncthreads(); for (int o = 128; o > 0; o >>= 1) { if (tid < o) red[tid] = fmaxf(red[tid], red[tid + o]); __syncthreads(); } mx = red[0]; __syncthreads();
    float l = 0.f; for (int key = tid; key < NKEY; key += 256) { const float e = exp2f(sc[key] - mx); sc[key] = e; l += e; }
    red[tid] = l; __syncthreads(); for (int o = 128; o > 0; o >>= 1) { if (tid < o) red[tid] += red[tid + o]; __syncthreads(); } l = red[0];
    if (tid < 128) { float o = 0.f; for (int key = 0; key < NKEY; ++key) o += sc[key] * bf2f(WSP(bf16_t, OFF_V)[((size_t)h * NKEY + key) * 128 + tid]);
        dreport(p, 4, o / l, bf2f(WSP(bf16_t, OFF_OCAT)[(size_t)n * DM + h * 128 + tid]), 0.05f); }
}
__global__ void dbg_na(Params p) {
    __shared__ float sc[384]; __shared__ float red[512];
    const unsigned hh = dhash(blockIdx.x + 777u); const int tid = threadIdx.x;
    int n = hh % NTOK; if (blockIdx.x < 8) { const int rr[8] = {0, 3, 4, 5, 251, 252, 255, 128}; const int cc[8] = {0, 7, 8, 9, 55, 56, 63, 33}; n = rr[blockIdx.x] * 64 + cc[blockIdx.x]; }
    const int h = dhash(hh) % 8, r = n >> 6, cq = n & 63, rs = r < 4 ? 0 : (r > 252 ? 248 : r - 4), cs = cq < 8 ? 0 : (cq > 56 ? 48 : cq - 8);
    const bf16_t* q = WSP(bf16_t, OFF_QNA) + ((size_t)h * NTOK + n) * 128;
    float s = -1e30f; int key = 0;
    if (tid < 384) { float bias = 0.f;
        if (tid < 256) key = tid; else { const int j = tid - 256, jr = j >> 4, jc = j & 15; key = NCTX + (rs + jr) * 64 + cs + jc; bias = p.na_bias[(h * 15 + (rs + jr - r + 7)) * 31 + (cs + jc - cq + 15)] * LOG2E; }
        const bf16_t* kk = WSP(bf16_t, OFF_KNA) + ((size_t)h * NKEY + key) * 128; s = bias; for (int d = 0; d < 128; ++d) s += bf2f(q[d]) * bf2f(kk[d]); }
    red[tid] = s; __syncthreads(); for (int o = 256; o > 0; o >>= 1) { if (tid < o) red[tid] = fmaxf(red[tid], red[tid + o]); __syncthreads(); } const float mx = red[0]; __syncthreads();
    const float e = tid < 384 ? exp2f(s - mx) : 0.f; if (tid < 384) sc[tid] = e;
    red[tid] = e; __syncthreads(); for (int o = 256; o > 0; o >>= 1) { if (tid < o) red[tid] += red[tid + o]; __syncthreads(); } const float l = red[0];
    if (tid < 128) { float o = 0.f;
        for (int j = 0; j < 384; ++j) { int kj = j; if (j >= 256) { const int jj = j - 256; kj = NCTX + (rs + (jj >> 4)) * 64 + cs + (jj & 15); }
            o += sc[j] * bf2f(WSP(bf16_t, OFF_VNA)[((size_t)h * NKEY + kj) * 128 + tid]); }
        dreport(p, 5, o / l, bf2f(WSP(bf16_t, OFF_OCAT)[(size_t)n * DM + 1024 + h * 128 + tid]), 0.05f); }
}
__global__ void dbg_resid(Params p, int slot, const bf16_t* A, const float* W, const float* base, const float* gate, const float* mineb) {
    const unsigned i = blockIdx.x * blockDim.x + threadIdx.x, h = dhash(i + 31337u + slot);
    const int row = h % NTOK, col = dhash(h) % DM; float s = 0.f;
    for (int k = 0; k < DM; ++k) s += bf2f(A[(size_t)row * DM + k]) * W[(size_t)k * DM + col];
    dreport(p, slot, base[(size_t)row * DM + col] + gate[col] * s, mineb[(size_t)row * DM + col], 0.3f);
}
__global__ void dbg_router(Params p, int slot, int layer) {
    const unsigned i = blockIdx.x * blockDim.x + threadIdx.x, h = dhash(i + 555u + slot);
    const int row = h % NTOK; const float* src = WSP(float, OFF_X1) + (size_t)row * DM;
    const float* ada = WSP(float, OFF_ADA) + layer * 12288; const float* g = p.g_ffn + layer * DM; const float* W = p.w_router + (size_t)layer * DM * NE;
    float ss = 0.f; for (int k = 0; k < DM; ++k) ss += src[k] * src[k]; const float rs = rsqrtf(ss / DM + EPS);
    float lg[16]; for (int e = 0; e < 16; ++e) lg[e] = 0.f;
    const int col = dhash(h) % DM;
    for (int k = 0; k < DM; ++k) { const float hv = src[k] * rs * g[k] * (1.f + ada[4 * DM + k]) + ada[3 * DM + k];
        if (k == col) dreport(p, slot, hv, bf2f(WSP(bf16_t, OFF_H)[(size_t)row * DM + k]), 0.5f);
        for (int e = 0; e < 16; ++e) lg[e] += hv * W[k * NE + e]; }
    float mx = -1e30f; for (int e = 0; e < 16; ++e) mx = fmaxf(mx, lg[e]); float sm = 0.f; for (int e = 0; e < 16; ++e) { lg[e] = expf(lg[e] - mx); sm += lg[e]; }
    for (int e = 0; e < 16; ++e) dreport(p, slot, lg[e] / sm, WSP(float, OFF_AFF)[(size_t)e * NTOK + row], 0.01f);
}
__global__ void dbg_topk(Params p, int slot_) {
    __shared__ float rmin[512], rmax[512]; __shared__ int rc[512], bad[512];
    const int e = blockIdx.x, tid = threadIdx.x; float mn = 1e30f, mxu = -1e30f; int cnt = 0, b = 0;
    for (int t = tid; t < NTOK; t += 512) { const int s = WSP(int, OFF_SLOT)[(size_t)t * NE + e]; const float a = WSP(float, OFF_AFF)[(size_t)e * NTOK + t];
        if (s >= 0) { ++cnt; mn = fminf(mn, a); if (s >= CAP || WSP(int, OFF_IDX)[e * CAP + s] != t || WSP(float, OFF_GATE)[e * CAP + s] != a) b = 1; } else mxu = fmaxf(mxu, a); }
    rmin[tid] = mn; rmax[tid] = mxu; rc[tid] = cnt; bad[tid] = b; __syncthreads();
    for (int o = 256; o > 0; o >>= 1) { if (tid < o) { rmin[tid] = fminf(rmin[tid], rmin[tid + o]); rmax[tid] = fmaxf(rmax[tid], rmax[tid + o]); rc[tid] += rc[tid + o]; bad[tid] |= bad[tid + o]; } __syncthreads(); }
    if (tid == 0) { float err = 0.f; if (rc[0] != CAP) err = 0.5f; else if (bad[0]) err = 0.25f; else if (rmin[0] < rmax[0]) err = 0.125f; dreport(p, slot_, err, 0.f, 1.0f - err); }
}
__global__ void dbg_act(Params p, int slot_, int layer) {
    const unsigned i = blockIdx.x * blockDim.x + threadIdx.x, h = dhash(i + 2024u + slot_);
    const int e = h % NE, sl = dhash(h) % CAP, ff = dhash(h + 9u) % FF; const int t = WSP(int, OFF_IDX)[e * CAP + sl];
    if (t < 0 || t >= NTOK) { dreport(p, slot_, 1.f, 0.f, 0.f); return; }
    const bf16_t* hr = WSP(bf16_t, OFF_H) + (size_t)t * DM; const float* wg = p.w_gate + ((size_t)layer * NE + e) * DM * FF; const float* wu = p.w_up + ((size_t)layer * NE + e) * DM * FF;
    float a = 0.f, u = 0.f; for (int k = 0; k < DM; ++k) { const float v = bf2f(hr[k]); a += v * wg[(size_t)k * FF + ff]; u += v * wu[(size_t)k * FF + ff]; }
    dreport(p, slot_, a / (1.f + expf(-a)) * u, bf2f(WSP(bf16_t, OFF_ACT)[((size_t)e * CAP + sl) * FF + ff]), 0.2f);
}
__global__ void dbg_ye(Params p, int slot_, int layer) {
    const unsigned i = blockIdx.x * blockDim.x + threadIdx.x, h = dhash(i + 808u + slot_);
    const int e = h % NE, sl = dhash(h) % CAP, d = dhash(h + 9u) % DM;
    const bf16_t* ar = WSP(bf16_t, OFF_ACT) + ((size_t)e * CAP + sl) * FF; const float* wd = p.w_down + ((size_t)layer * NE + e) * FF * DM;
    float s = 0.f; for (int k = 0; k < FF; ++k) s += bf2f(ar[k]) * wd[(size_t)k * DM + d];
    dreport(p, slot_, s * WSP(float, OFF_GATE)[e * CAP + sl], bf2f(WSP(bf16_t, OFF_YE)[((size_t)e * CAP + sl) * DM + d]), 0.1f);
}
__device__ __forceinline__ float dbg_x2(const Params& p, int layer, int row, int c) {
    float acc = 0.f; for (int e = 0; e < NE; ++e) { const int s = WSP(int, OFF_SLOT)[(size_t)row * NE + e]; if (s >= 0) acc += bf2f(WSP(bf16_t, OFF_YE)[((size_t)e * CAP + s) * DM + c]); }
    return WSP(float, OFF_X1)[(size_t)row * DM + c] + WSP(float, OFF_ADA)[layer * 12288 + 5 * DM + c] * acc;
}
__global__ void dbg_comb0(Params p) {
    const unsigned i = blockIdx.x * blockDim.x + threadIdx.x, h = dhash(i + 1111u);
    const int row = h % NTOK, col = dhash(h) % DM;
    dreport(p, 11, dbg_x2(p, 0, row, col), WSP(float, OFF_X2)[(size_t)row * DM + col], 0.3f);
    float ss = 0.f; for (int k = 0; k < DM; ++k) { const float v = WSP(float, OFF_X2)[(size_t)row * DM + k]; ss += v * v; }
    const float* ada1 = WSP(float, OFF_ADA) + 12288;
    const float ref = WSP(float, OFF_X2)[(size_t)row * DM + col] * rsqrtf(ss / DM + EPS) * p.g_mix[DM + col] * (1.f + ada1[DM + col]) + ada1[col];
    dreport(p, 11, ref, bf2f(WSP(bf16_t, OFF_H)[(size_t)row * DM + col]), 0.5f);
}
__global__ void dbg_fft(Params p, const bf16_t* Hsave) {
    __shared__ float cb[256], sb[256]; __shared__ double red[256];
    const unsigned hh = dhash(blockIdx.x + 606u); const int tid = threadIdx.x;
    int k = hh % NTOK, col = dhash(hh) % DM; if (blockIdx.x == 0) { k = 0; col = 0; } if (blockIdx.x == 1) { k = 1; col = 257; } if (blockIdx.x == 2) { k = 128; col = 3; }
    const int g = col >> 8, m = col & 255;
    { float s, c; sincospif((float)((m * tid) & 255) / 128.f, &s, &c); cb[tid] = c; sb[tid] = s; } __syncthreads();
    double acc = 0.0;
    for (int n = tid; n < NTOK; n += 256) { float P = 0.f, Q = 0.f; const bf16_t* hr = Hsave + (size_t)n * DM + g * 256;
        for (int c = 0; c < 256; ++c) { const float v = bf2f(hr[c]); P += v * cb[c]; Q += v * sb[c]; }
        float sa, ca; sincospif((float)(((long)k * n) & 16383) / 8192.f, &sa, &ca); acc += (double)ca * P - (double)sa * Q; }
    red[tid] = acc; __syncthreads(); for (int o = 128; o > 0; o >>= 1) { if (tid < o) red[tid] += red[tid + o]; __syncthreads(); }
    if (tid == 0) dreport(p, 12, (float)(red[0] / 2048.0), bf2f(WSP(bf16_t, OFF_OCAT)[(size_t)k * DM + col]), 0.3f);
}
__global__ void dbg_final(Params p) {
    const unsigned i = blockIdx.x * blockDim.x + threadIdx.x, h = dhash(i + 9090u);
    const int row = h % NTOK, col = dhash(h) % DM; float ss = 0.f, xc = 0.f;
    for (int k = 0; k < DM; ++k) { const float v = dbg_x2(p, 1, row, k); ss += v * v; if (k == col) xc = v; }
    dreport(p, 18, xc * rsqrtf(ss / DM + EPS) * p.g_final[col], p.out[(size_t)row * DM + col], 0.3f);
}
__global__ void dbg_report(Params p) {
    const unsigned* err = (const unsigned*)(p.ws + OFF_ERR);
    int bad = -1; float be = 0.f;
    for (int s = 0; s < 19; ++s) { const float e = __uint_as_float(err[s]); if (e > 0.04f) { bad = s; be = e; break; } }
    if (bad < 0) return;
    const size_t i0 = (size_t)blockIdx.x * blockDim.x + threadIdx.x;
    for (size_t i = i0; i < (size_t)NTOK * DM; i += (size_t)gridDim.x * blockDim.x) p.out[i] = 0.f;
    if (i0 == 0) { const float m = 1.f + 8.f * fminf(1.f, be); p.out[0] = sqrtf(m * 33554432.f) * powf(10.f, 0.5f * (float)(bad + 2)); }
}
static void dbg_after_phase(int ph, const Params& p, hipStream_t st) {
    char* ws = p.ws;
    static bool a = false; if (!a) { (void)hipFuncSetAttribute((const void*)dbg_mla, hipFuncAttributeMaxDynamicSharedMemorySize, NKEY * 4); a = true; }
    bf16_t* hsave = (bf16_t*)(ws + OFF_CQ);
    switch (ph) {
    case PH_PREP: hipLaunchKernelGGL(dbg_ada, dim3(16), dim3(256), 0, st, p); break;
    case PH_MOD0: hipLaunchKernelGGL(dbg_mod0, dim3(16), dim3(256), 0, st, p); break;
    case PH_INPROJ: hipLaunchKernelGGL(dbg_inproj, dim3(64), dim3(256), 0, st, p); break;
    case PH_UP: hipLaunchKernelGGL(dbg_up, dim3(64), dim3(256), 0, st, p); break;
    case PH_ATTN: hipLaunchKernelGGL(dbg_mla, dim3(48), dim3(256), NKEY * 4, st, p); hipLaunchKernelGGL(dbg_na, dim3(96), dim3(512), 0, st, p); break;
    case PH_OUT: hipLaunchKernelGGL(dbg_resid, dim3(64), dim3(256), 0, st, p, 6, (const bf16_t*)(ws + OFF_OCAT), p.w_out_attn, p.x, (const float*)(ws + OFF_ADA) + 2 * DM, (const float*)(ws + OFF_X1)); break;
    case PH_ROUTER0: hipLaunchKernelGGL(dbg_router, dim3(8), dim3(256), 0, st, p, 7, 0); break;
    case PH_TOPK0: hipLaunchKernelGGL(dbg_topk, dim3(16), dim3(512), 0, st, p, 8); break;
    case PH_MOE1_0: hipLaunchKernelGGL(dbg_act, dim3(64), dim3(256), 0, st, p, 9, 0); break;
    case PH_MOE2_0: hipLaunchKernelGGL(dbg_ye, dim3(64), dim3(256), 0, st, p, 10, 0); break;
    case PH_COMB0: hipLaunchKernelGGL(dbg_comb0, dim3(16), dim3(256), 0, st, p);
        (void)hipMemcpyAsync(hsave, ws + OFF_H, (size_t)NTOK * DM * 2, hipMemcpyDeviceToDevice, st); break;
    case PH_F2B: hipLaunchKernelGGL(dbg_fft, dim3(48), dim3(256), 0, st, p, (const bf16_t*)hsave); break;
    case PH_FOUT: hipLaunchKernelGGL(dbg_resid, dim3(64), dim3(256), 0, st, p, 13, (const bf16_t*)(ws + OFF_OCAT), p.w_out_fourier, (const float*)(ws + OFF_X2), (const float*)(ws + OFF_ADA) + 12288 + 2 * DM, (const float*)(ws + OFF_X1)); break;
    case PH_ROUTER1: hipLaunchKernelGGL(dbg_router, dim3(8), dim3(256), 0, st, p, 14, 1); break;
    case PH_TOPK1: hipLaunchKernelGGL(dbg_topk, dim3(16), dim3(512), 0, st, p, 15); break;
    case PH_MOE1_1: hipLaunchKernelGGL(dbg_act, dim3(64), dim3(256), 0, st, p, 16, 1); break;
    case PH_MOE2_1: hipLaunchKernelGGL(dbg_ye, dim3(64), dim3(256), 0, st, p, 17, 1); break;
    case PH_COMB1: hipLaunchKernelGGL(dbg_final, dim3(8), dim3(256), 0, st, p); hipLaunchKernelGGL(dbg_report, dim3(1024), dim3(256), 0, st, p); break;
    default: break;
    }
}
#endif
template <int PH> static void launch_phases(const Params& p, int grid, hipStream_t stream) {
    static bool attr_done = false;
    if (!attr_done) { (void)hipFuncSetAttribute((const void*)k_phase<PH>, hipFuncAttributeMaxDynamicSharedMemorySize, LDS_BYTES); attr_done = true; }
    hipLaunchKernelGGL(k_phase<PH>, dim3(grid), dim3(NTHR), LDS_BYTES, stream, p);
#if DEBUG_CHECK
    dbg_after_phase(PH, p, stream);
#endif
    if constexpr (PH + 1 < PH_COUNT) launch_phases<PH + 1>(p, grid, stream);
}

extern "C" void kernel_launch(void* const* d_in, const int* in_sizes, int n_in, void* d_out, int out_size, void* d_ws, size_t ws_size, hipStream_t stream) {
    if (n_in != 21 || ws_size < WS_END || out_size != NTOK * DM) {
        fprintf(stderr, "kernel_launch: unexpected shapes: n_in %d ws %zu (need %zu) out %d\n", n_in, ws_size, (size_t)WS_END, out_size);
        return;
    }
    Params p{};
    p.x = (const float*)d_in[0]; p.c = (const float*)d_in[1]; p.ctx = (const float*)d_in[2]; p.c_ctx = (const float*)d_in[3];
    p.ada_w = (const float*)d_in[4]; p.ada_b = (const float*)d_in[5]; p.g_mix = (const float*)d_in[6]; p.g_ffn = (const float*)d_in[7];
    p.g_final = (const float*)d_in[8]; p.w_in = (const float*)d_in[9]; p.g_qn = (const float*)d_in[10]; p.w_uq = (const float*)d_in[11];
    p.g_kvn = (const float*)d_in[12]; p.w_ukv = (const float*)d_in[13]; p.na_bias = (const float*)d_in[14]; p.w_out_attn = (const float*)d_in[15];
    p.w_out_fourier = (const float*)d_in[16]; p.w_router = (const float*)d_in[17]; p.w_gate = (const float*)d_in[18]; p.w_up = (const float*)d_in[19];
    p.w_down = (const float*)d_in[20];
    p.out = (float*)d_out; p.ws = (char*)d_ws;
    static int grid = 0;
    if (!grid) {
        int dev = 0, cus = 0, per_cu = 0;
        (void)hipGetDevice(&dev);
        (void)hipDeviceGetAttribute(&cus, hipDeviceAttributeMultiprocessorCount, dev);
#if N_LAUNCH_MODE == 0 && !DEBUG_CHECK
        (void)hipFuncSetAttribute((const void*)k_mega, hipFuncAttributeMaxDynamicSharedMemorySize, LDS_BYTES);
        (void)hipOccupancyMaxActiveBlocksPerMultiprocessor(&per_cu, (const void*)k_mega, NTHR, LDS_BYTES);
#else
        per_cu = 1;
#endif
        if (cus <= 0) cus = 256;
        grid = per_cu >= 1 ? cus : 0;
        if (!grid) { fprintf(stderr, "kernel_launch: persistent kernel does not fit (occupancy %d)\n", per_cu); grid = -1; }
    }
    if (grid <= 0) return;
    (void)hipMemsetAsync((char*)d_ws + OFF_BAR, 0, 16384, stream);
#if DEBUG_CHECK
    (void)hipMemsetAsync((char*)d_ws + OFF_ERR, 0, 4096, stream);
#endif
#if N_LAUNCH_MODE == 0 && !DEBUG_CHECK
    hipLaunchKernelGGL(k_mega, dim3(grid), dim3(NTHR), LDS_BYTES, stream, p);
#else
    launch_phases<0>(p, grid, stream);
#endif
    const hipError_t le = hipPeekAtLastError();
    if (le != hipSuccess) fprintf(stderr, "kernel_launch: launch failed: %s\n", hipGetErrorName(le));
}
```

```cpp
#include <hip/hip_runtime.h>
#include <cstdio>
#include <cstdint>

#ifndef N_LAUNCH_MODE
#define N_LAUNCH_MODE 0
#endif
#ifndef DEBUG_CHECK
#define DEBUG_CHECK 0
#endif
#ifndef PROBE_DOUBLE
#define PROBE_DOUBLE 0
#endif

typedef unsigned short bf16_t;
typedef short bf16x8 __attribute__((ext_vector_type(8)));
typedef short s16x4 __attribute__((ext_vector_type(4)));
typedef float f32x2 __attribute__((ext_vector_type(2)));
typedef float f32x4 __attribute__((ext_vector_type(4)));
typedef float f32x16 __attribute__((ext_vector_type(16)));
typedef unsigned u32x2 __attribute__((ext_vector_type(2)));
typedef unsigned u32x4 __attribute__((ext_vector_type(4)));
#define LAS __attribute__((address_space(3)))

constexpr int DM = 2048, NTOK = 16384, NCTX = 256, NKEY = NTOK + NCTX, GW = 64, GH = 256;
constexpr int NH = 8, NE = 16, CAP = 2048, FF = 2048;
constexpr int INW = 3904, INWP = 4096;
constexpr float EPS = 1e-6f;
constexpr float LOG2E = 1.4426950408889634f;
constexpr float MLA_QS = 0.07216878364870322f * LOG2E;
constexpr float NA_QS = 0.08838834764831845f * LOG2E;
constexpr int NTHR = 512;

constexpr size_t al256(size_t x) { return (x + 255) / 256 * 256; }
constexpr size_t OFF_BAR = 0;
constexpr size_t OFF_ADA = 16384;
constexpr size_t OFF_ROPE = OFF_ADA + al256((2 * 12288 + 4096) * 4);
constexpr size_t OFF_TW = OFF_ROPE + 256 * 16 * 2 * 4;
constexpr size_t OFF_DFT1 = OFF_TW + 128 * 128 * 2 * 4;
constexpr size_t OFF_WA = OFF_DFT1 + 512 * 256 * 2;
constexpr size_t OFF_WB = OFF_WA + 256 * 256 * 2;
constexpr size_t OFF_ERR = OFF_WB + 256 * 256 * 2;
constexpr size_t OFF_WIN = OFF_ERR + 4096;
constexpr size_t OFF_WUQ = OFF_WIN + (size_t)INWP * DM * 2;
constexpr size_t OFF_WUKV = OFF_WUQ + (size_t)1536 * 512 * 2;
constexpr size_t OFF_WOUT = OFF_WUKV + (size_t)2048 * 256 * 2;
constexpr size_t OFF_WFOUT = OFF_WOUT + (size_t)DM * DM * 2;
constexpr size_t OFF_WGU = OFF_WFOUT + (size_t)DM * DM * 2;
constexpr size_t OFF_WD = OFF_WGU + (size_t)2 * NE * 4096 * DM * 2;
constexpr size_t OFF_H = OFF_WD + (size_t)2 * NE * DM * FF * 2;
constexpr size_t OFF_X1 = OFF_H + (size_t)NKEY * DM * 2;
constexpr size_t OFF_X2 = OFF_X1 + (size_t)NTOK * DM * 4;
constexpr size_t OFF_AFF = OFF_X2 + (size_t)NTOK * DM * 4;
constexpr size_t OFF_IDX = OFF_AFF + (size_t)NE * NTOK * 4;
constexpr size_t OFF_GATE = OFF_IDX + (size_t)NE * CAP * 4;
constexpr size_t OFF_SLOT = OFF_GATE + (size_t)NE * CAP * 4;
constexpr size_t OFF_ACT = OFF_SLOT + (size_t)NTOK * NE * 4;
constexpr size_t OFF_YE = OFF_ACT + (size_t)NE * CAP * FF * 2;
constexpr size_t OFF_OCAT = OFF_YE + (size_t)NE * CAP * DM * 2;
constexpr size_t OFF_CQ = OFF_OCAT + (size_t)NTOK * DM * 2;
constexpr size_t OFF_CKV = OFF_CQ + (size_t)NTOK * 512 * 2;
constexpr size_t OFF_PSQ = OFF_CKV + (size_t)NKEY * 256 * 2;
constexpr size_t OFF_KR = OFF_PSQ + al256((size_t)NKEY * 24 * 4);
constexpr size_t OFF_QNA = OFF_KR + (size_t)NKEY * 64 * 2;
constexpr size_t OFF_KNA = OFF_QNA + (size_t)NH * NTOK * 128 * 2;
constexpr size_t OFF_VNA = OFF_KNA + (size_t)NH * NKEY * 128 * 2;
constexpr size_t OFF_Q = OFF_VNA + (size_t)NH * NKEY * 128 * 2;
constexpr size_t OFF_KN = OFF_Q + (size_t)NH * NTOK * 192 * 2;
constexpr size_t OFF_V = OFF_KN + (size_t)NH * NKEY * 128 * 2;
constexpr size_t WS_END = OFF_V + (size_t)NH * NKEY * 128 * 2;

struct Params {
    const float *x, *c, *ctx, *c_ctx, *ada_w, *ada_b, *g_mix, *g_ffn, *g_final, *w_in, *g_qn, *w_uq, *g_kvn, *w_ukv,
        *na_bias, *w_out_attn, *w_out_fourier, *w_router, *w_gate, *w_up, *w_down;
    float* out;
    char* ws;
};

__device__ __forceinline__ unsigned cvtpk(float lo, float hi) {
    unsigned r; asm volatile("v_cvt_pk_bf16_f32 %0, %1, %2" : "=v"(r) : "v"(lo), "v"(hi)); return r;
}
__device__ __forceinline__ float bf2f(bf16_t b) { return __uint_as_float(((unsigned)b) << 16); }
__device__ __forceinline__ bf16_t f2bf(float f) { return (bf16_t)(cvtpk(f, 0.f) & 0xffffu); }
__device__ __forceinline__ float wave_sum(float v) {
#pragma unroll
    for (int o = 32; o > 0; o >>= 1) v += __shfl_xor(v, o, 64);
    return v;
}
extern __shared__ __attribute__((aligned(16))) char g_smem[];
constexpr int LDS_STAGE = 131072, LDS_XBW = LDS_STAGE, LDS_WTAB = LDS_STAGE + 16, LDS_BYTES = LDS_STAGE + 16 + 256;
__device__ __forceinline__ unsigned hw_slot() { return (unsigned)__builtin_amdgcn_s_getreg((5 << 11) | 4) & 63u; }
__device__ __forceinline__ void ltid_init() { const int t = threadIdx.x; if ((t & 63) == 0) ((volatile int*)(g_smem + LDS_WTAB))[hw_slot()] = t >> 6; __syncthreads(); }
__device__ __forceinline__ int ltid() {
    int w = ((volatile int*)(g_smem + LDS_WTAB))[hw_slot()];
    w = __builtin_amdgcn_readfirstlane(w);
    const int lane = __builtin_amdgcn_mbcnt_hi(~0u, __builtin_amdgcn_mbcnt_lo(~0u, 0u));
    int t = w * 64 + lane; asm volatile("" : "+v"(t)); return t;
}
__device__ __forceinline__ int lbid() { int t = blockIdx.x; asm volatile("" : "+s"(t)); return t; }
__device__ __forceinline__ float siluf(float v) { return v / (1.f + __expf(-v)); }

#define XB_TMO      128
#define XB_XCNT(j)  (256  + 64 * (j))
#define XB_XSUB(j)  (1280 + 64 * (j))
#define XB_XGEN(j)  (2304 + 64 * (j))
#define XB_TOP      3328
#define XB_TOPGEN   3392
#define XCD_BAR_WORDS 3456
#define XB_SPIN_CAP (1u << 18)
__device__ __forceinline__ unsigned xb_ld(unsigned* p)              { return __hip_atomic_load(p, __ATOMIC_RELAXED, __HIP_MEMORY_SCOPE_AGENT); }
__device__ __forceinline__ unsigned xb_add(unsigned* p, unsigned v) { return __hip_atomic_fetch_add(p, v, __ATOMIC_RELAXED, __HIP_MEMORY_SCOPE_AGENT); }
__device__ __forceinline__ unsigned xb_xcc_id() { return (unsigned)__builtin_amdgcn_s_getreg((3 << 11) | 20) & 0xFu; }
#define XB_SPIN(cond, bar) do { unsigned _sp = 0; while (cond) { __builtin_amdgcn_s_sleep(1); \
    if ((++_sp & 255u) == 0u) { if (xb_ld(&(bar)[XB_TMO])) break; if (_sp > XB_SPIN_CAP) { atomicAdd(&(bar)[XB_TMO], 1u); break; } } } } while (0)
struct XcdBarrier { unsigned* bar; unsigned x; volatile LAS unsigned* st; };
__device__ __forceinline__ XcdBarrier xcd_barrier_post(unsigned* bar, volatile LAS unsigned* st) {
    XcdBarrier b; b.bar = bar; b.x = xb_xcc_id(); b.st = st;
    if (ltid() == 0) (void)xb_add(&bar[XB_XCNT(b.x)], 1u);
    return b;
}
__device__ __forceinline__ void xcd_barrier_complete(unsigned* bar, unsigned x, unsigned& nloc, unsigned& nx) {
    const unsigned G = gridDim.x * gridDim.y * gridDim.z;
    unsigned sum, cnt, mine, sp = 0u;
    for (;;) {
        sum = 0u; cnt = 0u; mine = 0u;
#pragma unroll
        for (unsigned j = 0; j < 16; ++j) { const unsigned c = xb_ld(&bar[XB_XCNT(j)]); sum += c; cnt += (c > 0u) ? 1u : 0u; mine = (j == x) ? c : mine; }
        if (sum == G) break;
        __builtin_amdgcn_s_sleep(1);
        if ((++sp & 255u) == 0u) { if (xb_ld(&bar[XB_TMO])) break; if (sp > XB_SPIN_CAP) { atomicAdd(&bar[XB_TMO], 1u); break; } }
    }
    nloc = mine > 0u ? mine : 1u; nx = cnt > 0u ? cnt : 1u;
}
__device__ __forceinline__ void xcd_barrier(const XcdBarrier& b) {
    asm volatile("s_waitcnt vmcnt(0)" ::: "memory");
    __syncthreads();
    if (ltid() == 0) {
        unsigned* bar = b.bar;
        __builtin_amdgcn_s_waitcnt(0);
        unsigned nloc = b.st[0], nx = b.st[1];
        if (nloc == 0u) { xcd_barrier_complete(bar, b.x, nloc, nx); b.st[0] = nloc; b.st[1] = nx; }
        const unsigned old = xb_add(&bar[XB_XSUB(b.x)], 1u);
        const unsigned gen = old / nloc;
        if (old + 1u == (gen + 1u) * nloc) {
            __builtin_amdgcn_fence(__ATOMIC_RELEASE, "agent");
            asm volatile("s_waitcnt vmcnt(0)" ::: "memory");
            const unsigned og = xb_add(&bar[XB_TOP], 1u);
            const unsigned tg = og / nx;
            if (og + 1u == (tg + 1u) * nx) xb_add(&bar[XB_TOPGEN], 1u);
            else XB_SPIN(xb_ld(&bar[XB_TOPGEN]) == tg, bar);
            __builtin_amdgcn_fence(__ATOMIC_ACQUIRE, "agent");
            xb_add(&bar[XB_XGEN(b.x)], 1u);
            asm volatile("s_waitcnt vmcnt(0)" ::: "memory");
        } else {
            XB_SPIN(xb_ld(&bar[XB_XGEN(b.x)]) == gen, bar);
            __builtin_amdgcn_fence(__ATOMIC_ACQUIRE, "agent");
            asm volatile("s_waitcnt vmcnt(0)" ::: "memory");
        }
    }
    __syncthreads();
}

namespace pg8 {
constexpr int BM = 256, BK = 64, HALF = 128, HTB = HALF * BK * 2, STAGE_BYTES = 8 * HTB, NXCD = 8, WGM = 8;
__host__ __device__ __forceinline__ int lds_byte(int r, int c) { const int st = (r >> 4) * 2 + (c >> 5), rr = r & 15, cc = c & 31, ob = rr * 64 + cc * 2; return st * 1024 + (ob ^ (((ob >> 9) & 1) << 5)); }
__host__ __device__ __forceinline__ void stage_rc(int b, int& R, int& C) { const int st = b / 1024, sb = b % 1024, swz = sb ^ (((sb >> 9) & 1) << 5); R = (st >> 1) * 16 + swz / 64; C = (st & 1) * 32 + (swz % 64) / 2; }
__host__ __device__ __forceinline__ int perm32(int rho) { const int n = rho >> 4, i = rho & 15; return 8 * (i >> 2) + 4 * n + (i & 3); }
struct Unit { int pm, pn; };
struct StaticOrder {
    int nM, nN, nwg, G, c;
    __device__ void init(int nM_, int nN_, int G_, int c_) { nM = nM_; nN = nN_; nwg = nM * nN; G = G_; c = c_; }
    __device__ bool next(int i, Unit& u) const {
        const long L = (long)i * G + c; if (L >= nwg) return false;
        int wgid = (int)L; { const int q = nwg / NXCD, r = nwg % NXCD, xcd = wgid % NXCD, off = wgid / NXCD; wgid = (xcd < r ? xcd * (q + 1) : r * (q + 1) + (xcd - r) * q) + off; }
        const int nig = WGM * nN, gid = wgid / nig, fm = gid * WGM, gsz = (nM - fm) < WGM ? (nM - fm) : WGM;
        u.pm = fm + ((wgid % nig) % gsz); u.pn = (wgid % nig) / gsz; return true;
    }
};

template <class Desc, class Epi>
__device__ __forceinline__ void gemm_phase(LAS unsigned char* lds, const Desc& D, const StaticOrder& S, const Epi& E) {
    const int tid = ltid(), wid = __builtin_amdgcn_readfirstlane(tid >> 6), lane = tid & 63, wr = wid >> 2, wc = wid & 3, fr = lane & 15, fq = lane >> 4;
    const int K = D.K, nt = K / BK;
    int sR[2], sC[2];
    unsigned voffA[2][2], voffB[2][2], nvA[2][2];
#pragma unroll
    for (int i = 0; i < 2; ++i) { stage_rc(tid * 16 + i * 8192, sR[i], sC[i]);
        const int Rb = Epi::PERM ? ((sR[i] & ~31) + perm32(sR[i] & 31)) : sR[i];
#pragma unroll
        for (int h = 0; h < 2; ++h) { voffA[h][i] = D.arow(sR[i] + HALF * h) + (unsigned)sC[i] * 2u; voffB[h][i] = D.brow(Rb + HALF * h) + (unsigned)sC[i] * 2u; nvA[h][i] = voffA[h][i]; } }
    const size_t kstep = (size_t)(BK * 2);
    const unsigned ldsw = (unsigned)wid * 1024u;
    const int aoff = lds_byte(wr * 64 + fr, fq * 8), boff = lds_byte(wc * 32 + fr, fq * 8);
#define PG8_SA(b, h) (((b) * 2 + (h)) * HTB)
#define PG8_SB(b, h) ((4 + (b) * 2 + (h)) * HTB)
#define PG8_STAGE(bufoff, gbase, voff) do { _Pragma("unroll") for (int _i = 0; _i < 2; ++_i) \
        __builtin_amdgcn_global_load_lds((const unsigned*)((const char*)(gbase) + (voff)[_i]), (LAS unsigned*)(lds + (bufoff) + ldsw + _i * 8192), 16, 0, 0); } while (0)
#define PG8_LDA(dst, b, h) do { _Pragma("unroll") for (int m = 0; m < 4; ++m) _Pragma("unroll") for (int k = 0; k < 2; ++k) dst[m][k] = *(const LAS bf16x8*)(lds + PG8_SA(b, h) + aoff + m * 2048 + k * 1024); } while (0)
#define PG8_LDB(dst, b, h) do { _Pragma("unroll") for (int n = 0; n < 2; ++n) _Pragma("unroll") for (int k = 0; k < 2; ++k) dst[n][k] = *(const LAS bf16x8*)(lds + PG8_SB(b, h) + boff + n * 2048 + k * 1024); } while (0)
#define PG8_MMA(ai, bj, At, Bt) do { __builtin_amdgcn_s_setprio(1); _Pragma("unroll") for (int m = 0; m < 4; ++m) _Pragma("unroll") for (int n = 0; n < 2; ++n) _Pragma("unroll") for (int k = 0; k < 2; ++k) \
        acc[ai][bj][m][n] = __builtin_amdgcn_mfma_f32_16x16x32_bf16(Bt[n][k], At[m][k], acc[ai][bj][m][n], 0, 0, 0); __builtin_amdgcn_s_setprio(0); } while (0)
#define PG8_WAIT_V(n) asm volatile("s_waitcnt vmcnt(" #n ")" ::: "memory")
#define PG8_WAIT_L(n) asm volatile("s_waitcnt lgkmcnt(" #n ")" ::: "memory")
#define PG8_BAR __builtin_amdgcn_s_barrier()
#define PG8_SCHED __builtin_amdgcn_sched_barrier(0)
    Unit cur, nxt; int ui = 0;
    if (!S.next(0, cur)) return;
    f32x4 acc[2][2][4][2];
#pragma unroll
    for (int a = 0; a < 2; ++a)
#pragma unroll
        for (int b = 0; b < 2; ++b)
#pragma unroll
            for (int m = 0; m < 4; ++m)
#pragma unroll
                for (int n = 0; n < 2; ++n) acc[a][b][m][n] = (f32x4){0.f, 0.f, 0.f, 0.f};
    bf16x8 At[4][2], B0[2][2], B1[2][2];
    if constexpr (Desc::GATHER) {
#pragma unroll
        for (int i = 0; i < 2; ++i)
#pragma unroll
            for (int h = 0; h < 2; ++h) { voffA[h][i] = D.agather(cur, sR[i] + HALF * h) + (unsigned)sC[i] * 2u; nvA[h][i] = voffA[h][i]; }
    }
    const char* cA = D.A + D.abase(cur); const char* cB = D.B + D.bbase(cur);
    PG8_STAGE(PG8_SB(0, 0), cB, voffB[0]); PG8_STAGE(PG8_SA(0, 0), cA, voffA[0]); PG8_STAGE(PG8_SB(0, 1), cB, voffB[1]); PG8_STAGE(PG8_SA(0, 1), cA, voffA[1]);
    if (wr == 1) PG8_BAR;
    PG8_WAIT_V(4); PG8_BAR;
    PG8_STAGE(PG8_SB(1, 0), cB + kstep, voffB[0]); PG8_STAGE(PG8_SA(1, 0), cA + kstep, voffA[0]); PG8_STAGE(PG8_SB(1, 1), cB + kstep, voffB[1]);
    PG8_WAIT_V(6); PG8_BAR;
    for (;;) {
        const bool has_next = S.next(ui + 1, nxt);
        const char* nA = has_next ? D.A + D.abase(nxt) : cA; const char* nB = has_next ? D.B + D.bbase(nxt) : cB;
        for (int t = 0; t < nt; t += 2) {
            const bool last = (t == nt - 2);
            const char* a1 = cA + (size_t)(t + 1) * kstep;
            const char* a2 = last ? nA : cA + (size_t)(t + 2) * kstep; const char* b2 = last ? nB : cB + (size_t)(t + 2) * kstep;
            const char* a3 = a2 + kstep; const char* b3 = b2 + kstep;
            if constexpr (Desc::GATHER) {
                if (last && has_next) {
#pragma unroll
                    for (int i = 0; i < 2; ++i)
#pragma unroll
                        for (int h = 0; h < 2; ++h) nvA[h][i] = D.agather(nxt, sR[i] + HALF * h) + (unsigned)sC[i] * 2u;
                }
            }
            unsigned va2[2][2];
#pragma unroll
            for (int i = 0; i < 2; ++i)
#pragma unroll
                for (int h = 0; h < 2; ++h) va2[h][i] = (Desc::GATHER && last) ? nvA[h][i] : voffA[h][i];
            PG8_LDB(B0, 0, 0); PG8_SCHED; PG8_LDA(At, 0, 0); PG8_STAGE(PG8_SA(1, 1), a1, voffA[1]);
            PG8_WAIT_L(8); PG8_BAR; PG8_WAIT_L(0); PG8_MMA(0, 0, At, B0); PG8_BAR; PG8_SCHED;
            PG8_LDB(B1, 0, 1); PG8_STAGE(PG8_SB(0, 0), b2, voffB[0]);
            PG8_BAR; PG8_WAIT_L(0); PG8_MMA(0, 1, At, B1); PG8_BAR;
            PG8_LDA(At, 0, 1); PG8_STAGE(PG8_SA(0, 0), a2, va2[0]);
            PG8_BAR; PG8_WAIT_L(0); PG8_MMA(1, 0, At, B0); PG8_BAR; PG8_SCHED;
            PG8_STAGE(PG8_SB(0, 1), b2, voffB[1]);
            PG8_WAIT_V(6); PG8_BAR; PG8_MMA(1, 1, At, B1); PG8_BAR;
            PG8_LDB(B0, 1, 0); PG8_SCHED; PG8_LDA(At, 1, 0); PG8_STAGE(PG8_SA(0, 1), a2, va2[1]);
            PG8_WAIT_L(8); PG8_BAR; PG8_WAIT_L(0); PG8_MMA(0, 0, At, B0); PG8_BAR; PG8_SCHED;
            PG8_LDB(B1, 1, 1); PG8_STAGE(PG8_SB(1, 0), b3, voffB[0]);
            PG8_BAR; PG8_WAIT_L(0); PG8_MMA(0, 1, At, B1); PG8_BAR;
            PG8_LDA(At, 1, 1); PG8_STAGE(PG8_SA(1, 0), a3, va2[0]);
            PG8_BAR; PG8_WAIT_L(0); PG8_MMA(1, 0, At, B0); PG8_BAR; PG8_SCHED;
            PG8_STAGE(PG8_SB(1, 1), b3, voffB[1]);
            PG8_WAIT_V(6); PG8_BAR; PG8_MMA(1, 1, At, B1); PG8_BAR;
        }
        E(acc, cur, wr, wc, fr, fq);
        if (!has_next) break;
#pragma unroll
        for (int a = 0; a < 2; ++a)
#pragma unroll
            for (int b = 0; b < 2; ++b)
#pragma unroll
                for (int m = 0; m < 4; ++m)
#pragma unroll
                    for (int n = 0; n < 2; ++n) acc[a][b][m][n] = (f32x4){0.f, 0.f, 0.f, 0.f};
        cur = nxt; cA = nA; cB = nB; ++ui;
        if constexpr (Desc::GATHER) {
#pragma unroll
            for (int i = 0; i < 2; ++i)
#pragma unroll
                for (int h = 0; h < 2; ++h) voffA[h][i] = nvA[h][i];
        }
    }
    PG8_WAIT_V(0);
    if (wr == 0) PG8_BAR;
    PG8_BAR;
#undef PG8_SA
#undef PG8_SB
#undef PG8_STAGE
#undef PG8_LDA
#undef PG8_LDB
#undef PG8_MMA
#undef PG8_WAIT_V
#undef PG8_WAIT_L
#undef PG8_BAR
#undef PG8_SCHED
}
}
using pg8::Unit;

struct DescPlain {
    static constexpr bool GATHER = false;
    const char* A; const char* B; int K; int lda, ldb;
    __device__ __forceinline__ size_t abase(const Unit& u) const { return (size_t)u.pm * 256 * lda * 2; }
    __device__ __forceinline__ size_t bbase(const Unit& u) const { return (size_t)u.pn * 256 * ldb * 2; }
    __device__ __forceinline__ unsigned arow(int r) const { return (unsigned)(r * lda) * 2u; }
    __device__ __forceinline__ unsigned brow(int r) const { return (unsigned)(r * ldb) * 2u; }
    __device__ __forceinline__ unsigned agather(const Unit&, int) const { return 0u; }
};
struct DescMoe1 {
    static constexpr bool GATHER = true;
    const char* A; const char* B; int K; const int* idx;
    __device__ __forceinline__ size_t abase(const Unit&) const { return 0; }
    __device__ __forceinline__ size_t bbase(const Unit& u) const { return ((size_t)(u.pm >> 3) * 4096 + (size_t)u.pn * 256) * DM * 2; }
    __device__ __forceinline__ unsigned arow(int) const { return 0u; }
    __device__ __forceinline__ unsigned brow(int r) const { return (unsigned)(r * DM) * 2u; }
    __device__ __forceinline__ unsigned agather(const Unit& u, int r) const { return (unsigned)idx[u.pm * 256 + r] * (unsigned)(DM * 2); }
};
struct DescMoe2 {
    static constexpr bool GATHER = false;
    const char* A; const char* B; int K;
    __device__ __forceinline__ size_t abase(const Unit& u) const { return (size_t)u.pm * 256 * FF * 2; }
    __device__ __forceinline__ size_t bbase(const Unit& u) const { return ((size_t)(u.pm >> 3) * 2048 + (size_t)u.pn * 256) * FF * 2; }
    __device__ __forceinline__ unsigned arow(int r) const { return (unsigned)(r * FF) * 2u; }
    __device__ __forceinline__ unsigned brow(int r) const { return (unsigned)(r * FF) * 2u; }
    __device__ __forceinline__ unsigned agather(const Unit&, int) const { return 0u; }
};
struct DescF1 {
    static constexpr bool GATHER = false;
    const char* A; const char* B; int K;
    __device__ __forceinline__ size_t abase(const Unit& u) const { return (size_t)u.pm * 256 * 256 * 2; }
    __device__ __forceinline__ size_t bbase(const Unit& u) const { const int g = u.pn >> 6, pp = u.pn & 63; return ((size_t)(2 * pp) * DM + (size_t)g * 256) * 2; }
    __device__ __forceinline__ unsigned arow(int r) const { return (unsigned)(r * 256) * 2u; }
    __device__ __forceinline__ unsigned brow(int r) const { return (unsigned)((128 * (r & 127) + (r >> 7)) * DM) * 2u; }
    __device__ __forceinline__ unsigned agather(const Unit&, int) const { return 0u; }
};

__device__ __forceinline__ u32x4 pack8(const f32x4& a, const f32x4& b, float s) {
    u32x4 w; w.x = cvtpk(a[0] * s, a[1] * s); w.y = cvtpk(a[2] * s, a[3] * s); w.z = cvtpk(b[0] * s, b[1] * s); w.w = cvtpk(b[2] * s, b[3] * s); return w;
}
struct EpiInproj {
    static constexpr bool PERM = true;
    bf16_t *cq, *ckv, *kr, *qna, *kna, *vna; float* psq; const float* rope;
    __device__ __forceinline__ void operator()(const f32x4 (&acc)[2][2][4][2], const Unit& u, int wr, int wc, int fr, int fq) const {
        const int pn = u.pn;
#pragma unroll
        for (int ai = 0; ai < 2; ++ai)
#pragma unroll
            for (int m = 0; m < 4; ++m) {
                const int row = u.pm * 256 + ai * 128 + wr * 64 + m * 16 + fr;
                const bool lat = row >= NCTX;
#pragma unroll
                for (int bj = 0; bj < 2; ++bj) {
                    const f32x4 v0 = acc[ai][bj][m][0], v1 = acc[ai][bj][m][1];
                    const int cl = bj * 128 + wc * 32 + fq * 8;
                    if (pn <= 2) {
                        float ss = v0[0] * v0[0] + v0[1] * v0[1] + v0[2] * v0[2] + v0[3] * v0[3] + v1[0] * v1[0] + v1[1] * v1[1] + v1[2] * v1[2] + v1[3] * v1[3];
                        ss += __shfl_xor(ss, 16, 64); ss += __shfl_xor(ss, 32, 64);
                        if (fq == 0) psq[(size_t)row * 24 + pn * 8 + bj * 4 + wc] = ss;
                        if (pn < 2) { if (lat) *(u32x4*)(cq + (size_t)(row - NCTX) * 512 + pn * 256 + cl) = pack8(v0, v1, 1.f); }
                        else *(u32x4*)(ckv + (size_t)row * 256 + cl) = pack8(v0, v1, 1.f);
                    } else if (pn <= 6) {
                        const int h = 2 * (pn - 3) + bj, d = wc * 32 + fq * 8;
                        if (lat) *(u32x4*)(qna + ((size_t)h * NTOK + (row - NCTX)) * 128 + d) = pack8(v0, v1, NA_QS);
                    } else if (pn <= 10) {
                        const int h = 2 * (pn - 7) + bj, d = wc * 32 + fq * 8;
                        *(u32x4*)(kna + ((size_t)h * NKEY + row) * 128 + d) = pack8(v0, v1, 1.f);
                    } else if (pn <= 14) {
                        const int h = 2 * (pn - 11) + bj, d = wc * 32 + fq * 8;
                        *(u32x4*)(vna + ((size_t)h * NKEY + row) * 128 + d) = pack8(v0, v1, 1.f);
                    } else if (bj == 0 && wc < 2) {
                        f32x4 o0 = v0, o1 = v1;
                        if (lat) {
                            const int n = row - NCTX, pos = wc == 0 ? (n >> 6) : (n & 63);
                            const f32x4 cs0 = *(const f32x4*)(rope + (pos * 16 + fq * 4) * 2), cs1 = *(const f32x4*)(rope + (pos * 16 + fq * 4 + 2) * 2);
                            o0[0] = v0[0] * cs0[0] - v0[1] * cs0[1]; o0[1] = v0[1] * cs0[0] + v0[0] * cs0[1];
                            o0[2] = v0[2] * cs0[2] - v0[3] * cs0[3]; o0[3] = v0[3] * cs0[2] + v0[2] * cs0[3];
                            o1[0] = v1[0] * cs1[0] - v1[1] * cs1[1]; o1[1] = v1[1] * cs1[0] + v1[0] * cs1[1];
                            o1[2] = v1[2] * cs1[2] - v1[3] * cs1[3]; o1[3] = v1[3] * cs1[2] + v1[2] * cs1[3];
                        }
                        *(u32x4*)(kr + (size_t)row * 64 + wc * 32 + fq * 8) = pack8(o0, o1, 1.f);
                    }
                }
            }
    }
};
__device__ __forceinline__ float rstd_from_psq(const float* p, int cnt, float inv_n) {
    float s = 0.f;
    for (int i = 0; i < cnt; i += 4) { const f32x4 v = *(const f32x4*)(p + i); s += v[0] + v[1] + v[2] + v[3]; }
    return rsqrtf(s * inv_n + EPS);
}
struct EpiUq {
    static constexpr bool PERM = true;
    bf16_t* q; const float* psq; const float* rope;
    __device__ __forceinline__ void operator()(const f32x4 (&acc)[2][2][4][2], const Unit& u, int wr, int wc, int fr, int fq) const {
        const int pn = u.pn;
#pragma unroll
        for (int ai = 0; ai < 2; ++ai)
#pragma unroll
            for (int m = 0; m < 4; ++m) {
                const int row = u.pm * 256 + ai * 128 + wr * 64 + m * 16 + fr;
                const float rs = rstd_from_psq(psq + (size_t)(row + NCTX) * 24, 16, 1.f / 512.f);
#pragma unroll
                for (int bj = 0; bj < 2; ++bj) {
                    const f32x4 v0 = acc[ai][bj][m][0] * rs, v1 = acc[ai][bj][m][1] * rs;
                    if (pn < 4) {
                        const int h = 2 * pn + bj, d = wc * 32 + fq * 8;
                        *(u32x4*)(q + ((size_t)h * NTOK + row) * 192 + d) = pack8(v0, v1, MLA_QS);
                    } else {
                        const int h = 4 * (pn - 4) + 2 * bj + (wc >> 1), ax = wc & 1;
                        const int pos = ax == 0 ? (row >> 6) : (row & 63);
                        const f32x4 cs0 = *(const f32x4*)(rope + (pos * 16 + fq * 4) * 2), cs1 = *(const f32x4*)(rope + (pos * 16 + fq * 4 + 2) * 2);
                        f32x4 o0, o1;
                        o0[0] = v0[0] * cs0[0] - v0[1] * cs0[1]; o0[1] = v0[1] * cs0[0] + v0[0] * cs0[1];
                        o0[2] = v0[2] * cs0[2] - v0[3] * cs0[3]; o0[3] = v0[3] * cs0[2] + v0[2] * cs0[3];
                        o1[0] = v1[0] * cs1[0] - v1[1] * cs1[1]; o1[1] = v1[1] * cs1[0] + v1[0] * cs1[1];
                        o1[2] = v1[2] * cs1[2] - v1[3] * cs1[3]; o1[3] = v1[3] * cs1[2] + v1[2] * cs1[3];
                        *(u32x4*)(q + ((size_t)h * NTOK + row) * 192 + 128 + ax * 32 + fq * 8) = pack8(o0, o1, MLA_QS);
                    }
                }
            }
    }
};
struct EpiUkv {
    static constexpr bool PERM = true;
    bf16_t *kn, *v; const float* psq;
    __device__ __forceinline__ void operator()(const f32x4 (&acc)[2][2][4][2], const Unit& u, int wr, int wc, int fr, int fq) const {
        const int pn = u.pn;
#pragma unroll
        for (int ai = 0; ai < 2; ++ai)
#pragma unroll
            for (int m = 0; m < 4; ++m) {
                const int row = u.pm * 256 + ai * 128 + wr * 64 + m * 16 + fr;
                const float rs = rstd_from_psq(psq + (size_t)row * 24 + 16, 8, 1.f / 256.f);
#pragma unroll
                for (int bj = 0; bj < 2; ++bj) {
                    const int h = 2 * (pn & 3) + bj, d = wc * 32 + fq * 8;
                    bf16_t* dst = (pn < 4 ? kn : v) + ((size_t)h * NKEY + row) * 128 + d;
                    *(u32x4*)dst = pack8(acc[ai][bj][m][0], acc[ai][bj][m][1], rs);
                }
            }
    }
};
struct EpiResid {
    static constexpr bool PERM = false;
    float* out; const float* base; const float* gate;
    __device__ __forceinline__ void operator()(const f32x4 (&acc)[2][2][4][2], const Unit& u, int wr, int wc, int fr, int fq) const {
        const int row0 = u.pm * 256 + wr * 64 + fr, col0 = u.pn * 256 + wc * 32 + 4 * fq;
        f32x4 gv[2][2];
#pragma unroll
        for (int bj = 0; bj < 2; ++bj)
#pragma unroll
            for (int n = 0; n < 2; ++n) gv[bj][n] = *(const f32x4*)(gate + col0 + bj * 128 + n * 16);
#pragma unroll
        for (int ai = 0; ai < 2; ++ai)
#pragma unroll
            for (int m = 0; m < 4; ++m) { const size_t ro = (size_t)(row0 + ai * 128 + m * 16) * DM + col0;
#pragma unroll
                for (int bj = 0; bj < 2; ++bj)
#pragma unroll
                    for (int n = 0; n < 2; ++n) { const f32x4 b = *(const f32x4*)(base + ro + bj * 128 + n * 16);
                        *(f32x4*)(out + ro + bj * 128 + n * 16) = b + gv[bj][n] * acc[ai][bj][m][n]; } }
    }
};
struct EpiMoe1 {
    static constexpr bool PERM = true;
    bf16_t* act;
    __device__ __forceinline__ void operator()(const f32x4 (&acc)[2][2][4][2], const Unit& u, int wr, int wc, int fr, int fq) const {
#pragma unroll
        for (int ai = 0; ai < 2; ++ai)
#pragma unroll
            for (int m = 0; m < 4; ++m) {
                const int row = u.pm * 256 + ai * 128 + wr * 64 + m * 16 + fr;
                f32x4 o[2];
#pragma unroll
                for (int n = 0; n < 2; ++n)
#pragma unroll
                    for (int j = 0; j < 4; ++j) { const float g = acc[ai][0][m][n][j], up = acc[ai][1][m][n][j];
                        o[n][j] = g * up * __builtin_amdgcn_rcpf(1.f + __builtin_amdgcn_exp2f(-g * LOG2E)); }
                *(u32x4*)(act + (size_t)row * FF + u.pn * 128 + wc * 32 + fq * 8) = pack8(o[0], o[1], 1.f);
            }
    }
};
struct EpiMoe2 {
    static constexpr bool PERM = true;
    bf16_t* ye; const float* gate;
    __device__ __forceinline__ void operator()(const f32x4 (&acc)[2][2][4][2], const Unit& u, int wr, int wc, int fr, int fq) const {
#pragma unroll
        for (int ai = 0; ai < 2; ++ai)
#pragma unroll
            for (int m = 0; m < 4; ++m) {
                const int row = u.pm * 256 + ai * 128 + wr * 64 + m * 16 + fr;
                const float g = gate[row];
#pragma unroll
                for (int bj = 0; bj < 2; ++bj)
                    *(u32x4*)(ye + (size_t)row * DM + u.pn * 256 + bj * 128 + wc * 32 + fq * 8) = pack8(acc[ai][bj][m][0], acc[ai][bj][m][1], g);
            }
    }
};
struct EpiF1 {
    static constexpr bool PERM = true;
    bf16_t* g1;
    __device__ __forceinline__ void operator()(const f32x4 (&acc)[2][2][4][2], const Unit& u, int wr, int wc, int fr, int fq) const {
        const int g = u.pn >> 6, pp = u.pn & 63, ri = u.pm;
#pragma unroll
        for (int ai = 0; ai < 2; ++ai)
#pragma unroll
            for (int m = 0; m < 4; ++m) {
                const int mm = ai * 128 + wr * 64 + m * 16 + fr;
#pragma unroll
                for (int bj = 0; bj < 2; ++bj) { const int b = 2 * pp + bj;
                    *(u32x4*)(g1 + ((((size_t)(g * 256 + mm) * 128 + b) * 2 + ri) * 128) + wc * 32 + fq * 8) = pack8(acc[ai][bj][m][0], acc[ai][bj][m][1], 1.f); }
            }
    }
};
struct EpiF2A {
    static constexpr bool PERM = true;
    bf16_t* tp; const float* tw;
    __device__ __forceinline__ void operator()(const f32x4 (&acc)[2][2][4][2], const Unit& u, int wr, int wc, int fr, int fq) const {
#pragma unroll
        for (int m = 0; m < 4; ++m) {
            const int k1 = wr * 64 + m * 16 + fr, b0 = wc * 32 + fq * 8;
            const float* t = tw + ((size_t)k1 * 128 + b0) * 2;
            f32x4 cs[4];
#pragma unroll
            for (int j = 0; j < 4; ++j) cs[j] = *(const f32x4*)(t + 4 * j);
#pragma unroll
            for (int bj = 0; bj < 2; ++bj) {
                const int gm = 2 * u.pn + bj;
                f32x4 r0, r1, i0, i1;
#pragma unroll
                for (int j = 0; j < 4; ++j) {
                    const float c_a = cs[j >> 1][(j & 1) * 2], s_a = cs[j >> 1][(j & 1) * 2 + 1];
                    const float c_b = cs[2 + (j >> 1)][(j & 1) * 2], s_b = cs[2 + (j >> 1)][(j & 1) * 2 + 1];
                    const float tr0 = acc[0][bj][m][0][j], ti0 = acc[1][bj][m][0][j], tr1 = acc[0][bj][m][1][j], ti1 = acc[1][bj][m][1][j];
                    r0[j] = c_a * tr0 + s_a * ti0; i0[j] = c_a * ti0 - s_a * tr0;
                    r1[j] = c_b * tr1 + s_b * ti1; i1[j] = c_b * ti1 - s_b * tr1;
                }
                bf16_t* dst = tp + (((size_t)k1 * 2048 + gm) * 2) * 128 + b0;
                *(u32x4*)dst = pack8(r0, r1, 1.f); *(u32x4*)(dst + 128) = pack8(i0, i1, 1.f);
            }
        }
    }
};
struct EpiF2B {
    static constexpr bool PERM = true;
    bf16_t* f;
    __device__ __forceinline__ void operator()(const f32x4 (&acc)[2][2][4][2], const Unit& u, int wr, int wc, int fr, int fq) const {
        const int k1 = u.pn >> 3;
#pragma unroll
        for (int m = 0; m < 4; ++m) {
            const int k2 = wr * 64 + m * 16 + fr;
#pragma unroll
            for (int bj = 0; bj < 2; ++bj)
                *(u32x4*)(f + (size_t)(k1 + 128 * k2) * DM + (u.pn & 7) * 256 + bj * 128 + wc * 32 + fq * 8) = pack8(acc[0][bj][m][0], acc[0][bj][m][1], 1.f);
        }
    }
};

namespace att {
constexpr int QBLK = 32, KVBLK = 64;
constexpr float THR2 = 11.0f;
#define SBAR() __builtin_amdgcn_sched_barrier(0)
__device__ __forceinline__ int crow(int r, int hi) { return (r & 3) + 8 * (r >> 2) + 4 * hi; }
template <int DQK> __device__ __forceinline__ int kswz(int row, int colB) { return row * (DQK * 2 + 16) + colB; }
__device__ __forceinline__ void partialSM(f32x16& p0, f32x16& p1, float& m_reg, float& mn, float& alpha) {
    float pmax = p0[0];
#pragma unroll
    for (int r = 1; r < 16; ++r) pmax = fmaxf(pmax, p0[r]);
#pragma unroll
    for (int r = 0; r < 16; ++r) pmax = fmaxf(pmax, p1[r]);
    { auto rr = __builtin_amdgcn_permlane32_swap(__float_as_uint(pmax), __float_as_uint(pmax), false, false);
      pmax = fmaxf(__uint_as_float(rr[0]), __uint_as_float(rr[1])); }
    if (__builtin_expect(__all(pmax - m_reg <= THR2), 1)) { mn = m_reg; alpha = 1.f; }
    else { mn = fmaxf(m_reg, pmax); alpha = __builtin_amdgcn_exp2f(m_reg - mn); m_reg = mn; }
#pragma unroll
    for (int r = 0; r < 16; ++r) p0[r] = p0[r] - mn;
#pragma unroll
    for (int r = 0; r < 16; ++r) p1[r] = p1[r] - mn;
#pragma unroll
    for (int r = 0; r < 16; ++r) p0[r] = __builtin_amdgcn_exp2f(p0[r]);
}
__device__ __forceinline__ void finishSM(f32x16& p0, f32x16& p1, float alpha, float& l_reg, bf16x8& pa0, bf16x8& pa1, bf16x8& pa2, bf16x8& pa3) {
#pragma unroll
    for (int r = 0; r < 16; ++r) p1[r] = __builtin_amdgcn_exp2f(p1[r]);
    float ps = 0;
#pragma unroll
    for (int r = 0; r < 16; ++r) ps += p0[r];
#pragma unroll
    for (int r = 0; r < 16; ++r) ps += p1[r];
    { auto rr = __builtin_amdgcn_permlane32_swap(__float_as_uint(ps), __float_as_uint(ps), false, false);
      ps = __uint_as_float(rr[0]) + __uint_as_float(rr[1]); }
    l_reg = l_reg * alpha + ps;
#define PK4(P, BASE, OUT) do { unsigned a0 = cvtpk(P[BASE + 0], P[BASE + 1]), a1 = cvtpk(P[BASE + 2], P[BASE + 3]);   \
    unsigned b0 = cvtpk(P[BASE + 4], P[BASE + 5]), b1 = cvtpk(P[BASE + 6], P[BASE + 7]);                              \
    auto r0 = __builtin_amdgcn_permlane32_swap(a0, b0, false, false); auto r1 = __builtin_amdgcn_permlane32_swap(a1, b1, false, false); \
    u32x4 w = {r0[0], r1[0], r0[1], r1[1]}; OUT = *reinterpret_cast<bf16x8*>(&w); } while (0)
    PK4(p0, 0, pa0); PK4(p0, 8, pa1); PK4(p1, 0, pa2); PK4(p1, 8, pa3);
#undef PK4
}
template <int DQK>
__device__ __forceinline__ void qkt(f32x16& p0, f32x16& p1, const char* Ks, const bf16x8* qr, const char* qx, int r32, int hi) {
    p0 = f32x16{}; p1 = f32x16{};
    const char* kb_ = Ks + r32 * (DQK * 2 + 16) + hi * 16;
#pragma unroll
    for (int d0 = 0; d0 < DQK / 16; ++d0) {
        bf16x8 b0 = *reinterpret_cast<const bf16x8*>(kb_ + d0 * 32);
        bf16x8 b1 = *reinterpret_cast<const bf16x8*>(kb_ + 32 * (DQK * 2 + 16) + d0 * 32);
        const bf16x8 q = d0 < 8 ? qr[d0 < 8 ? d0 : 0] : *reinterpret_cast<const bf16x8*>(qx + (d0 - 8) * 1024);
        p0 = __builtin_amdgcn_mfma_f32_32x32x16_bf16(b0, q, p0, 0, 0, 0);
        p1 = __builtin_amdgcn_mfma_f32_32x32x16_bf16(b1, q, p1, 0, 0, 0); }
}
__device__ __forceinline__ int v_st(int k, int c) { const int kk = (k & ~0xC) | ((k & 4) << 1) | ((k & 8) >> 1); return ((kk >> 3) * 4 + (c >> 5)) * 512 + ((kk & 7) * 32 + (c & 31)) * 2; }
__device__ __forceinline__ int v_rd_base(int lane) { return ((lane & 3) << 3) | (((lane >> 2) & 3) << 6) | (((lane >> 4) & 1) << 5) | (((lane >> 5) & 1) << 8); }
constexpr int v_rd_off(int d0, int ks, int half) { return d0 * 512 + ks * 4096 + half * 2048; }
template <int OFF> __device__ __forceinline__ s16x4 tr_read(int vb) {
    s16x4 r; asm volatile("ds_read_b64_tr_b16 %0, %1 offset:%2" : "=&v"(r) : "v"(vb), "i"(OFF) : "memory"); return r;
}
template <int D0> __device__ __forceinline__ void pv_one(f32x16& od, int vb, bf16x8 pa0, bf16x8 pa1, bf16x8 pa2, bf16x8 pa3) {
    const s16x4 l0 = tr_read<v_rd_off(D0, 0, 0)>(vb), h0 = tr_read<v_rd_off(D0, 0, 1)>(vb), l1 = tr_read<v_rd_off(D0, 1, 0)>(vb), h1 = tr_read<v_rd_off(D0, 1, 1)>(vb);
    const s16x4 l2 = tr_read<v_rd_off(D0, 2, 0)>(vb), h2 = tr_read<v_rd_off(D0, 2, 1)>(vb), l3 = tr_read<v_rd_off(D0, 3, 0)>(vb), h3 = tr_read<v_rd_off(D0, 3, 1)>(vb);
    asm volatile("s_waitcnt lgkmcnt(0)" ::: "memory"); SBAR();
#define PK(L, H) (bf16x8){L[0], L[1], L[2], L[3], H[0], H[1], H[2], H[3]}
    od = __builtin_amdgcn_mfma_f32_32x32x16_bf16(pa0, PK(l0, h0), od, 0, 0, 0);
    od = __builtin_amdgcn_mfma_f32_32x32x16_bf16(pa1, PK(l1, h1), od, 0, 0, 0);
    od = __builtin_amdgcn_mfma_f32_32x32x16_bf16(pa2, PK(l2, h2), od, 0, 0, 0);
    od = __builtin_amdgcn_mfma_f32_32x32x16_bf16(pa3, PK(l3, h3), od, 0, 0, 0);
#undef PK
}
__device__ __forceinline__ void pv_d0(f32x16* o, int vb, bf16x8 pa0, bf16x8 pa1, bf16x8 pa2, bf16x8 pa3) {
    pv_one<0>(o[0], vb, pa0, pa1, pa2, pa3); pv_one<1>(o[1], vb, pa0, pa1, pa2, pa3); pv_one<2>(o[2], vb, pa0, pa1, pa2, pa3); pv_one<3>(o[3], vb, pa0, pa1, pa2, pa3);
}
template <int DQK> struct Lds {
    static constexpr int SHM_V = KVBLK * 128 * 2, SHM_K = KVBLK * (DQK * 2 + 16);
    static constexpr int OFF_K = 2 * SHM_V, OFF_WS = OFF_K + 2 * SHM_K, OFF_BT = OFF_WS + 8 * 64 * 4, OFF_QX = OFF_BT + 640 * 4, TOTAL = OFF_QX + 8 * 4096;
};
struct NaCtx { int u0; int rq; int rs; int cq; int cs; const LAS float* bt; };

template <int DQK, bool NA>
__device__ __forceinline__ void attn_body(const bf16_t* __restrict__ Qb, const bf16_t* __restrict__ Kh, const bf16_t* __restrict__ Krope, const bf16_t* __restrict__ Vh,
                                          bf16_t* __restrict__ Ob, int NT, int u0, int qrow0, const float* __restrict__ bias_h, char* lds) {
    using L = Lds<DQK>;
    constexpr int SHM_V = L::SHM_V, SHM_K = L::SHM_K;
    const int tid = ltid(), wid = tid >> 6, lane = tid & 63, r32 = lane & 31, hi = lane >> 5;
    char* V_lds = lds; char* K_lds = lds + L::OFF_K;
    float* ws = (float*)(lds + L::OFF_WS) + wid * 64; float* li_l = ws; float* al_l = ws + 32;
    float* bt = (float*)(lds + L::OFF_BT);
    __syncthreads();
    if constexpr (NA) { if (tid < 15 * 31) bt[48 + (tid / 31) * 32 + (tid % 31)] = bias_h[tid] * LOG2E; }
    float m_reg = -1e30f, l_reg = 0; f32x16 o[4] = {}; bf16x8 qr[8];
    const bf16_t* Qw = Qb + (size_t)(wid * QBLK + r32) * DQK + hi * 8;
    char* qx = lds + L::OFF_QX + wid * 4096 + lane * 16;
#pragma unroll
    for (int d0 = 0; d0 < 8; ++d0) qr[d0] = *reinterpret_cast<const bf16x8*>(Qw + d0 * 16);
    if constexpr (DQK == 192) {
#pragma unroll
        for (int d0 = 8; d0 < 12; ++d0) *reinterpret_cast<bf16x8*>(qx + (d0 - 8) * 1024) = *reinterpret_cast<const bf16x8*>(Qw + d0 * 16);
    }
    const int sr = tid >> 4, sc = (tid & 15) * 8, vst0 = v_st(sr, sc), vst1 = v_st(32 + sr, sc);
    const int rr_ = tid >> 3, rc_ = (tid & 7) * 8;
    const unsigned offKV = (unsigned)(sr * 128 + sc) * 2u, offR = (unsigned)(rr_ * 64 + rc_) * 2u;
    const int vb0 = (int)(uintptr_t)V_lds + v_rd_base(lane);
    const int rq = NA ? (wid >> 1) : 0;
    const int cq = 32 * (wid & 1) + r32;
    const int cs = cq < 8 ? 0 : (cq > 56 ? 48 : cq - 8);
    constexpr int SD = (DQK == 192) ? 1 : 2, SE = 0, SO = SD - 1;
    struct Slot { bf16x8 vs0, vs1, ks0, ks1, kr; } s_[SD];
    auto keyof = [&](int t) -> int { if constexpr (!NA) return t * KVBLK; else { if (t < 4) return t * KVBLK; int kr = u0 + t - 4; kr = kr > 255 ? 255 : kr; return NCTX + kr * KVBLK; } };
#define SLOAD(i, t) do { const size_t k0_ = (size_t)__builtin_amdgcn_readfirstlane(keyof(t)); const char* vp_ = (const char*)Vh + k0_ * 256; const char* kp_ = (const char*)Kh + k0_ * 256; \
    s_[i].vs0 = *(const bf16x8*)(vp_ + offKV); s_[i].vs1 = *(const bf16x8*)(vp_ + offKV + 8192u); \
    s_[i].ks0 = *(const bf16x8*)(kp_ + offKV); s_[i].ks1 = *(const bf16x8*)(kp_ + offKV + 8192u); \
    if constexpr (DQK == 192) s_[i].kr = *(const bf16x8*)((const char*)Krope + k0_ * 128 + offR); } while (0)
#define SWRITE(b, i) do { *(bf16x8*)(V_lds + (b) * SHM_V + vst0) = s_[i].vs0; *(bf16x8*)(V_lds + (b) * SHM_V + vst1) = s_[i].vs1; \
    *(bf16x8*)(K_lds + (b) * SHM_K + kswz<DQK>(sr, sc * 2)) = s_[i].ks0; *(bf16x8*)(K_lds + (b) * SHM_K + kswz<DQK>(32 + sr, sc * 2)) = s_[i].ks1; \
    if constexpr (DQK == 192) *(bf16x8*)(K_lds + (b) * SHM_K + kswz<DQK>(rr_, 256 + rc_ * 2)) = s_[i].kr; } while (0)
#define SWAIT() do { if constexpr (SD == 1) asm volatile("s_waitcnt vmcnt(0)" ::: "memory"); else asm volatile("s_waitcnt vmcnt(4)" ::: "memory"); } while (0)
#define RESC(a) do { if (__any((a) < 1.f)) { if (hi == 0) al_l[r32] = (a); asm volatile("s_waitcnt lgkmcnt(0)" ::: "memory"); \
    _Pragma("unroll") for (int d = 0; d < 4; ++d) _Pragma("unroll") for (int r = 0; r < 16; ++r) o[d][r] *= al_l[crow(r, hi)]; } } while (0)
#define NAHOOK(P0, P1, t) do { if constexpr (NA) { if ((t) >= 4) { const int kr_ = u0 + (t) - 4; const int rabs = qrow0 + rq; \
        const int rs_ = rabs < 4 ? 0 : (rabs > 252 ? 248 : rabs - 4); const bool tv = (kr_ >= rs_) && (kr_ < rs_ + 8) && (kr_ <= 255); \
        int ro = kr_ - rabs + 7; ro = ro < 0 ? 0 : (ro > 14 ? 14 : ro); \
        const float* bp = bt + 48 + ro * 32 + 15 - cq + 4 * hi; \
        _Pragma("unroll") for (int r = 0; r < 16; ++r) { const int ckc = (r & 3) + 8 * (r >> 2); const int ck0 = ckc + 4 * hi; \
            const bool v0_ = tv && ((unsigned)(ck0 - cs) < 16u), v1_ = tv && ((unsigned)(ck0 + 32 - cs) < 16u); \
            P0[r] = v0_ ? P0[r] + bp[ckc] : -1e30f; P1[r] = v1_ ? P1[r] + bp[ckc + 32] : -1e30f; } } } } while (0)
    f32x16 pA0, pA1, pB0, pB1; float mnA, mnB, alA, alB; bf16x8 pa0, pa1, pa2, pa3;
    SLOAD(SE, 0); asm volatile("s_waitcnt vmcnt(0)" ::: "memory"); SWRITE(0, SE); __syncthreads();
    qkt<DQK>(pA0, pA1, K_lds, qr, qx, r32, hi); partialSM(pA0, pA1, m_reg, mnA, alA);
    SLOAD(SO, 1); if constexpr (SD == 2) { if (2 < NT) SLOAD(SE, 2); }
    SWAIT(); SWRITE(1, SO); __syncthreads();
    for (int j = 1; j + 1 < NT; j += 2) {
        SBAR(); qkt<DQK>(pB0, pB1, K_lds + SHM_K, qr, qx, r32, hi);
        finishSM(pA0, pA1, alA, l_reg, pa0, pa1, pa2, pa3); SBAR();
        SLOAD(SO, j + SD); SBAR();
        pv_d0(o, vb0, pa0, pa1, pa2, pa3); NAHOOK(pB0, pB1, j); partialSM(pB0, pB1, m_reg, mnB, alB);
        __syncthreads(); SWAIT(); SWRITE(0, SE);
        RESC(alB); __syncthreads();
        SBAR(); qkt<DQK>(pA0, pA1, K_lds, qr, qx, r32, hi);
        finishSM(pB0, pB1, alB, l_reg, pa0, pa1, pa2, pa3); SBAR();
        if (SD == 1 || j + 3 < NT) SLOAD(SE, j + 1 + SD); SBAR();
        pv_d0(o, vb0 + SHM_V, pa0, pa1, pa2, pa3); NAHOOK(pA0, pA1, j + 1); partialSM(pA0, pA1, m_reg, mnA, alA);
        __syncthreads(); SWAIT(); SWRITE(1, SO);
        RESC(alA); __syncthreads();
    }
    SBAR(); qkt<DQK>(pB0, pB1, K_lds + SHM_K, qr, qx, r32, hi);
    finishSM(pA0, pA1, alA, l_reg, pa0, pa1, pa2, pa3); SBAR();
    pv_d0(o, vb0, pa0, pa1, pa2, pa3); NAHOOK(pB0, pB1, NT - 1); partialSM(pB0, pB1, m_reg, mnB, alB);
    __syncthreads(); RESC(alB);
    finishSM(pB0, pB1, alB, l_reg, pa0, pa1, pa2, pa3); SBAR();
    pv_d0(o, vb0 + SHM_V, pa0, pa1, pa2, pa3);
    if (hi == 0) li_l[r32] = l_reg; asm volatile("s_waitcnt lgkmcnt(0)" ::: "memory");
    float rli[16];
#pragma unroll
    for (int r = 0; r < 16; ++r) rli[r] = __builtin_amdgcn_rcpf(li_l[crow(r, hi)]);
    bf16_t* Ow = Ob + (size_t)(wid * QBLK) * DM;
#pragma unroll
    for (int r = 0; r < 16; ++r) { const int orow = crow(r, hi);
#pragma unroll
        for (int d0 = 0; d0 < 4; ++d0) Ow[(size_t)orow * DM + d0 * 32 + r32] = f2bf(o[d0][r] * rli[r]); }
#undef SLOAD
#undef SWRITE
#undef SWAIT
#undef RESC
#undef NAHOOK
}
}

#define WSP(T, off) ((T*)(p.ws + (off)))
constexpr float TWO_PI = 6.283185307179586f;

constexpr int P0_ADA = 112, P0_TAB = 72;
constexpr int P0_SLOW_WIN = 64 * 32, P0_SLOW_WUQ = 24 * 8, P0_SLOW_WUKV = 32 * 4;
constexpr int P0_SLOW = P0_SLOW_WIN + P0_SLOW_WUQ + P0_SLOW_WUKV;
constexpr int P0_FAST_SQ = 64;
constexpr int P0_FAST_GU = 2 * NE * 32 * 4, P0_FAST_D = 2 * NE * 16 * 4;
constexpr int P0_FAST = 2 * P0_FAST_SQ + P0_FAST_GU + P0_FAST_D;
constexpr int P0_UNITS = P0_ADA + P0_FAST + P0_SLOW + P0_TAB;
constexpr size_t OFF_QCTR = 14336;

__device__ __forceinline__ int rope_src(int jj) { const int pp = jj >> 1, wh = jj & 1; return (pp < 16 ? 0 : 32) + (pp & 15) + 16 * wh; }

__device__ __forceinline__ void p0_slow_tile(const float* src, int lds_, const float* scale, bf16_t* dst, int K, int n0, int k0, int tid) {
    const int kg = tid >> 6, k = k0 + kg * 8;
    float v[8];
#pragma unroll
    for (int i = 0; i < 8; ++i) v[i] = src ? src[(size_t)(k + i) * lds_] * (scale ? scale[k + i] : 1.f) : 0.f;
    u32x4 w; w.x = cvtpk(v[0], v[1]); w.y = cvtpk(v[2], v[3]); w.z = cvtpk(v[4], v[5]); w.w = cvtpk(v[6], v[7]);
    *(u32x4*)(dst + (size_t)(n0 + (tid & 63)) * K + k) = w;
}
__device__ __forceinline__ void p0_fast_tile(const float* src, int lds_, bf16_t* dst, int K, int tid) {
    const int n4 = tid & 31, kg = tid >> 5;
    f32x4 v[4][8];
#pragma unroll
    for (int sb = 0; sb < 4; ++sb)
#pragma unroll
        for (int i = 0; i < 8; ++i) v[sb][i] = __builtin_nontemporal_load((const f32x4*)(src + (size_t)(sb * 128 + kg * 8 + i) * lds_ + n4 * 4));
#pragma unroll
    for (int sb = 0; sb < 4; ++sb)
#pragma unroll
        for (int j = 0; j < 4; ++j) {
            u32x4 w; w.x = cvtpk(v[sb][0][j], v[sb][1][j]); w.y = cvtpk(v[sb][2][j], v[sb][3][j]); w.z = cvtpk(v[sb][4][j], v[sb][5][j]); w.w = cvtpk(v[sb][6][j], v[sb][7][j]);
            *(u32x4*)(dst + (size_t)(n4 * 4 + j) * K + sb * 128 + kg * 8) = w;
        }
}

__device__ __forceinline__ void phase_prep(const Params& p, char* smem) {
    const int tid = ltid(), wid = tid >> 6, lane = tid & 63;
    float* sl = (float*)smem;
    volatile int* qslot = (volatile int*)(smem + 16384);
    unsigned* qctr = (unsigned*)(p.ws + OFF_QCTR);
    for (;;) {
        __syncthreads();
        if (tid == 0) *qslot = (int)__hip_atomic_fetch_add(qctr, 1u, __ATOMIC_RELAXED, __HIP_MEMORY_SCOPE_AGENT);
        __syncthreads();
        const int u = *qslot;
        if (u >= P0_UNITS) break;
        if (u < P0_ADA) {
            const bool isctx = u >= 96; const int layer = (u >= 48 && u < 96) ? 1 : 0; const int j0 = isctx ? (u - 96) * 256 : (u % 48) * 256;
            const float* cv = isctx ? p.c_ctx : p.c; const float* W = p.ada_w + (size_t)layer * DM * 12288;
            for (int k = tid; k < DM; k += NTHR) { const float v = cv[k]; sl[k] = v / (1.f + expf(-v)); }
            __syncthreads();
            f32x4 acc = {0.f, 0.f, 0.f, 0.f};
            const float* wp = W + (size_t)(wid * 256) * 12288 + j0 + lane * 4;
#pragma unroll 16
            for (int k = 0; k < 256; ++k) { const f32x4 w = __builtin_nontemporal_load((const f32x4*)(wp + (size_t)k * 12288)); const float s_ = sl[wid * 256 + k]; acc += w * s_; }
            float* red = sl + 2048;
            *(f32x4*)(red + wid * 256 + lane * 4) = acc;
            __syncthreads();
            if (tid < 256) { float s_ = 0.f;
#pragma unroll
                for (int w = 0; w < 8; ++w) s_ += red[w * 256 + tid];
                s_ += p.ada_b[(size_t)layer * 12288 + j0 + tid];
                float* dst = isctx ? WSP(float, OFF_ADA) + 2 * 12288 : WSP(float, OFF_ADA) + layer * 12288;
                dst[j0 + tid] = s_; }
        } else if (u < P0_ADA + P0_FAST) {
            int s_ = u - P0_ADA;
            if (s_ < 2 * P0_FAST_SQ) {
                const float* W = s_ < P0_FAST_SQ ? p.w_out_attn : p.w_out_fourier; bf16_t* dst = WSP(bf16_t, s_ < P0_FAST_SQ ? OFF_WOUT : OFF_WFOUT);
                s_ &= 63; const int n0 = (s_ >> 2) * 128, k0 = (s_ & 3) * 512;
                p0_fast_tile(W + (size_t)k0 * DM + n0, DM, dst + (size_t)n0 * DM + k0, DM, tid);
            } else if (s_ < 2 * P0_FAST_SQ + P0_FAST_GU) {
                s_ -= 2 * P0_FAST_SQ; const int le = s_ >> 7, t = s_ & 127, nt_ = t >> 2, k0 = (t & 3) * 512;
                const int pn = nt_ >> 1, bj = nt_ & 1;
                const float* W = (bj ? p.w_up : p.w_gate) + (size_t)le * DM * FF;
                p0_fast_tile(W + (size_t)k0 * FF + pn * 128, FF, WSP(bf16_t, OFF_WGU) + ((size_t)le * 4096 + nt_ * 128) * DM + k0, DM, tid);
            } else {
                s_ -= 2 * P0_FAST_SQ + P0_FAST_GU; const int le = s_ >> 6, t = s_ & 63, n0 = (t >> 2) * 128, k0 = (t & 3) * 512;
                const float* W = p.w_down + (size_t)le * FF * DM;
                p0_fast_tile(W + (size_t)k0 * DM + n0, DM, WSP(bf16_t, OFF_WD) + ((size_t)le * 2048 + n0) * FF + k0, FF, tid);
            }
        } else if (u < P0_ADA + P0_FAST + P0_SLOW) {
            int s_ = u - P0_ADA - P0_FAST;
            if (s_ < P0_SLOW_WIN) {
                const int n0 = (s_ >> 5) * 64, k0 = (s_ & 31) * 64, n = n0 + (tid & 63);
                int col;
                if (n < 768) col = n; else if (n < 1792) col = 832 + (n - 768); else if (n < 2816) col = 1856 + (n - 1792); else if (n < 3840) col = 2880 + (n - 2816);
                else if (n < 3904) col = 768 + rope_src(n - 3840); else col = -1;
                p0_slow_tile(col >= 0 ? p.w_in + col : nullptr, INW, nullptr, WSP(bf16_t, OFF_WIN), DM, n0, k0, tid);
            } else if (s_ < P0_SLOW_WIN + P0_SLOW_WUQ) {
                s_ -= P0_SLOW_WIN; const int n0 = (s_ >> 3) * 64, k0 = (s_ & 7) * 64, n = n0 + (tid & 63);
                int col; if (n < 1024) col = (n >> 7) * 192 + (n & 127); else { const int j = n - 1024; col = (j >> 6) * 192 + 128 + rope_src(j & 63); }
                p0_slow_tile(p.w_uq + col, 1536, p.g_qn, WSP(bf16_t, OFF_WUQ), 512, n0, k0, tid);
            } else {
                s_ -= P0_SLOW_WIN + P0_SLOW_WUQ; const int n0 = (s_ >> 2) * 64, k0 = (s_ & 3) * 64, n = n0 + (tid & 63);
                const int col = n < 1024 ? (n >> 7) * 256 + (n & 127) : ((n - 1024) >> 7) * 256 + 128 + (n & 127);
                p0_slow_tile(p.w_ukv + col, 2048, p.g_kvn, WSP(bf16_t, OFF_WUKV), 256, n0, k0, tid);
            }
        } else {
            const int base = (u - P0_ADA - P0_FAST - P0_SLOW) * 4096;
            for (int e = base + tid; e < base + 4096; e += NTHR) {
                if (e < 4096) { const int pos = e >> 4, i = e & 15; const float inv = powf(10000.f, -(float)i / 16.f); const float a = (float)pos * inv;
                    float* d = WSP(float, OFF_ROPE) + e * 2; d[0] = cosf(a); d[1] = sinf(a); }
                else if (e < 4096 + 16384) { const int q = e - 4096, k1 = q >> 7, b = q & 127; float s, c; sincospif((float)(k1 * b) / 8192.f, &s, &c);
                    float* d = WSP(float, OFF_TW) + q * 2; d[0] = c; d[1] = s; }
                else if (e < 4096 + 16384 + 131072) { const int q = e - 20480, row = q >> 8, cc = q & 255, ri = row >> 8, m = row & 255; float s, c; sincospif((float)((m * cc) & 255) / 128.f, &s, &c);
                    WSP(bf16_t, OFF_DFT1)[q] = f2bf(ri == 0 ? c * 0.0625f : -s * 0.0625f); }
                else if (e < 4096 + 16384 + 131072 + 65536) { const int q = e - 151552, row = q >> 8, col = q & 255, rip = row >> 7, k1 = row & 127, ri = col >> 7, a = col & 127;
                    float s, c; sincospif((float)((k1 * a) & 127) / 64.f, &s, &c); const float sc_ = 0.08838834764831845f; c *= sc_; s *= sc_;
                    const float v = (rip == ri) ? c : (rip == 0 ? s : -s);
                    WSP(bf16_t, OFF_WA)[q] = f2bf(v); }
                else if (e < 4096 + 16384 + 131072 + 131072) { const int q = e - 217088, row = q >> 8, col = q & 255, ri = col >> 7, b = col & 127;
                    float v = 0.f; if (row < 128) { float s, c; sincospif((float)((row * b) & 127) / 64.f, &s, &c); v = (ri == 0 ? c : s) * 0.08838834764831845f; }
                    WSP(bf16_t, OFF_WB)[q] = f2bf(v); }
            }
        }
    }
}

__device__ __forceinline__ void modulate_row(const float* __restrict__ src, const float* __restrict__ g, const float* __restrict__ sh, const float* __restrict__ sc,
                                             bf16_t* __restrict__ dst, int lane) {
    f32x4 v[8]; float ss = 0.f;
#pragma unroll
    for (int j = 0; j < 8; ++j) { v[j] = *(const f32x4*)(src + j * 256 + lane * 4); ss += v[j][0] * v[j][0] + v[j][1] * v[j][1] + v[j][2] * v[j][2] + v[j][3] * v[j][3]; }
    ss = wave_sum(ss); const float rs = rsqrtf(ss * (1.f / DM) + EPS);
#pragma unroll
    for (int j = 0; j < 8; ++j) { const int c = j * 256 + lane * 4; const f32x4 gv = *(const f32x4*)(g + c), sv = *(const f32x4*)(sc + c), hv = *(const f32x4*)(sh + c);
        const f32x4 o = v[j] * rs * gv * (sv + 1.f) + hv;
        u32x2 w; w.x = cvtpk(o[0], o[1]); w.y = cvtpk(o[2], o[3]); *(u32x2*)(dst + c) = w; }
}
__device__ __forceinline__ void phase_mod0(const Params& p) {
    const int tid = ltid(), wid = tid >> 6, lane = tid & 63;
    const float* ada = WSP(float, OFF_ADA); const float* adac = ada + 2 * 12288;
    for (int row = blockIdx.x * 8 + wid; row < NKEY; row += gridDim.x * 8) {
        if (row < NCTX) modulate_row(p.ctx + (size_t)row * DM, p.g_mix, adac, adac + DM, WSP(bf16_t, OFF_H) + (size_t)row * DM, lane);
        else modulate_row(p.x + (size_t)(row - NCTX) * DM, p.g_mix, ada, ada + DM, WSP(bf16_t, OFF_H) + (size_t)row * DM, lane);
    }
}

__device__ __forceinline__ void phase_router(const Params& p, int layer, const float* __restrict__ xin, bf16_t* __restrict__ h2, char* smem) {
    const int tid = ltid(), wid = tid >> 6, lane = tid & 63;
    float* wr = (float*)smem;
    const float* W = p.w_router + (size_t)layer * DM * NE;
    __syncthreads();
    for (int i = tid; i < DM * NE; i += NTHR) { const int k = i >> 4, e = i & 15; wr[e * DM + k] = W[i]; }
    __syncthreads();
    const float* ada = WSP(float, OFF_ADA) + layer * 12288; const float* g = p.g_ffn + layer * DM; const float* sh = ada + 3 * DM; const float* sc = ada + 4 * DM;
    float* aff = WSP(float, OFF_AFF);
    for (int row = blockIdx.x * 8 + wid; row < NTOK; row += gridDim.x * 8) {
        const float* src = xin + (size_t)row * DM;
        f32x4 v[8]; float ss = 0.f;
#pragma unroll
        for (int j = 0; j < 8; ++j) { v[j] = *(const f32x4*)(src + j * 256 + lane * 4); ss += v[j][0] * v[j][0] + v[j][1] * v[j][1] + v[j][2] * v[j][2] + v[j][3] * v[j][3]; }
        ss = wave_sum(ss); const float rs = rsqrtf(ss * (1.f / DM) + EPS);
        float lg[16];
#pragma unroll
        for (int e = 0; e < 16; ++e) lg[e] = 0.f;
#pragma unroll
        for (int j = 0; j < 8; ++j) { const int c = j * 256 + lane * 4; const f32x4 gv = *(const f32x4*)(g + c), sv = *(const f32x4*)(sc + c), hv = *(const f32x4*)(sh + c);
            const f32x4 o = v[j] * rs * gv * (sv + 1.f) + hv;
            u32x2 w; w.x = cvtpk(o[0], o[1]); w.y = cvtpk(o[2], o[3]); *(u32x2*)(h2 + (size_t)row * DM + c) = w;
#pragma unroll
            for (int e = 0; e < 16; ++e) { const f32x4 wv = *(const f32x4*)(wr + e * DM + c); lg[e] += o[0] * wv[0] + o[1] * wv[1] + o[2] * wv[2] + o[3] * wv[3]; } }
        float mx = -1e30f;
#pragma unroll
        for (int e = 0; e < 16; ++e) { lg[e] = wave_sum(lg[e]); mx = fmaxf(mx, lg[e]); }
        float sum = 0.f;
#pragma unroll
        for (int e = 0; e < 16; ++e) { lg[e] = expf(lg[e] - mx); sum += lg[e]; }
        const float inv = 1.f / sum;
        float mine = 0.f;
#pragma unroll
        for (int e = 0; e < 16; ++e) mine = (lane == e) ? lg[e] * inv : mine;
        if (lane < 16) aff[(size_t)lane * NTOK + row] = mine;
    }
}

__device__ __forceinline__ void phase_topk(const Params& p, char* smem) {
    const int tid = ltid(), wid = tid >> 6, lane = tid & 63;
    volatile unsigned* wsum = (volatile unsigned*)smem;
    for (int e = lbid(); e < NE; e += gridDim.x) {
        const float* aff = WSP(float, OFF_AFF) + (size_t)e * NTOK + tid * 32;
        unsigned v[32];
#pragma unroll
        for (int i = 0; i < 8; ++i) { const u32x4 w = *(const u32x4*)(aff + i * 4); v[4 * i] = w.x; v[4 * i + 1] = w.y; v[4 * i + 2] = w.z; v[4 * i + 3] = w.w; }
        unsigned T = 0u;
        __syncthreads();
        for (int bit = 30; bit >= 0; --bit) {
            const unsigned cand = T | (1u << bit);
            unsigned c = 0u;
#pragma unroll
            for (int i = 0; i < 32; ++i) c += (unsigned)__builtin_popcountll(__ballot(v[i] >= cand));
            volatile unsigned* ws_ = wsum + ((bit & 1) << 3);
            if (lane == 0) ws_[wid] = c;
            __syncthreads();
            unsigned tot = 0u;
#pragma unroll
            for (int w = 0; w < 8; ++w) tot += ws_[w];
            if (tot >= (unsigned)CAP) T = cand;
        }
        unsigned gt = 0u, eq = 0u;
#pragma unroll
        for (int i = 0; i < 32; ++i) { gt += v[i] > T; eq += v[i] == T; }
        unsigned sg = gt, se = eq;
#pragma unroll
        for (int o = 1; o < 64; o <<= 1) { const unsigned a_ = __shfl_up(sg, o, 64), b_ = __shfl_up(se, o, 64); if (lane >= o) { sg += a_; se += b_; } }
        __syncthreads();
        if (lane == 63) { wsum[32 + wid] = sg; wsum[40 + wid] = se; }
        __syncthreads();
        unsigned og = 0u, oe = 0u, totg = 0u;
#pragma unroll
        for (int w = 0; w < 8; ++w) { const unsigned a_ = wsum[32 + w], b_ = wsum[40 + w]; if (w < wid) { og += a_; oe += b_; } totg += a_; }
        const unsigned krem = (unsigned)CAP - totg;
        unsigned pg = og + sg - gt, pe = oe + se - eq;
        int* idx = WSP(int, OFF_IDX) + e * CAP; float* gate = WSP(float, OFF_GATE) + e * CAP; int* slot = WSP(int, OFF_SLOT);
#pragma unroll
        for (int i = 0; i < 32; ++i) { const int t = tid * 32 + i; int s_ = -1;
            if (v[i] > T) { s_ = (int)(pg + (pe < krem ? pe : krem)); ++pg; }
            else if (v[i] == T) { if (pe < krem) s_ = (int)(pg + pe); ++pe; }
            slot[(size_t)t * NE + e] = s_;
            if (s_ >= 0) { idx[s_] = t; gate[s_] = __uint_as_float(v[i]); } }
    }
}

template <bool FINAL>
__device__ __forceinline__ void phase_combine(const Params& p, int layer, const float* __restrict__ xin, float* __restrict__ xout) {
    const int tid = ltid(), wid = tid >> 6, lane = tid & 63;
    const float* ada = WSP(float, OFF_ADA) + layer * 12288; const float* gf = ada + 5 * DM;
    const float* ada1 = WSP(float, OFF_ADA) + 12288;
    const bf16_t* ye = WSP(bf16_t, OFF_YE); const int* slot = WSP(int, OFF_SLOT);
    for (int row = blockIdx.x * 8 + wid; row < NTOK; row += gridDim.x * 8) {
        const int sv = lane < 16 ? slot[(size_t)row * NE + lane] : -1;
        f32x4 acc[8];
#pragma unroll
        for (int j = 0; j < 8; ++j) acc[j] = (f32x4){0.f, 0.f, 0.f, 0.f};
        for (int e = 0; e < NE; ++e) { const int s = __shfl(sv, e, 64);
            if (s >= 0) { const bf16_t* yr = ye + ((size_t)e * CAP + s) * DM;
#pragma unroll
                for (int j = 0; j < 8; ++j) { const u32x2 w = *(const u32x2*)(yr + j * 256 + lane * 4);
                    acc[j][0] += __uint_as_float(w.x << 16); acc[j][1] += __uint_as_float(w.x & 0xffff0000u); acc[j][2] += __uint_as_float(w.y << 16); acc[j][3] += __uint_as_float(w.y & 0xffff0000u); } } }
        float ss = 0.f; f32x4 v[8];
#pragma unroll
        for (int j = 0; j < 8; ++j) { const int c = j * 256 + lane * 4; v[j] = *(const f32x4*)(xin + (size_t)row * DM + c) + *(const f32x4*)(gf + c) * acc[j];
            ss += v[j][0] * v[j][0] + v[j][1] * v[j][1] + v[j][2] * v[j][2] + v[j][3] * v[j][3]; }
        ss = wave_sum(ss); const float rs = rsqrtf(ss * (1.f / DM) + EPS);
#pragma unroll
        for (int j = 0; j < 8; ++j) { const int c = j * 256 + lane * 4;
            if constexpr (FINAL) { *(f32x4*)(p.out + (size_t)row * DM + c) = v[j] * rs * *(const f32x4*)(p.g_final + c); }
            else { *(f32x4*)(xout + (size_t)row * DM + c) = v[j];
                const f32x4 o = v[j] * rs * *(const f32x4*)(p.g_mix + DM + c) * (*(const f32x4*)(ada1 + DM + c) + 1.f) + *(const f32x4*)(ada1 + c);
                u32x2 w; w.x = cvtpk(o[0], o[1]); w.y = cvtpk(o[2], o[3]); *(u32x2*)(WSP(bf16_t, OFF_H) + (size_t)row * DM + c) = w; } }
    }
}

enum { PH_PREP = 0, PH_MOD0, PH_INPROJ, PH_UP, PH_ATTN, PH_OUT, PH_ROUTER0, PH_TOPK0, PH_MOE1_0, PH_MOE2_0, PH_COMB0,
       PH_F1, PH_F2A, PH_F2B, PH_FOUT, PH_ROUTER1, PH_TOPK1, PH_MOE1_1, PH_MOE2_1, PH_COMB1, PH_COUNT };

template <int PH>
__device__ __forceinline__ void run_phase(char* smem) {
    typedef __attribute__((address_space(4))) const unsigned long long* KargPtr;
    KargPtr pp = (KargPtr)__builtin_amdgcn_kernarg_segment_ptr();
    asm volatile("; phase %1 begin" : "+s"(pp) : "n"(PH));
    union { Params p; unsigned long long w[sizeof(Params) / 8]; } pu;
#pragma unroll
    for (unsigned i = 0; i < sizeof(Params) / 8; ++i) pu.w[i] = pp[i];
    const Params& p = pu.p;
    LAS unsigned char* lds = (LAS unsigned char*)smem;
    pg8::StaticOrder S;
    const int G = gridDim.x, c = lbid();
    if constexpr (PH == PH_PREP) phase_prep(p, smem);
    else if constexpr (PH == PH_MOD0) phase_mod0(p);
    else if constexpr (PH == PH_INPROJ) {
        DescPlain d{WSP(char, OFF_H), WSP(char, OFF_WIN), DM, DM, DM};
        EpiInproj e{WSP(bf16_t, OFF_CQ), WSP(bf16_t, OFF_CKV), WSP(bf16_t, OFF_KR), WSP(bf16_t, OFF_QNA), WSP(bf16_t, OFF_KNA), WSP(bf16_t, OFF_VNA), WSP(float, OFF_PSQ), WSP(float, OFF_ROPE)};
        S.init(NKEY / 256, INWP / 256, G, c); pg8::gemm_phase(lds, d, S, e);
    } else if constexpr (PH == PH_UP) {
        { DescPlain d{WSP(char, OFF_CQ), WSP(char, OFF_WUQ), 512, 512, 512};
          EpiUq e{WSP(bf16_t, OFF_Q), WSP(float, OFF_PSQ), WSP(float, OFF_ROPE)};
          S.init(NTOK / 256, 1536 / 256, G, c); pg8::gemm_phase(lds, d, S, e); }
        { DescPlain d{WSP(char, OFF_CKV), WSP(char, OFF_WUKV), 256, 256, 256};
          EpiUkv e{WSP(bf16_t, OFF_KN), WSP(bf16_t, OFF_V), WSP(float, OFF_PSQ)};
          S.init(NKEY / 256, 2048 / 256, G, G - 1 - c); pg8::gemm_phase(lds, d, S, e); }
    } else if constexpr (PH == PH_ATTN) {
        for (int L = c; L < 512; L += G) {
            const int h = L & 7, qb = L >> 3;
            att::attn_body<192, false>(WSP(bf16_t, OFF_Q) + ((size_t)h * NTOK + qb * 256) * 192, WSP(bf16_t, OFF_KN) + (size_t)h * NKEY * 128, WSP(bf16_t, OFF_KR),
                                       WSP(bf16_t, OFF_V) + (size_t)h * NKEY * 128, WSP(bf16_t, OFF_OCAT) + (size_t)(qb * 256) * DM + h * 128, NKEY / 64, 0, 0, nullptr, smem);
        }
        for (int L = c; L < 512; L += G) {
            const int h = L & 7, qb = L >> 3;
            const int r0 = qb * 4; const int u0 = r0 < 4 ? 0 : (r0 - 4 > 248 ? 248 : r0 - 4);
            const int r3 = r0 + 3; const int ulast = (r3 < 4 ? 0 : (r3 - 4 > 248 ? 248 : r3 - 4)) + 7;
            int nt = 4 + (ulast - u0 + 1); nt += nt & 1;
            att::attn_body<128, true>(WSP(bf16_t, OFF_QNA) + ((size_t)h * NTOK + qb * 256) * 128, WSP(bf16_t, OFF_KNA) + (size_t)h * NKEY * 128, nullptr,
                                      WSP(bf16_t, OFF_VNA) + (size_t)h * NKEY * 128, WSP(bf16_t, OFF_OCAT) + (size_t)(qb * 256) * DM + 1024 + h * 128, nt, u0, r0,
                                      p.na_bias + h * 15 * 31, smem);
        }
    } else if constexpr (PH == PH_OUT) {
        DescPlain d{WSP(char, OFF_OCAT), WSP(char, OFF_WOUT), DM, DM, DM};
        EpiResid e{WSP(float, OFF_X1), p.x, WSP(float, OFF_ADA) + 2 * DM};
        S.init(NTOK / 256, DM / 256, G, c); pg8::gemm_phase(lds, d, S, e);
    } else if constexpr (PH == PH_ROUTER0) phase_router(p, 0, WSP(float, OFF_X1), WSP(bf16_t, OFF_H), smem);
    else if constexpr (PH == PH_ROUTER1) phase_router(p, 1, WSP(float, OFF_X1), WSP(bf16_t, OFF_H), smem);
    else if constexpr (PH == PH_TOPK0 || PH == PH_TOPK1) phase_topk(p, smem);
    else if constexpr (PH == PH_MOE1_0 || PH == PH_MOE1_1) {
        constexpr int l = PH == PH_MOE1_1;
        DescMoe1 d{WSP(char, OFF_H), WSP(char, OFF_WGU) + (size_t)l * NE * 4096 * DM * 2, DM, WSP(int, OFF_IDX)};
        EpiMoe1 e{WSP(bf16_t, OFF_ACT)};
        S.init(NE * CAP / 256, 4096 / 256, G, c); pg8::gemm_phase(lds, d, S, e);
    } else if constexpr (PH == PH_MOE2_0 || PH == PH_MOE2_1) {
        constexpr int l = PH == PH_MOE2_1;
        DescMoe2 d{WSP(char, OFF_ACT), WSP(char, OFF_WD) + (size_t)l * NE * DM * FF * 2, FF};
        EpiMoe2 e{WSP(bf16_t, OFF_YE), WSP(float, OFF_GATE)};
        S.init(NE * CAP / 256, DM / 256, G, c); pg8::gemm_phase(lds, d, S, e);
    } else if constexpr (PH == PH_COMB0) phase_combine<false>(p, 0, WSP(float, OFF_X1), WSP(float, OFF_X2));
    else if constexpr (PH == PH_COMB1) phase_combine<true>(p, 1, WSP(float, OFF_X1), nullptr);
    else if constexpr (PH == PH_F1) {
        DescF1 d{WSP(char, OFF_DFT1), WSP(char, OFF_H), 256};
        EpiF1 e{WSP(bf16_t, OFF_ACT)};
        S.init(2, 512, G, c); pg8::gemm_phase(lds, d, S, e);
    } else if constexpr (PH == PH_F2A) {
        DescPlain d{WSP(char, OFF_WA), WSP(char, OFF_ACT), 256, 256, 256};
        EpiF2A e{WSP(bf16_t, OFF_YE), WSP(float, OFF_TW)};
        S.init(1, 1024, G, c); pg8::gemm_phase(lds, d, S, e);
    } else if constexpr (PH == PH_F2B) {
        DescPlain d{WSP(char, OFF_WB), WSP(char, OFF_YE), 256, 256, 256};
        EpiF2B e{WSP(bf16_t, OFF_OCAT)};
        S.init(1, 1024, G, c); pg8::gemm_phase(lds, d, S, e);
    } else if constexpr (PH == PH_FOUT) {
        DescPlain d{WSP(char, OFF_OCAT), WSP(char, OFF_WFOUT), DM, DM, DM};
        EpiResid e{WSP(float, OFF_X1), WSP(float, OFF_X2), WSP(float, OFF_ADA) + 12288 + 2 * DM};
        S.init(NTOK / 256, DM / 256, G, c); pg8::gemm_phase(lds, d, S, e);
    }
}

template <int PH>
__global__ __launch_bounds__(NTHR, 2) void k_phase(Params p) {
    ltid_init();
    run_phase<PH>(g_smem);
}

#ifndef MEGA_NOINLINE
#define MEGA_NOINLINE 0
#endif
template <int PH> __device__ __forceinline__ void run_all(char* smem, const XcdBarrier& bar) {
#ifdef MEGA_MASK
    if constexpr ((MEGA_MASK >> PH) & 1)
#endif
    run_phase<PH>(smem);
#if PROBE_DOUBLE
    if constexpr ((PROBE_DOUBLE >> PH) & 1) { xcd_barrier(bar); run_phase<PH>(smem); }
#endif
    if constexpr (PH + 1 < PH_COUNT) { xcd_barrier(bar); run_all<PH + 1>(smem, bar); }
}
#if N_LAUNCH_MODE == 0 && !DEBUG_CHECK
__global__ __launch_bounds__(NTHR, 2) void k_mega(Params p) {
    uint4* xbw = (uint4*)(g_smem + LDS_XBW);
    if (threadIdx.x == 0) *xbw = make_uint4(0u, 0u, 0u, 0u);
    ltid_init();
    XcdBarrier bar = xcd_barrier_post((unsigned*)(p.ws + OFF_BAR), (volatile LAS unsigned*)xbw);
    run_all<0>(g_smem, bar);
}
#endif


#if DEBUG_CHECK
__device__ __forceinline__ unsigned dhash(unsigned x) { x ^= x >> 16; x *= 0x7feb352dU; x ^= x >> 15; x *= 0x846ca68bU; x ^= x >> 16; return x; }
__device__ __forceinline__ void dreport(const Params& p, int slot, float ref, float mine, float scale) {
    float e = fabsf(ref - mine) / (fabsf(ref) + scale); if (!(e == e) || e > 1e9f) e = 1e9f;
    atomicMax((unsigned*)(p.ws + OFF_ERR) + slot, __float_as_uint(e));
}
__device__ __forceinline__ float drope(float x1, float x2, int i  , int pos) {
    const int f = i & 15; const float inv = powf(10000.f, -(float)f / 16.f), a = (float)pos * inv, c = cosf(a), s = sinf(a);
    return i < 16 ? x1 * c - x2 * s : x2 * c + x1 * s;
}
__global__ void dbg_ada(Params p) {
    const unsigned i = blockIdx.x * blockDim.x + threadIdx.x, h = dhash(i), w = h % 3;
    const int j = (int)(dhash(h) % (w == 2 ? 4096u : 12288u)); const int layer = w == 1;
    const float* cv = w == 2 ? p.c_ctx : p.c; const float* W = p.ada_w + (size_t)layer * DM * 12288;
    float s = 0.f; for (int k = 0; k < DM; ++k) { const float v = cv[k]; s += v / (1.f + expf(-v)) * W[(size_t)k * 12288 + j]; }
    s += p.ada_b[layer * 12288 + j];
    const float mine = (w == 2 ? WSP(float, OFF_ADA) + 2 * 12288 : WSP(float, OFF_ADA) + layer * 12288)[j];
    dreport(p, 0, s, mine, 0.05f);
}
__global__ void dbg_mod0(Params p) {
    const unsigned i = blockIdx.x * blockDim.x + threadIdx.x, h = dhash(i + 77u);
    const int row = h % NKEY, col = dhash(h) % DM;
    const float* src = row < NCTX ? p.ctx + (size_t)row * DM : p.x + (size_t)(row - NCTX) * DM;
    const float* ad = row < NCTX ? WSP(float, OFF_ADA) + 2 * 12288 : WSP(float, OFF_ADA);
    float ss = 0.f; for (int k = 0; k < DM; ++k) ss += src[k] * src[k];
    const float ref = src[col] * rsqrtf(ss / DM + EPS) * p.g_mix[col] * (1.f + ad[DM + col]) + ad[col];
    dreport(p, 1, ref, bf2f(WSP(bf16_t, OFF_H)[(size_t)row * DM + col]), 0.5f);
}
__device__ __forceinline__ float dbg_indot(const Params& p, int row, int col) {
    const bf16_t* hr = WSP(bf16_t, OFF_H) + (size_t)row * DM; float s = 0.f;
    for (int k = 0; k < DM; ++k) s += bf2f(hr[k]) * p.w_in[(size_t)k * INW + col];
    return s;
}
__global__ void dbg_inproj(Params p) {
    const unsigned i = blockIdx.x * blockDim.x + threadIdx.x, h = dhash(i + 1234u);
    const int row = h % NKEY; int col = dhash(h) % INW; const bool lat = row >= NCTX; const int n = row - NCTX;
    if (i & 1) col = 768 + (int)(dhash(h + 5u) % 64u);
    float ref, mine;
    if (col < 512) { if (!lat) return; ref = dbg_indot(p, row, col); mine = bf2f(WSP(bf16_t, OFF_CQ)[(size_t)n * 512 + col]); }
    else if (col < 768) { ref = dbg_indot(p, row, col); mine = bf2f(WSP(bf16_t, OFF_CKV)[(size_t)row * 256 + col - 512]); }
    else if (col < 832) { const int ridx = col - 768, half = ridx >> 5, ii = ridx & 31, f = ii & 15;
        const float x1 = dbg_indot(p, row, 768 + 32 * half + f), x2 = dbg_indot(p, row, 768 + 32 * half + 16 + f);
        ref = lat ? drope(x1, x2, ii, half == 0 ? (n >> 6) : (n & 63)) : (ii < 16 ? x1 : x2);
        mine = bf2f(WSP(bf16_t, OFF_KR)[(size_t)row * 64 + 2 * (16 * half + f) + (ii >> 4)]); }
    else if (col < 1856) { if (!lat) return; const int j = col - 832; ref = dbg_indot(p, row, col) * NA_QS; mine = bf2f(WSP(bf16_t, OFF_QNA)[((size_t)(j >> 7) * NTOK + n) * 128 + (j & 127)]); }
    else if (col < 2880) { const int j = col - 1856; ref = dbg_indot(p, row, col); mine = bf2f(WSP(bf16_t, OFF_KNA)[((size_t)(j >> 7) * NKEY + row) * 128 + (j & 127)]); }
    else { const int j = col - 2880; ref = dbg_indot(p, row, col); mine = bf2f(WSP(bf16_t, OFF_VNA)[((size_t)(j >> 7) * NKEY + row) * 128 + (j & 127)]); }
    dreport(p, 2, ref, mine, 0.3f);
}
__device__ __forceinline__ float dbg_uqdot(const Params& p, int n, int col) {
    const bf16_t* r = WSP(bf16_t, OFF_CQ) + (size_t)n * 512; float s = 0.f;
    for (int k = 0; k < 512; ++k) s += bf2f(r[k]) * p.g_qn[k] * p.w_uq[(size_t)k * 1536 + col];
    return s;
}
__global__ void dbg_up(Params p) {
    const unsigned i = blockIdx.x * blockDim.x + threadIdx.x, h = dhash(i + 999u);
    if (i & 1) {
        const int n = h % NTOK, hd = dhash(h) % 8, d = dhash(h + 3u) % 192;
        const bf16_t* r = WSP(bf16_t, OFF_CQ) + (size_t)n * 512; float ss = 0.f; for (int k = 0; k < 512; ++k) ss += bf2f(r[k]) * bf2f(r[k]);
        const float rs = rsqrtf(ss / 512.f + EPS); float ref, mine;
        if (d < 128) { ref = dbg_uqdot(p, n, hd * 192 + d) * rs * MLA_QS; mine = bf2f(WSP(bf16_t, OFF_Q)[((size_t)hd * NTOK + n) * 192 + d]); }
        else { const int ridx = d - 128, half = ridx >> 5, ii = ridx & 31, f = ii & 15;
            const float x1 = dbg_uqdot(p, n, hd * 192 + 128 + 32 * half + f) * rs, x2 = dbg_uqdot(p, n, hd * 192 + 128 + 32 * half + 16 + f) * rs;
            ref = drope(x1, x2, ii, half == 0 ? (n >> 6) : (n & 63)) * MLA_QS;
            mine = bf2f(WSP(bf16_t, OFF_Q)[((size_t)hd * NTOK + n) * 192 + 128 + 2 * (16 * half + f) + (ii >> 4)]); }
        dreport(p, 3, ref, mine, 0.1f);
    } else {
        const int key = h % NKEY, hd = dhash(h) % 8, d = dhash(h + 3u) % 256;
        const bf16_t* r = WSP(bf16_t, OFF_CKV) + (size_t)key * 256; float ss = 0.f, s = 0.f;
        for (int k = 0; k < 256; ++k) { const float v = bf2f(r[k]); ss += v * v; s += v * p.g_kvn[k] * p.w_ukv[(size_t)k * 2048 + hd * 256 + d]; }
        const float ref = s * rsqrtf(ss / 256.f + EPS);
        const float mine = bf2f((d < 128 ? WSP(bf16_t, OFF_KN) : WSP(bf16_t, OFF_V))[((size_t)hd * NKEY + key) * 128 + (d & 127)]);
        dreport(p, 3, ref, mine, 0.3f);
    }
}
__global__ void dbg_mla(Params p) {
    extern __shared__ float sc[];
    __shared__ float red[256];
    const unsigned hh = dhash(blockIdx.x + 4242u); const int n = blockIdx.x < 4 ? (blockIdx.x * 5461 + (blockIdx.x & 1) * 255) % NTOK : hh % NTOK, h = dhash(hh) % 8, tid = threadIdx.x;
    const bf16_t* q = WSP(bf16_t, OFF_Q) + ((size_t)h * NTOK + n) * 192;
    float mx = -1e30f;
    for (int key = tid; key < NKEY; key += 256) { const bf16_t* kn = WSP(bf16_t, OFF_KN) + ((size_t)h * NKEY + key) * 128; const bf16_t* kr = WSP(bf16_t, OFF_KR) + (size_t)key * 64;
        float s = 0.f; for (int d = 0; d < 128; ++d) s += bf2f(q[d]) * bf2f(kn[d]); for (int d = 0; d < 64; ++d) s += bf2f(q[128 + d]) * bf2f(kr[d]);
        sc[key] = s; mx = fmaxf(mx, s); }
    red[tid] = mx; __syncthreads(); for (int o = 128; o > 0; o >>= 1) { if (tid < o) red[tid] = fmaxf(red[tid], red[tid + o]); __syncthreads(); } mx = red[0]; __syncthreads();
    float l = 0.f; for (int key = tid; key < NKEY; key += 256) { const float e = exp2f(sc[key] - mx); sc[key] = e; l += e; }
    red[tid] = l; __syncthreads(); for (int o = 128; o > 0; o >>= 1) { if (tid < o) red[tid] += red[tid + o]; __syncthreads(); } l = red[0];
    if (tid < 128) { float o = 0.f; for (int key = 0; key < NKEY; ++key) o += sc[key] * bf2f(WSP(bf16_t, OFF_V)[((size_t)h * NKEY + key) * 128 + tid]);
        dreport(p, 4, o / l, bf2f(WSP(bf16_t, OFF_OCAT)[(size_t)n * DM + h * 128 + tid]), 0.05f); }
}
__global__ void dbg_na(Params p) {
    __shared__ float sc[384]; __shared__ float red[512];
    const unsigned hh = dhash(blockIdx.x + 777u); const int tid = threadIdx.x;
    int n = hh % NTOK; if (blockIdx.x < 8) { const int rr[8] = {0, 3, 4, 5, 251, 252, 255, 128}; const int cc[8] = {0, 7, 8, 9, 55, 56, 63, 33}; n = rr[blockIdx.x] * 64 + cc[blockIdx.x]; }
    const int h = dhash(hh) % 8, r = n >> 6, cq = n & 63, rs = r < 4 ? 0 : (r > 252 ? 248 : r - 4), cs = cq < 8 ? 0 : (cq > 56 ? 48 : cq - 8);
    const bf16_t* q = WSP(bf16_t, OFF_QNA) + ((size_t)h * NTOK + n) * 128;
    float s = -1e30f; int key = 0;
    if (tid < 384) { float bias = 0.f;
        if (tid < 256) key = tid; else { const int j = tid - 256, jr = j >> 4, jc = j & 15; key = NCTX + (rs + jr) * 64 + cs + jc; bias = p.na_bias[(h * 15 + (rs + jr - r + 7)) * 31 + (cs + jc - cq + 15)] * LOG2E; }
        const bf16_t* kk = WSP(bf16_t, OFF_KNA) + ((size_t)h * NKEY + key) * 128; s = bias; for (int d = 0; d < 128; ++d) s += bf2f(q[d]) * bf2f(kk[d]); }
    red[tid] = s; __syncthreads(); for (int o = 256; o > 0; o >>= 1) { if (tid < o) red[tid] = fmaxf(red[tid], red[tid + o]); __syncthreads(); } const float mx = red[0]; __syncthreads();
    const float e = tid < 384 ? exp2f(s - mx) : 0.f; if (tid < 384) sc[tid] = e;
    red[tid] = e; __syncthreads(); for (int o = 256; o > 0; o >>= 1) { if (tid < o) red[tid] += red[tid + o]; __syncthreads(); } const float l = red[0];
    if (tid < 128) { float o = 0.f;
        for (int j = 0; j < 384; ++j) { int kj = j; if (j >= 256) { const int jj = j - 256; kj = NCTX + (rs + (jj >> 4)) * 64 + cs + (jj & 15); }
            o += sc[j] * bf2f(WSP(bf16_t, OFF_VNA)[((size_t)h * NKEY + kj) * 128 + tid]); }
        dreport(p, 5, o / l, bf2f(WSP(bf16_t, OFF_OCAT)[(size_t)n * DM + 1024 + h * 128 + tid]), 0.05f); }
}
__global__ void dbg_resid(Params p, int slot, const bf16_t* A, const float* W, const float* base, const float* gate, const float* mineb) {
    const unsigned i = blockIdx.x * blockDim.x + threadIdx.x, h = dhash(i + 31337u + slot);
    const int row = h % NTOK, col = dhash(h) % DM; float s = 0.f;
    for (int k = 0; k < DM; ++k) s += bf2f(A[(size_t)row * DM + k]) * W[(size_t)k * DM + col];
    dreport(p, slot, base[(size_t)row * DM + col] + gate[col] * s, mineb[(size_t)row * DM + col], 0.3f);
}
__global__ void dbg_router(Params p, int slot, int layer) {
    const unsigned i = blockIdx.x * blockDim.x + threadIdx.x, h = dhash(i + 555u + slot);
    const int row = h % NTOK; const float* src = WSP(float, OFF_X1) + (size_t)row * DM;
    const float* ada = WSP(float, OFF_ADA) + layer * 12288; const float* g = p.g_ffn + layer * DM; const float* W = p.w_router + (size_t)layer * DM * NE;
    float ss = 0.f; for (int k = 0; k < DM; ++k) ss += src[k] * src[k]; const float rs = rsqrtf(ss / DM + EPS);
    float lg[16]; for (int e = 0; e < 16; ++e) lg[e] = 0.f;
    const int col = dhash(h) % DM;
    for (int k = 0; k < DM; ++k) { const float hv = src[k] * rs * g[k] * (1.f + ada[4 * DM + k]) + ada[3 * DM + k];
        if (k == col) dreport(p, slot, hv, bf2f(WSP(bf16_t, OFF_H)[(size_t)row * DM + k]), 0.5f);
        for (int e = 0; e < 16; ++e) lg[e] += hv * W[k * NE + e]; }
    float mx = -1e30f; for (int e = 0; e < 16; ++e) mx = fmaxf(mx, lg[e]); float sm = 0.f; for (int e = 0; e < 16; ++e) { lg[e] = expf(lg[e] - mx); sm += lg[e]; }
    for (int e = 0; e < 16; ++e) dreport(p, slot, lg[e] / sm, WSP(float, OFF_AFF)[(size_t)e * NTOK + row], 0.01f);
}
__global__ void dbg_topk(Params p, int slot_) {
    __shared__ float rmin[512], rmax[512]; __shared__ int rc[512], bad[512];
    const int e = blockIdx.x, tid = threadIdx.x; float mn = 1e30f, mxu = -1e30f; int cnt = 0, b = 0;
    for (int t = tid; t < NTOK; t += 512) { const int s = WSP(int, OFF_SLOT)[(size_t)t * NE + e]; const float a = WSP(float, OFF_AFF)[(size_t)e * NTOK + t];
        if (s >= 0) { ++cnt; mn = fminf(mn, a); if (s >= CAP || WSP(int, OFF_IDX)[e * CAP + s] != t || WSP(float, OFF_GATE)[e * CAP + s] != a) b = 1; } else mxu = fmaxf(mxu, a); }
    rmin[tid] = mn; rmax[tid] = mxu; rc[tid] = cnt; bad[tid] = b; __syncthreads();
    for (int o = 256; o > 0; o >>= 1) { if (tid < o) { rmin[tid] = fminf(rmin[tid], rmin[tid + o]); rmax[tid] = fmaxf(rmax[tid], rmax[tid + o]); rc[tid] += rc[tid + o]; bad[tid] |= bad[tid + o]; } __syncthreads(); }
    if (tid == 0) { float err = 0.f; if (rc[0] != CAP) err = 0.5f; else if (bad[0]) err = 0.25f; else if (rmin[0] < rmax[0]) err = 0.125f; dreport(p, slot_, err, 0.f, 1.0f - err); }
}
__global__ void dbg_act(Params p, int slot_, int layer) {
    const unsigned i = blockIdx.x * blockDim.x + threadIdx.x, h = dhash(i + 2024u + slot_);
    const int e = h % NE, sl = dhash(h) % CAP, ff = dhash(h + 9u) % FF; const int t = WSP(int, OFF_IDX)[e * CAP + sl];
    if (t < 0 || t >= NTOK) { dreport(p, slot_, 1.f, 0.f, 0.f); return; }
    const bf16_t* hr = WSP(bf16_t, OFF_H) + (size_t)t * DM; const float* wg = p.w_gate + ((size_t)layer * NE + e) * DM * FF; const float* wu = p.w_up + ((size_t)layer * NE + e) * DM * FF;
    float a = 0.f, u = 0.f; for (int k = 0; k < DM; ++k) { const float v = bf2f(hr[k]); a += v * wg[(size_t)k * FF + ff]; u += v * wu[(size_t)k * FF + ff]; }
    dreport(p, slot_, a / (1.f + expf(-a)) * u, bf2f(WSP(bf16_t, OFF_ACT)[((size_t)e * CAP + sl) * FF + ff]), 0.2f);
}
__global__ void dbg_ye(Params p, int slot_, int layer) {
    const unsigned i = blockIdx.x * blockDim.x + threadIdx.x, h = dhash(i + 808u + slot_);
    const int e = h % NE, sl = dhash(h) % CAP, d = dhash(h + 9u) % DM;
    const bf16_t* ar = WSP(bf16_t, OFF_ACT) + ((size_t)e * CAP + sl) * FF; const float* wd = p.w_down + ((size_t)layer * NE + e) * FF * DM;
    float s = 0.f; for (int k = 0; k < FF; ++k) s += bf2f(ar[k]) * wd[(size_t)k * DM + d];
    dreport(p, slot_, s * WSP(float, OFF_GATE)[e * CAP + sl], bf2f(WSP(bf16_t, OFF_YE)[((size_t)e * CAP + sl) * DM + d]), 0.1f);
}
__device__ __forceinline__ float dbg_x2(const Params& p, int layer, int row, int c) {
    float acc = 0.f; for (int e = 0; e < NE; ++e) { const int s = WSP(int, OFF_SLOT)[(size_t)row * NE + e]; if (s >= 0) acc += bf2f(WSP(bf16_t, OFF_YE)[((size_t)e * CAP + s) * DM + c]); }
    return WSP(float, OFF_X1)[(size_t)row * DM + c] + WSP(float, OFF_ADA)[layer * 12288 + 5 * DM + c] * acc;
}
__global__ void dbg_comb0(Params p) {
    const unsigned i = blockIdx.x * blockDim.x + threadIdx.x, h = dhash(i + 1111u);
    const int row = h % NTOK, col = dhash(h) % DM;
    dreport(p, 11, dbg_x2(p, 0, row, col), WSP(float, OFF_X2)[(size_t)row * DM + col], 0.3f);
    float ss = 0.f; for (int k = 0; k < DM; ++k) { const float v = WSP(float, OFF_X2)[(size_t)row * DM + k]; ss += v * v; }
    const float* ada1 = WSP(float, OFF_ADA) + 12288;
    const float ref = WSP(float, OFF_X2)[(size_t)row * DM + col] * rsqrtf(ss / DM + EPS) * p.g_mix[DM + col] * (1.f + ada1[DM + col]) + ada1[col];
    dreport(p, 11, ref, bf2f(WSP(bf16_t, OFF_H)[(size_t)row * DM + col]), 0.5f);
}
__global__ void dbg_fft(Params p, const bf16_t* Hsave) {
    __shared__ float cb[256], sb[256]; __shared__ double red[256];
    const unsigned hh = dhash(blockIdx.x + 606u); const int tid = threadIdx.x;
    int k = hh % NTOK, col = dhash(hh) % DM; if (blockIdx.x == 0) { k = 0; col = 0; } if (blockIdx.x == 1) { k = 1; col = 257; } if (blockIdx.x == 2) { k = 128; col = 3; }
    const int g = col >> 8, m = col & 255;
    { float s, c; sincospif((float)((m * tid) & 255) / 128.f, &s, &c); cb[tid] = c; sb[tid] = s; } __syncthreads();
    double acc = 0.0;
    for (int n = tid; n < NTOK; n += 256) { float P = 0.f, Q = 0.f; const bf16_t* hr = Hsave + (size_t)n * DM + g * 256;
        for (int c = 0; c < 256; ++c) { const float v = bf2f(hr[c]); P += v * cb[c]; Q += v * sb[c]; }
        float sa, ca; sincospif((float)(((long)k * n) & 16383) / 8192.f, &sa, &ca); acc += (double)ca * P - (double)sa * Q; }
    red[tid] = acc; __syncthreads(); for (int o = 128; o > 0; o >>= 1) { if (tid < o) red[tid] += red[tid + o]; __syncthreads(); }
    if (tid == 0) dreport(p, 12, (float)(red[0] / 2048.0), bf2f(WSP(bf16_t, OFF_OCAT)[(size_t)k * DM + col]), 0.3f);
}
__global__ void dbg_final(Params p) {
    const unsigned i = blockIdx.x * blockDim.x + threadIdx.x, h = dhash(i + 9090u);
    const int row = h % NTOK, col = dhash(h) % DM; float ss = 0.f, xc = 0.f;
    for (int k = 0; k < DM; ++k) { const float v = dbg_x2(p, 1, row, k); ss += v * v; if (k == col) xc = v; }
    dreport(p, 18, xc * rsqrtf(ss / DM + EPS) * p.g_final[col], p.out[(size_t)row * DM + col], 0.3f);
}
__global__ void dbg_report(Params p) {
    const unsigned* err = (const unsigned*)(p.ws + OFF_ERR);
    int bad = -1; float be = 0.f;
    for (int s = 0; s < 19; ++s) { const float e = __uint_as_float(err[s]); if (e > 0.04f) { bad = s; be = e; break; } }
    if (bad < 0) return;
    const size_t i0 = (size_t)blockIdx.x * blockDim.x + threadIdx.x;
    for (size_t i = i0; i < (size_t)NTOK * DM; i += (size_t)gridDim.x * blockDim.x) p.out[i] = 0.f;
    if (i0 == 0) { const float m = 1.f + 8.f * fminf(1.f, be); p.out[0] = sqrtf(m * 33554432.f) * powf(10.f, 0.5f * (float)(bad + 2)); }
}
static void dbg_after_phase(int ph, const Params& p, hipStream_t st) {
    char* ws = p.ws;
    static bool a = false; if (!a) { (void)hipFuncSetAttribute((const void*)dbg_mla, hipFuncAttributeMaxDynamicSharedMemorySize, NKEY * 4); a = true; }
    bf16_t* hsave = (bf16_t*)(ws + OFF_CQ);
    switch (ph) {
    case PH_PREP: hipLaunchKernelGGL(dbg_ada, dim3(16), dim3(256), 0, st, p); break;
    case PH_MOD0: hipLaunchKernelGGL(dbg_mod0, dim3(16), dim3(256), 0, st, p); break;
    case PH_INPROJ: hipLaunchKernelGGL(dbg_inproj, dim3(64), dim3(256), 0, st, p); break;
    case PH_UP: hipLaunchKernelGGL(dbg_up, dim3(64), dim3(256), 0, st, p); break;
    case PH_ATTN: hipLaunchKernelGGL(dbg_mla, dim3(48), dim3(256), NKEY * 4, st, p); hipLaunchKernelGGL(dbg_na, dim3(96), dim3(512), 0, st, p); break;
    case PH_OUT: hipLaunchKernelGGL(dbg_resid, dim3(64), dim3(256), 0, st, p, 6, (const bf16_t*)(ws + OFF_OCAT), p.w_out_attn, p.x, (const float*)(ws + OFF_ADA) + 2 * DM, (const float*)(ws + OFF_X1)); break;
    case PH_ROUTER0: hipLaunchKernelGGL(dbg_router, dim3(8), dim3(256), 0, st, p, 7, 0); break;
    case PH_TOPK0: hipLaunchKernelGGL(dbg_topk, dim3(16), dim3(512), 0, st, p, 8); break;
    case PH_MOE1_0: hipLaunchKernelGGL(dbg_act, dim3(64), dim3(256), 0, st, p, 9, 0); break;
    case PH_MOE2_0: hipLaunchKernelGGL(dbg_ye, dim3(64), dim3(256), 0, st, p, 10, 0); break;
    case PH_COMB0: hipLaunchKernelGGL(dbg_comb0, dim3(16), dim3(256), 0, st, p);
        (void)hipMemcpyAsync(hsave, ws + OFF_H, (size_t)NTOK * DM * 2, hipMemcpyDeviceToDevice, st); break;
    case PH_F2B: hipLaunchKernelGGL(dbg_fft, dim3(48), dim3(256), 0, st, p, (const bf16_t*)hsave); break;
    case PH_FOUT: hipLaunchKernelGGL(dbg_resid, dim3(64), dim3(256), 0, st, p, 13, (const bf16_t*)(ws + OFF_OCAT), p.w_out_fourier, (const float*)(ws + OFF_X2), (const float*)(ws + OFF_ADA) + 12288 + 2 * DM, (const float*)(ws + OFF_X1)); break;
    case PH_ROUTER1: hipLaunchKernelGGL(dbg_router, dim3(8), dim3(256), 0, st, p, 14, 1); break;
    case PH_TOPK1: hipLaunchKernelGGL(dbg_topk, dim3(16), dim3(512), 0, st, p, 15); break;
    case PH_MOE1_1: hipLaunchKernelGGL(dbg_act, dim3(64), dim3(256), 0, st, p, 16, 1); break;
    case PH_MOE2_1: hipLaunchKernelGGL(dbg_ye, dim3(64), dim3(256), 0, st, p, 17, 1); break;
    case PH_COMB1: hipLaunchKernelGGL(dbg_final, dim3(8), dim3(256), 0, st, p); hipLaunchKernelGGL(dbg_report, dim3(1024), dim3(256), 0, st, p); break;
    default: break;
    }
}
#endif
template <int PH> static void launch_phases(const Params& p, int grid, hipStream_t stream) {
    static bool attr_done = false;
    if (!attr_done) { (void)hipFuncSetAttribute((const void*)k_phase<PH>, hipFuncAttributeMaxDynamicSharedMemorySize, LDS_BYTES); attr_done = true; }
    hipLaunchKernelGGL(k_phase<PH>, dim3(grid), dim3(NTHR), LDS_BYTES, stream, p);
#if DEBUG_CHECK
    dbg_after_phase(PH, p, stream);
#endif
    if constexpr (PH + 1 < PH_COUNT) launch_phases<PH + 1>(p, grid, stream);
}

extern "C" void kernel_launch(void* const* d_in, const int* in_sizes, int n_in, void* d_out, int out_size, void* d_ws, size_t ws_size, hipStream_t stream) {
    if (n_in != 21 || ws_size < WS_END || out_size != NTOK * DM) {
        fprintf(stderr, "kernel_launch: unexpected shapes: n_in %d ws %zu (need %zu) out %d\n", n_in, ws_size, (size_t)WS_END, out_size);
        return;
    }
    Params p{};
    p.x = (const float*)d_in[0]; p.c = (const float*)d_in[1]; p.ctx = (const float*)d_in[2]; p.c_ctx = (const float*)d_in[3];
    p.ada_w = (const float*)d_in[4]; p.ada_b = (const float*)d_in[5]; p.g_mix = (const float*)d_in[6]; p.g_ffn = (const float*)d_in[7];
    p.g_final = (const float*)d_in[8]; p.w_in = (const float*)d_in[9]; p.g_qn = (const float*)d_in[10]; p.w_uq = (const float*)d_in[11];
    p.g_kvn = (const float*)d_in[12]; p.w_ukv = (const float*)d_in[13]; p.na_bias = (const float*)d_in[14]; p.w_out_attn = (const float*)d_in[15];
    p.w_out_fourier = (const float*)d_in[16]; p.w_router = (const float*)d_in[17]; p.w_gate = (const float*)d_in[18]; p.w_up = (const float*)d_in[19];
    p.w_down = (const float*)d_in[20];
    p.out = (float*)d_out; p.ws = (char*)d_ws;
    static int grid = 0;
    if (!grid) {
        int dev = 0, cus = 0, per_cu = 0;
        (void)hipGetDevice(&dev);
        (void)hipDeviceGetAttribute(&cus, hipDeviceAttributeMultiprocessorCount, dev);
#if N_LAUNCH_MODE == 0 && !DEBUG_CHECK
        (void)hipFuncSetAttribute((const void*)k_mega, hipFuncAttributeMaxDynamicSharedMemorySize, LDS_BYTES);
        (void)hipOccupancyMaxActiveBlocksPerMultiprocessor(&per_cu, (const void*)k_mega, NTHR, LDS_BYTES);
#else
        per_cu = 1;
#endif
        if (cus <= 0) cus = 256;
        grid = per_cu >= 1 ? cus : 0;
        if (!grid) { fprintf(stderr, "kernel_launch: persistent kernel does not fit (occupancy %d)\n", per_cu); grid = -1; }
    }
    if (grid <= 0) return;
    (void)hipMemsetAsync((char*)d_ws + OFF_BAR, 0, 16384, stream);
#if DEBUG_CHECK
    (void)hipMemsetAsync((char*)d_ws + OFF_ERR, 0, 4096, stream);
#endif
#if N_LAUNCH_MODE == 0 && !DEBUG_CHECK
    hipLaunchKernelGGL(k_mega, dim3(grid), dim3(NTHR), LDS_BYTES, stream, p);
#else
    launch_phases<0>(p, grid, stream);
#endif
    const hipError_t le = hipPeekAtLastError();
    if (le != hipSuccess) fprintf(stderr, "kernel_launch: launch failed: %s\n", hipGetErrorName(le));
}
```

```cpp
#include <hip/hip_runtime.h>
#include <cstdio>
#include <cstdint>

#ifndef N_LAUNCH_MODE
#define N_LAUNCH_MODE 0
#endif
#ifndef DEBUG_CHECK
#define DEBUG_CHECK 0
#endif
#ifndef ATT_SPLIT
#define ATT_SPLIT 0
#endif
#ifndef MLA_FP8
#define MLA_FP8 1
#endif
#ifndef MOE1_FP8
#define MOE1_FP8 1
#endif
#ifndef MOE2_FP8
#define MOE2_FP8 1
#endif
#ifndef ATTG_FP8
#define ATTG_FP8 1
#endif
#ifndef PROBE_MB
#define PROBE_MB 0
#endif
#ifndef ATT_DIAG
#define ATT_DIAG 0
#endif
#ifndef ATT_GRP_MODE
#define ATT_GRP_MODE 0
#endif
#ifndef PROBE_ATT
#define PROBE_ATT 0
#endif
#ifndef PREP_DEFER
#define PREP_DEFER 1
#endif
#ifndef CONV_CUS
#define CONV_CUS 51
#endif
#ifndef RES_BF16
#define RES_BF16 1
#endif
#ifndef PROBE_DOUBLE
#define PROBE_DOUBLE 0
#endif

typedef unsigned short bf16_t;
typedef short bf16x8 __attribute__((ext_vector_type(8)));
typedef short s16x4 __attribute__((ext_vector_type(4)));
typedef float f32x2 __attribute__((ext_vector_type(2)));
typedef float f32x4 __attribute__((ext_vector_type(4)));
typedef float f32x16 __attribute__((ext_vector_type(16)));
typedef unsigned u32x2 __attribute__((ext_vector_type(2)));
typedef unsigned u32x4 __attribute__((ext_vector_type(4)));
typedef int i32x8 __attribute__((ext_vector_type(8)));
#define LAS __attribute__((address_space(3)))

constexpr int DM = 2048, NTOK = 16384, NCTX = 256, NKEY = NTOK + NCTX, GW = 64, GH = 256;
constexpr int NH = 8, NE = 16, CAP = 2048, FF = 2048;
constexpr int INW = 3904, INWP = 4096;
constexpr float EPS = 1e-6f;
constexpr float LOG2E = 1.4426950408889634f;
constexpr float MLA_QS = 0.07216878364870322f * LOG2E;
constexpr float NA_QS = 0.08838834764831845f * LOG2E;
constexpr int NTHR = 512;

constexpr size_t al256(size_t x) { return (x + 255) / 256 * 256; }
constexpr size_t OFF_BAR = 0;
constexpr size_t OFF_ADA = 16384;
constexpr size_t OFF_ROPE = OFF_ADA + al256((2 * 12288 + 4096) * 4);
constexpr size_t OFF_TW = OFF_ROPE + 256 * 16 * 2 * 4;
constexpr size_t OFF_DFT1 = OFF_TW + 128 * 128 * 2 * 4;
constexpr size_t OFF_WA = OFF_DFT1 + 512 * 256 * 2;
constexpr size_t OFF_WB = OFF_WA + 256 * 256 * 2;
constexpr size_t OFF_ERR = OFF_WB + 256 * 256 * 2;
constexpr size_t OFF_WIN = OFF_ERR + 4096;
constexpr size_t OFF_WUQ = OFF_WIN + (size_t)INWP * DM * 2;
constexpr size_t OFF_WUKV = OFF_WUQ + (size_t)1536 * 512 * 2;
constexpr size_t OFF_WOUT = OFF_WUKV + (size_t)2048 * 256 * 2;
constexpr size_t OFF_WFOUT = OFF_WOUT + (size_t)DM * DM * 2;
constexpr size_t OFF_WGU = OFF_WFOUT + (size_t)DM * DM * 2;
constexpr size_t OFF_WD = OFF_WGU + (size_t)2 * NE * 4096 * DM * 2;
constexpr size_t OFF_H = OFF_WD + (size_t)2 * NE * DM * FF * 2;
constexpr size_t OFF_X1 = OFF_H + (size_t)NKEY * DM * 2;
constexpr size_t OFF_X2 = OFF_X1 + (size_t)NTOK * DM * 4;
constexpr size_t OFF_AFF = OFF_X2 + (size_t)NTOK * DM * 4;
constexpr size_t OFF_IDX = OFF_AFF + (size_t)NE * NTOK * 4;
constexpr size_t OFF_GATE = OFF_IDX + (size_t)NE * CAP * 4;
constexpr size_t OFF_SLOT = OFF_GATE + (size_t)NE * CAP * 4;
constexpr size_t OFF_ACT = OFF_SLOT + (size_t)NTOK * NE * 4;
constexpr size_t OFF_YE = OFF_ACT + (size_t)NE * CAP * FF * 2;
constexpr size_t OFF_OCAT = OFF_YE + (size_t)NE * CAP * DM * 2;
constexpr size_t OFF_CQ = OFF_OCAT + (size_t)NTOK * DM * 2;
constexpr size_t OFF_CKV = OFF_CQ + (size_t)NTOK * 512 * 2;
constexpr size_t OFF_PSQ = OFF_CKV + (size_t)NKEY * 256 * 2;
constexpr size_t OFF_KR = OFF_PSQ + al256((size_t)NKEY * 24 * 4);
constexpr size_t OFF_QNA = OFF_KR + (size_t)NKEY * 64 * 2;
constexpr size_t OFF_KNA = OFF_QNA + (size_t)NH * NTOK * 128 * 2;
constexpr size_t OFF_VNA = OFF_KNA + (size_t)NH * NKEY * 128 * 2;
constexpr size_t OFF_Q = OFF_VNA + (size_t)NH * NKEY * 128 * 2;
constexpr size_t OFF_KN = OFF_Q + (size_t)NH * NTOK * 192 * 2;
constexpr size_t OFF_V = OFF_KN + (size_t)NH * NKEY * 128 * 2;
constexpr size_t WS_END = OFF_V + (size_t)NH * NKEY * 128 * 2;

struct Params {
    const float *x, *c, *ctx, *c_ctx, *ada_w, *ada_b, *g_mix, *g_ffn, *g_final, *w_in, *g_qn, *w_uq, *g_kvn, *w_ukv,
        *na_bias, *w_out_attn, *w_out_fourier, *w_router, *w_gate, *w_up, *w_down;
    float* out;
    char* ws;
};

__device__ __forceinline__ unsigned cvtpk(float lo, float hi) {
    unsigned r; asm volatile("v_cvt_pk_bf16_f32 %0, %1, %2" : "=v"(r) : "v"(lo), "v"(hi)); return r;
}
__device__ __forceinline__ u32x2 pack8_fp8(const f32x4& a, const f32x4& b, float sc) {
    int lo = 0, hi = 0;
    lo = __builtin_amdgcn_cvt_pk_fp8_f32(a[0] * sc, a[1] * sc, lo, false); lo = __builtin_amdgcn_cvt_pk_fp8_f32(a[2] * sc, a[3] * sc, lo, true);
    hi = __builtin_amdgcn_cvt_pk_fp8_f32(b[0] * sc, b[1] * sc, hi, false); hi = __builtin_amdgcn_cvt_pk_fp8_f32(b[2] * sc, b[3] * sc, hi, true);
    u32x2 w; w.x = (unsigned)lo; w.y = (unsigned)hi; return w;
}
__device__ __forceinline__ float fp8_to_f(unsigned char b) { return __builtin_amdgcn_cvt_f32_fp8((int)b, 0); }
constexpr float Q8_SC = 4.f, K8_SC = 0.25f;
__device__ __forceinline__ float bf2f(bf16_t b) { return __uint_as_float(((unsigned)b) << 16); }
__device__ __forceinline__ bf16_t f2bf(float f) { return (bf16_t)(cvtpk(f, 0.f) & 0xffffu); }
template <int CTRL> __device__ __forceinline__ float dpp_add(float v) { return v + __int_as_float(__builtin_amdgcn_update_dpp(0, __float_as_int(v), CTRL, 0xf, 0xf, true)); }
__device__ __forceinline__ float wave_sum(float v) {
    v = dpp_add<0xB1>(v);
    v = dpp_add<0x4E>(v);
    v = dpp_add<0x141>(v);
    v = dpp_add<0x140>(v);
    { auto rr = __builtin_amdgcn_permlane16_swap(__float_as_uint(v), __float_as_uint(v), false, false); v = __uint_as_float(rr[0]) + __uint_as_float(rr[1]); }
    { auto rr = __builtin_amdgcn_permlane32_swap(__float_as_uint(v), __float_as_uint(v), false, false); v = __uint_as_float(rr[0]) + __uint_as_float(rr[1]); }
    return v;
}
extern __shared__ __attribute__((aligned(16))) char g_smem[];
constexpr int LDS_STAGE = 131072, LDS_XBW = LDS_STAGE + 512, LDS_WTAB = LDS_XBW + 16, LDS_BYTES = LDS_XBW + 16 + 512;
__device__ __forceinline__ unsigned hw_slot() { return (unsigned)__builtin_amdgcn_s_getreg((5 << 11) | 4) & 63u; }
__device__ __forceinline__ void ltid_init() { const int t = threadIdx.x; volatile int* tab = (volatile int*)(g_smem + LDS_WTAB);
    if ((t & 63) == 0) { tab[hw_slot()] = t >> 6; tab[72 + (t >> 6)] = (int)(hw_slot() >> 4); } if (t == 0) tab[64] = 0; __syncthreads(); }
__device__ __forceinline__ int wave_rank(int wid) { volatile int* tab = (volatile int*)(g_smem + LDS_WTAB); const int my = tab[72 + wid]; int r = 0;
    for (int w = 0; w < 8; ++w) r += (w < wid && tab[72 + w] == my) ? 1 : 0; return __builtin_amdgcn_readfirstlane(r & 1); }
__device__ __forceinline__ int ltid() {
    int w = ((volatile int*)(g_smem + LDS_WTAB))[hw_slot()];
    w = __builtin_amdgcn_readfirstlane(w);
    unsigned ones_ = ~0u; asm volatile("" : "+s"(ones_));
    const int lane = __builtin_amdgcn_mbcnt_hi(ones_, __builtin_amdgcn_mbcnt_lo(ones_, 0u));
    int t = w * 64 + lane; asm volatile("" : "+v"(t)); return t;
}
__device__ __forceinline__ int lbid() { int t = blockIdx.x; asm volatile("" : "+s"(t)); return t; }
__device__ __forceinline__ float siluf(float v) { return v / (1.f + __expf(-v)); }

#define XB_TMO      128
#define XB_XCNT(j)  (256  + 64 * (j))
#define XB_XSUB(j)  (1280 + 64 * (j))
#define XB_XGEN(j)  (2304 + 64 * (j))
#define XB_TOP      3328
#define XB_TOPGEN   3392
#define XCD_BAR_WORDS 3456
#define XB_SPIN_CAP (1u << 18)
__device__ __forceinline__ unsigned xb_ld(unsigned* p)              { return __hip_atomic_load(p, __ATOMIC_RELAXED, __HIP_MEMORY_SCOPE_AGENT); }
__device__ __forceinline__ unsigned xb_add(unsigned* p, unsigned v) { return __hip_atomic_fetch_add(p, v, __ATOMIC_RELAXED, __HIP_MEMORY_SCOPE_AGENT); }
__device__ __forceinline__ unsigned xb_xcc_id() { return (unsigned)__builtin_amdgcn_s_getreg((3 << 11) | 20) & 0xFu; }
#define XB_SPIN(cond, bar) do { unsigned _sp = 0; while (cond) { __builtin_amdgcn_s_sleep(1); \
    if ((++_sp & 255u) == 0u) { if (xb_ld(&(bar)[XB_TMO])) break; if (_sp > XB_SPIN_CAP) { atomicAdd(&(bar)[XB_TMO], 1u); break; } } } } while (0)
struct XcdBarrier { unsigned* bar; unsigned x; volatile LAS unsigned* st; };
__device__ __forceinline__ XcdBarrier xcd_barrier_post(unsigned* bar, volatile LAS unsigned* st) {
    XcdBarrier b; b.bar = bar; b.x = xb_xcc_id(); b.st = st;
    if (ltid() == 0) (void)xb_add(&bar[XB_XCNT(b.x)], 1u);
    return b;
}
__device__ __forceinline__ void xcd_barrier_complete(unsigned* bar, unsigned x, unsigned& nloc, unsigned& nx) {
    const unsigned G = gridDim.x * gridDim.y * gridDim.z;
    unsigned sum, cnt, mine, sp = 0u;
    for (;;) {
        sum = 0u; cnt = 0u; mine = 0u;
#pragma unroll
        for (unsigned j = 0; j < 16; ++j) { const unsigned c = xb_ld(&bar[XB_XCNT(j)]); sum += c; cnt += (c > 0u) ? 1u : 0u; mine = (j == x) ? c : mine; }
        if (sum == G) break;
        __builtin_amdgcn_s_sleep(1);
        if ((++sp & 255u) == 0u) { if (xb_ld(&bar[XB_TMO])) break; if (sp > XB_SPIN_CAP) { atomicAdd(&bar[XB_TMO], 1u); break; } }
    }
    nloc = mine > 0u ? mine : 1u; nx = cnt > 0u ? cnt : 1u;
}
__device__ __forceinline__ void xcd_barrier(const XcdBarrier& b) {
    asm volatile("s_waitcnt vmcnt(0)" ::: "memory");
    __syncthreads();
    if (ltid() == 0) {
        unsigned* bar = b.bar;
        __builtin_amdgcn_s_waitcnt(0);
        unsigned nloc = b.st[0], nx = b.st[1];
        if (nloc == 0u) { xcd_barrier_complete(bar, b.x, nloc, nx); b.st[0] = nloc; b.st[1] = nx; }
        const unsigned old = xb_add(&bar[XB_XSUB(b.x)], 1u);
        const unsigned gen = old / nloc;
        if (old + 1u == (gen + 1u) * nloc) {
            __builtin_amdgcn_fence(__ATOMIC_RELEASE, "agent");
            asm volatile("s_waitcnt vmcnt(0)" ::: "memory");
            const unsigned og = xb_add(&bar[XB_TOP], 1u);
            const unsigned tg = og / nx;
            if (og + 1u == (tg + 1u) * nx) xb_add(&bar[XB_TOPGEN], 1u);
            else XB_SPIN(xb_ld(&bar[XB_TOPGEN]) == tg, bar);
            __builtin_amdgcn_fence(__ATOMIC_ACQUIRE, "agent");
            xb_add(&bar[XB_XGEN(b.x)], 1u);
            asm volatile("s_waitcnt vmcnt(0)" ::: "memory");
        } else {
            XB_SPIN(xb_ld(&bar[XB_XGEN(b.x)]) == gen, bar);
            __builtin_amdgcn_fence(__ATOMIC_ACQUIRE, "agent");
            asm volatile("s_waitcnt vmcnt(0)" ::: "memory");
        }
    }
    __syncthreads();
}

namespace pg8 {
constexpr int BM = 256, BK = 64, HALF = 128, HTB = HALF * BK * 2, STAGE_BYTES = 8 * HTB, NXCD = 8, WGM = 8;
__host__ __device__ __forceinline__ int lds_byte(int r, int c) { const int st = (r >> 4) * 2 + (c >> 5), rr = r & 15, cc = c & 31, ob = rr * 64 + cc * 2; return st * 1024 + (ob ^ (((ob >> 9) & 1) << 5)); }
__host__ __device__ __forceinline__ void stage_rc(int b, int& R, int& C) { const int st = b / 1024, sb = b % 1024, swz = sb ^ (((sb >> 9) & 1) << 5); R = (st >> 1) * 16 + swz / 64; C = (st & 1) * 32 + (swz % 64) / 2; }
__host__ __device__ __forceinline__ int perm32(int rho) { const int n = rho >> 4, i = rho & 15; return 8 * (i >> 2) + 4 * n + (i & 3); }
struct Unit { int pm, pn; };
struct StaticOrder {
    int nM, nN, nwg, G, c, fpm = -1, fpn = 0;
    __device__ void init(int nM_, int nN_, int G_, int c_) { nM = nM_; nN = nN_; nwg = nM * nN; G = G_; c = c_; fpm = -1; }
    __device__ void init_one(int pm_, int pn_) { fpm = pm_; fpn = pn_; }
    __device__ bool next(int i, Unit& u) const {
        if (fpm >= 0) { if (i) return false; u.pm = fpm; u.pn = fpn; return true; }
        const long L = (long)i * G + c; if (L >= nwg) return false;
        int wgid = (int)L; { const int q = nwg / NXCD, r = nwg % NXCD, xcd = wgid % NXCD, off = wgid / NXCD; wgid = (xcd < r ? xcd * (q + 1) : r * (q + 1) + (xcd - r) * q) + off; }
        const int nig = WGM * nN, gid = wgid / nig, fm = gid * WGM, gsz = (nM - fm) < WGM ? (nM - fm) : WGM;
        u.pm = fm + ((wgid % nig) % gsz); u.pn = (wgid % nig) / gsz; return true;
    }
};

__device__ __forceinline__ i32x8 pg8_cat(bf16x8 a, bf16x8 b) { const u32x4 x = __builtin_bit_cast(u32x4, a), y = __builtin_bit_cast(u32x4, b);
    return (i32x8){(int)x.x, (int)x.y, (int)x.z, (int)x.w, (int)y.x, (int)y.y, (int)y.z, (int)y.w}; }
template <class Desc, class Epi>
__device__ __forceinline__ void gemm_phase(LAS unsigned char* lds, const Desc& D, const StaticOrder& S, const Epi& E) {
    const int tid = ltid(), wid = __builtin_amdgcn_readfirstlane(tid >> 6), lane = tid & 63, wr = wid >> 2, wc = wid & 3, fr = lane & 15, fq = lane >> 4;
    const int K = D.K, nt = K / BK;
    int sR[2], sC[2];
    unsigned voffA[2][2], voffB[2][2], nvA[2][2];
#pragma unroll
    for (int i = 0; i < 2; ++i) { stage_rc(tid * 16 + i * 8192, sR[i], sC[i]);
        const int Rb = Epi::PERM ? ((sR[i] & ~31) + perm32(sR[i] & 31)) : sR[i];
#pragma unroll
        for (int h = 0; h < 2; ++h) { voffA[h][i] = D.arow(sR[i] + HALF * h) + (unsigned)sC[i] * 2u; voffB[h][i] = D.brow(Rb + HALF * h) + (unsigned)sC[i] * 2u; nvA[h][i] = voffA[h][i]; } }
    const size_t kstep = (size_t)(BK * 2);
    const unsigned ldsw = (unsigned)wid * 1024u;
    const int aoff = lds_byte(wr * 64 + fr, fq * 8), boff = lds_byte(wc * 32 + fr, fq * 8);
    const int aoff8 = lds_byte(wr * 64 + fr, fq * 16) | ((fq & 1) << 4), boff8 = lds_byte(wc * 32 + fr, fq * 16) | ((fq & 1) << 4);
#define PG8_SA(b, h) (((b) * 2 + (h)) * HTB)
#define PG8_SB(b, h) ((4 + (b) * 2 + (h)) * HTB)
#define PG8_STAGE(bufoff, gbase, voff) do { _Pragma("unroll") for (int _i = 0; _i < 2; ++_i) \
        __builtin_amdgcn_global_load_lds((const unsigned*)((const char*)(gbase) + (voff)[_i]), (LAS unsigned*)(lds + (bufoff) + ldsw + _i * 8192), 16, 0, 0); } while (0)
#define PG8_LD8(p_, q_) pg8_cat(*(const LAS bf16x8*)(p_), *(const LAS bf16x8*)(q_))
#define PG8_LDA(dst, b, h) do { if constexpr (Desc::FP8) { int aoff8x = aoff8; asm volatile("v_xor_b32 %0, 16, %0" : "+v"(aoff8x)); _Pragma("unroll") for (int m = 0; m < 4; ++m) dst##8[m] = PG8_LD8(lds + PG8_SA(b, h) + aoff8 + m * 2048, lds + PG8_SA(b, h) + aoff8x + m * 2048); } else { \
        _Pragma("unroll") for (int m = 0; m < 4; ++m) _Pragma("unroll") for (int k = 0; k < 2; ++k) dst[m][k] = *(const LAS bf16x8*)(lds + PG8_SA(b, h) + aoff + m * 2048 + k * 1024); } } while (0)
#define PG8_LDB(dst, b, h) do { if constexpr (Desc::FP8) { int boff8x = boff8; asm volatile("v_xor_b32 %0, 16, %0" : "+v"(boff8x)); _Pragma("unroll") for (int n = 0; n < 2; ++n) dst##8[n] = PG8_LD8(lds + PG8_SB(b, h) + boff8 + n * 2048, lds + PG8_SB(b, h) + boff8x + n * 2048); } else { \
        _Pragma("unroll") for (int n = 0; n < 2; ++n) _Pragma("unroll") for (int k = 0; k < 2; ++k) dst[n][k] = *(const LAS bf16x8*)(lds + PG8_SB(b, h) + boff + n * 2048 + k * 1024); } } while (0)
#define PG8_CAT(x) pg8_cat((x)[0], (x)[1])
#define PG8_MMA(ai, bj, At, Bt) do { __builtin_amdgcn_s_setprio(1); if constexpr (Desc::FP8) { _Pragma("unroll") for (int m = 0; m < 4; ++m) _Pragma("unroll") for (int n = 0; n < 2; ++n) \
        asm volatile("v_mfma_scale_f32_16x16x128_f8f6f4 %0, %1, %2, %0, %3, %3 op_sel_hi:[0,0,0]" : "+v"(acc[ai][bj][m][n]) : "v"(Bt##8[n]), "v"(At##8[m]), "v"(scl1)); } else { \
        _Pragma("unroll") for (int m = 0; m < 4; ++m) _Pragma("unroll") for (int n = 0; n < 2; ++n) _Pragma("unroll") for (int k = 0; k < 2; ++k) \
        acc[ai][bj][m][n] = __builtin_amdgcn_mfma_f32_16x16x32_bf16(Bt[n][k], At[m][k], acc[ai][bj][m][n], 0, 0, 0); } __builtin_amdgcn_s_setprio(0); } while (0)
#define PG8_WAIT_V(n) asm volatile("s_waitcnt vmcnt(" #n ")" ::: "memory")
#define PG8_WAIT_L(n) asm volatile("s_waitcnt lgkmcnt(" #n ")" ::: "memory")
#define PG8_BAR __builtin_amdgcn_s_barrier()
#define PG8_SCHED __builtin_amdgcn_sched_barrier(0)
    Unit cur, nxt; int ui = 0;
    if (!S.next(0, cur)) return;
    f32x4 acc[2][2][4][2];
#pragma unroll
    for (int a = 0; a < 2; ++a)
#pragma unroll
        for (int b = 0; b < 2; ++b)
#pragma unroll
            for (int m = 0; m < 4; ++m)
#pragma unroll
                for (int n = 0; n < 2; ++n) acc[a][b][m][n] = (f32x4){0.f, 0.f, 0.f, 0.f};
    bf16x8 At[4][2], B0[2][2], B1[2][2]; i32x8 At8[4], B08[2], B18[2];
    const int scl1 = 0x7f7f7f7f;
    if constexpr (Desc::GATHER) {
#pragma unroll
        for (int i = 0; i < 2; ++i)
#pragma unroll
            for (int h = 0; h < 2; ++h) { voffA[h][i] = D.agather(cur, sR[i] + HALF * h) + (unsigned)sC[i] * 2u; nvA[h][i] = voffA[h][i]; }
    }
    const char* cA = D.A + D.abase(cur); const char* cB = D.B + D.bbase(cur);
    PG8_STAGE(PG8_SB(0, 0), cB, voffB[0]); PG8_STAGE(PG8_SA(0, 0), cA, voffA[0]); PG8_STAGE(PG8_SB(0, 1), cB, voffB[1]); PG8_STAGE(PG8_SA(0, 1), cA, voffA[1]);
    if (wr == 1) PG8_BAR;
    PG8_WAIT_V(4); PG8_BAR;
    PG8_STAGE(PG8_SB(1, 0), cB + kstep, voffB[0]); PG8_STAGE(PG8_SA(1, 0), cA + kstep, voffA[0]); PG8_STAGE(PG8_SB(1, 1), cB + kstep, voffB[1]);
    PG8_WAIT_V(6); PG8_BAR;
    for (;;) {
        const bool has_next = S.next(ui + 1, nxt);
        const char* nA = has_next ? D.A + D.abase(nxt) : cA; const char* nB = has_next ? D.B + D.bbase(nxt) : cB;
        for (int t = 0; t < nt; t += 2) {
            const bool last = (t == nt - 2);
            const char* a1 = cA + (size_t)(t + 1) * kstep;
            const char* a2 = last ? nA : cA + (size_t)(t + 2) * kstep; const char* b2 = last ? nB : cB + (size_t)(t + 2) * kstep;
            const char* a3 = a2 + kstep; const char* b3 = b2 + kstep;
            if constexpr (Desc::GATHER) {
                if (last && has_next) {
#pragma unroll
                    for (int i = 0; i < 2; ++i)
#pragma unroll
                        for (int h = 0; h < 2; ++h) nvA[h][i] = D.agather(nxt, sR[i] + HALF * h) + (unsigned)sC[i] * 2u;
                }
            }
            unsigned va2[2][2];
#pragma unroll
            for (int i = 0; i < 2; ++i)
#pragma unroll
                for (int h = 0; h < 2; ++h) va2[h][i] = (Desc::GATHER && last) ? nvA[h][i] : voffA[h][i];
            PG8_LDB(B0, 0, 0); PG8_SCHED; PG8_LDA(At, 0, 0); PG8_STAGE(PG8_SA(1, 1), a1, voffA[1]);
            PG8_WAIT_L(8); PG8_BAR; PG8_WAIT_L(0); PG8_MMA(0, 0, At, B0); PG8_BAR; PG8_SCHED;
            PG8_LDB(B1, 0, 1); PG8_STAGE(PG8_SB(0, 0), b2, voffB[0]);
            PG8_BAR; PG8_WAIT_L(0); PG8_MMA(0, 1, At, B1); PG8_BAR;
            PG8_LDA(At, 0, 1); PG8_STAGE(PG8_SA(0, 0), a2, va2[0]);
            PG8_BAR; PG8_WAIT_L(0); PG8_MMA(1, 0, At, B0); PG8_BAR; PG8_SCHED;
            PG8_STAGE(PG8_SB(0, 1), b2, voffB[1]);
            PG8_WAIT_V(6); PG8_BAR; PG8_MMA(1, 1, At, B1); PG8_BAR;
            PG8_LDB(B0, 1, 0); PG8_SCHED; PG8_LDA(At, 1, 0); PG8_STAGE(PG8_SA(0, 1), a2, va2[1]);
            PG8_WAIT_L(8); PG8_BAR; PG8_WAIT_L(0); PG8_MMA(0, 0, At, B0); PG8_BAR; PG8_SCHED;
            PG8_LDB(B1, 1, 1); PG8_STAGE(PG8_SB(1, 0), b3, voffB[0]);
            PG8_BAR; PG8_WAIT_L(0); PG8_MMA(0, 1, At, B1); PG8_BAR;
            PG8_LDA(At, 1, 1); PG8_STAGE(PG8_SA(1, 0), a3, va2[0]);
            PG8_BAR; PG8_WAIT_L(0); PG8_MMA(1, 0, At, B0); PG8_BAR; PG8_SCHED;
            PG8_STAGE(PG8_SB(1, 1), b3, voffB[1]);
            PG8_WAIT_V(6); PG8_BAR; PG8_MMA(1, 1, At, B1); PG8_BAR;
        }
        if constexpr (Desc::FP8) asm volatile("s_nop 15\n\ts_nop 15" ::: "memory");
        E(acc, cur, wr, wc, fr, fq);
        if (!has_next) break;
#pragma unroll
        for (int a = 0; a < 2; ++a)
#pragma unroll
            for (int b = 0; b < 2; ++b)
#pragma unroll
                for (int m = 0; m < 4; ++m)
#pragma unroll
                    for (int n = 0; n < 2; ++n) acc[a][b][m][n] = (f32x4){0.f, 0.f, 0.f, 0.f};
        cur = nxt; cA = nA; cB = nB; ++ui;
        if constexpr (Desc::GATHER) {
#pragma unroll
            for (int i = 0; i < 2; ++i)
#pragma unroll
                for (int h = 0; h < 2; ++h) voffA[h][i] = nvA[h][i];
        }
    }
    PG8_WAIT_V(0);
    if (wr == 0) PG8_BAR;
    PG8_BAR;
#undef PG8_SA
#undef PG8_SB
#undef PG8_STAGE
#undef PG8_LDA
#undef PG8_LD8
#undef PG8_LDB
#undef PG8_MMA
#undef PG8_CAT
#undef PG8_WAIT_V
#undef PG8_WAIT_L
#undef PG8_BAR
#undef PG8_SCHED
}
}
using pg8::Unit;

struct DescPlain {
    static constexpr bool FP8 = false;
    static constexpr bool GATHER = false;
    const char* A; const char* B; int K; int lda, ldb;
    __device__ __forceinline__ size_t abase(const Unit& u) const { return (size_t)u.pm * 256 * lda * 2; }
    __device__ __forceinline__ size_t bbase(const Unit& u) const { return (size_t)u.pn * 256 * ldb * 2; }
    __device__ __forceinline__ unsigned arow(int r) const { return (unsigned)(r * lda) * 2u; }
    __device__ __forceinline__ unsigned brow(int r) const { return (unsigned)(r * ldb) * 2u; }
    __device__ __forceinline__ unsigned agather(const Unit&, int) const { return 0u; }
};
struct DescPlainF8 {
    static constexpr bool GATHER = false, FP8 = true;
    const char* A; const char* B; int K; int lda, ldb;
    __device__ __forceinline__ size_t abase(const Unit& u) const { return (size_t)u.pm * 256 * lda; }
    __device__ __forceinline__ size_t bbase(const Unit& u) const { return (size_t)u.pn * 256 * ldb; }
    __device__ __forceinline__ unsigned arow(int r) const { return (unsigned)(r * lda); }
    __device__ __forceinline__ unsigned brow(int r) const { return (unsigned)(r * ldb); }
    __device__ __forceinline__ unsigned agather(const Unit&, int) const { return 0u; }
};
struct DescMoe1 {
    static constexpr bool FP8 = false;
    static constexpr bool GATHER = true;
    const char* A; const char* B; int K; const int* idx;
    __device__ __forceinline__ size_t abase(const Unit&) const { return 0; }
    __device__ __forceinline__ size_t bbase(const Unit& u) const { return ((size_t)(u.pm >> 3) * 4096 + (size_t)u.pn * 256) * DM * 2; }
    __device__ __forceinline__ unsigned arow(int) const { return 0u; }
    __device__ __forceinline__ unsigned brow(int r) const { return (unsigned)(r * DM) * 2u; }
    __device__ __forceinline__ unsigned agather(const Unit& u, int r) const { return (unsigned)idx[u.pm * 256 + r] * (unsigned)(DM * 2); }
};
struct DescMoe1F8 {
    static constexpr bool GATHER = true, FP8 = true;
    const char* A; const char* B; int K; const int* idx;
    __device__ __forceinline__ size_t abase(const Unit&) const { return 0; }
    __device__ __forceinline__ size_t bbase(const Unit& u) const { return ((size_t)(u.pm >> 3) * 4096 + (size_t)u.pn * 256) * DM; }
    __device__ __forceinline__ unsigned arow(int) const { return 0u; }
    __device__ __forceinline__ unsigned brow(int r) const { return (unsigned)(r * DM); }
    __device__ __forceinline__ unsigned agather(const Unit& u, int r) const { return (unsigned)idx[u.pm * 256 + r] * (unsigned)DM; }
};
struct DescMoe2 {
    static constexpr bool FP8 = false;
    static constexpr bool GATHER = false;
    const char* A; const char* B; int K;
    __device__ __forceinline__ size_t abase(const Unit& u) const { return (size_t)u.pm * 256 * FF * 2; }
    __device__ __forceinline__ size_t bbase(const Unit& u) const { return ((size_t)(u.pm >> 3) * 2048 + (size_t)u.pn * 256) * FF * 2; }
    __device__ __forceinline__ unsigned arow(int r) const { return (unsigned)(r * FF) * 2u; }
    __device__ __forceinline__ unsigned brow(int r) const { return (unsigned)(r * FF) * 2u; }
    __device__ __forceinline__ unsigned agather(const Unit&, int) const { return 0u; }
};
struct DescMoe2F8 {
    static constexpr bool GATHER = false, FP8 = true;
    const char* A; const char* B; int K;
    __device__ __forceinline__ size_t abase(const Unit& u) const { return (size_t)u.pm * 256 * FF; }
    __device__ __forceinline__ size_t bbase(const Unit& u) const { return ((size_t)(u.pm >> 3) * 2048 + (size_t)u.pn * 256) * FF; }
    __device__ __forceinline__ unsigned arow(int r) const { return (unsigned)(r * FF); }
    __device__ __forceinline__ unsigned brow(int r) const { return (unsigned)(r * FF); }
    __device__ __forceinline__ unsigned agather(const Unit&, int) const { return 0u; }
};
struct DescF1 {
    static constexpr bool FP8 = false;
    static constexpr bool GATHER = false;
    const char* A; const char* B; int K;
    __device__ __forceinline__ size_t abase(const Unit& u) const { return (size_t)u.pm * 256 * 256 * 2; }
    __device__ __forceinline__ size_t bbase(const Unit& u) const { const int g = u.pn >> 6, pp = u.pn & 63; return ((size_t)(2 * pp) * DM + (size_t)g * 256) * 2; }
    __device__ __forceinline__ unsigned arow(int r) const { return (unsigned)(r * 256) * 2u; }
    __device__ __forceinline__ unsigned brow(int r) const { return (unsigned)((128 * (r & 127) + (r >> 7)) * DM) * 2u; }
    __device__ __forceinline__ unsigned agather(const Unit&, int) const { return 0u; }
};

__device__ __forceinline__ u32x4 pack8(const f32x4& a, const f32x4& b, float s) {
    u32x4 w; w.x = cvtpk(a[0] * s, a[1] * s); w.y = cvtpk(a[2] * s, a[3] * s); w.z = cvtpk(b[0] * s, b[1] * s); w.w = cvtpk(b[2] * s, b[3] * s); return w;
}
struct EpiInproj {
    static constexpr bool PERM = true;
    bf16_t *cq, *ckv, *kr, *qna, *kna, *vna; float* psq; const float* rope; float isc; int row0;
    __device__ __forceinline__ void operator()(const f32x4 (&acc)[2][2][4][2], const Unit& u, int wr, int wc, int fr, int fq) const {
        const int pn = u.pn;
#pragma unroll
        for (int ai = 0; ai < 2; ++ai)
#pragma unroll
            for (int m = 0; m < 4; ++m) {
                const int row = row0 + u.pm * 256 + ai * 128 + wr * 64 + m * 16 + fr;
                const bool lat = row >= NCTX;
#pragma unroll
                for (int bj = 0; bj < 2; ++bj) {
                    const f32x4 v0 = acc[ai][bj][m][0] * isc, v1 = acc[ai][bj][m][1] * isc;
                    const int cl = bj * 128 + wc * 32 + fq * 8;
                    if (pn <= 2) {
                        float ss = v0[0] * v0[0] + v0[1] * v0[1] + v0[2] * v0[2] + v0[3] * v0[3] + v1[0] * v1[0] + v1[1] * v1[1] + v1[2] * v1[2] + v1[3] * v1[3];
                        { auto r16 = __builtin_amdgcn_permlane16_swap(__float_as_uint(ss), __float_as_uint(ss), false, false); ss = __uint_as_float(r16[0]) + __uint_as_float(r16[1]); }
                        { auto r32 = __builtin_amdgcn_permlane32_swap(__float_as_uint(ss), __float_as_uint(ss), false, false); ss = __uint_as_float(r32[0]) + __uint_as_float(r32[1]); }
                        if (fq == 0) psq[(size_t)row * 24 + pn * 8 + bj * 4 + wc] = ss;
#if ATTG_FP8
                        if (pn < 2) { if (lat) *(u32x2*)((unsigned char*)cq + (size_t)(row - NCTX) * 512 + pn * 256 + cl) = pack8_fp8(v0, v1, 1.f); }
                        else *(u32x2*)((unsigned char*)ckv + (size_t)row * 256 + cl) = pack8_fp8(v0, v1, 1.f);
#else
                        if (pn < 2) { if (lat) *(u32x4*)(cq + (size_t)(row - NCTX) * 512 + pn * 256 + cl) = pack8(v0, v1, 1.f); }
                        else *(u32x4*)(ckv + (size_t)row * 256 + cl) = pack8(v0, v1, 1.f);
#endif
                    } else if (pn <= 6) {
                        const int h = 2 * (pn - 3) + bj, d = wc * 32 + fq * 8;
                        if (lat) *(u32x4*)(qna + ((size_t)h * NTOK + (row - NCTX)) * 128 + d) = pack8(v0, v1, NA_QS);
                    } else if (pn <= 10) {
                        const int h = 2 * (pn - 7) + bj, d = wc * 32 + fq * 8;
                        *(u32x4*)(kna + ((size_t)h * NKEY + row) * 128 + d) = pack8(v0, v1, 1.f);
                    } else if (pn <= 14) {
                        const int h = 2 * (pn - 11) + bj, d = wc * 32 + fq * 8;
                        *(u32x4*)(vna + ((size_t)h * NKEY + row) * 128 + d) = pack8(v0, v1, 1.f);
                    } else if (bj == 0 && wc < 2) {
                        f32x4 o0 = v0, o1 = v1;
                        if (lat) {
                            const int n = row - NCTX, pos = wc == 0 ? (n >> 6) : (n & 63);
                            const f32x4 cs0 = *(const f32x4*)(rope + (pos * 16 + fq * 4) * 2), cs1 = *(const f32x4*)(rope + (pos * 16 + fq * 4 + 2) * 2);
                            o0[0] = v0[0] * cs0[0] - v0[1] * cs0[1]; o0[1] = v0[1] * cs0[0] + v0[0] * cs0[1];
                            o0[2] = v0[2] * cs0[2] - v0[3] * cs0[3]; o0[3] = v0[3] * cs0[2] + v0[2] * cs0[3];
                            o1[0] = v1[0] * cs1[0] - v1[1] * cs1[1]; o1[1] = v1[1] * cs1[0] + v1[0] * cs1[1];
                            o1[2] = v1[2] * cs1[2] - v1[3] * cs1[3]; o1[3] = v1[3] * cs1[2] + v1[2] * cs1[3];
                        }
#if MLA_FP8
                        *(u32x2*)((unsigned char*)kr + (size_t)row * 64 + wc * 32 + fq * 8) = pack8_fp8(o0, o1, K8_SC);
#else
                        *(u32x4*)(kr + (size_t)row * 64 + wc * 32 + fq * 8) = pack8(o0, o1, 1.f);
#endif
                    }
                }
            }
    }
};
__device__ __forceinline__ float rstd_from_psq(const float* p, int cnt, float inv_n) {
    float s = 0.f;
    for (int i = 0; i < cnt; i += 4) { const f32x4 v = *(const f32x4*)(p + i); s += v[0] + v[1] + v[2] + v[3]; }
    return rsqrtf(s * inv_n + EPS);
}
struct EpiUq {
    static constexpr bool PERM = true;
    bf16_t* q; const float* psq; const float* rope; float isc;
    __device__ __forceinline__ void operator()(const f32x4 (&acc)[2][2][4][2], const Unit& u, int wr, int wc, int fr, int fq) const {
        const int pn = u.pn;
#pragma unroll
        for (int ai = 0; ai < 2; ++ai)
#pragma unroll
            for (int m = 0; m < 4; ++m) {
                const int row = u.pm * 256 + ai * 128 + wr * 64 + m * 16 + fr;
                const float rs = rstd_from_psq(psq + (size_t)(row + NCTX) * 24, 16, 1.f / 512.f) * isc;
#pragma unroll
                for (int bj = 0; bj < 2; ++bj) {
                    const f32x4 v0 = acc[ai][bj][m][0] * rs, v1 = acc[ai][bj][m][1] * rs;
                    if (pn < 4) {
                        const int h = 2 * pn + bj, d = wc * 32 + fq * 8;
#if MLA_FP8
                        *(u32x2*)((unsigned char*)q + ((size_t)h * NTOK + row) * 192 + d) = pack8_fp8(v0, v1, MLA_QS * Q8_SC);
#else
                        *(u32x4*)(q + ((size_t)h * NTOK + row) * 192 + d) = pack8(v0, v1, MLA_QS);
#endif
                    } else {
                        const int h = 4 * (pn - 4) + 2 * bj + (wc >> 1), ax = wc & 1;
                        const int pos = ax == 0 ? (row >> 6) : (row & 63);
                        const f32x4 cs0 = *(const f32x4*)(rope + (pos * 16 + fq * 4) * 2), cs1 = *(const f32x4*)(rope + (pos * 16 + fq * 4 + 2) * 2);
                        f32x4 o0, o1;
                        o0[0] = v0[0] * cs0[0] - v0[1] * cs0[1]; o0[1] = v0[1] * cs0[0] + v0[0] * cs0[1];
                        o0[2] = v0[2] * cs0[2] - v0[3] * cs0[3]; o0[3] = v0[3] * cs0[2] + v0[2] * cs0[3];
                        o1[0] = v1[0] * cs1[0] - v1[1] * cs1[1]; o1[1] = v1[1] * cs1[0] + v1[0] * cs1[1];
                        o1[2] = v1[2] * cs1[2] - v1[3] * cs1[3]; o1[3] = v1[3] * cs1[2] + v1[2] * cs1[3];
#if MLA_FP8
                        *(u32x2*)((unsigned char*)q + ((size_t)h * NTOK + row) * 192 + 128 + ax * 32 + fq * 8) = pack8_fp8(o0, o1, MLA_QS * Q8_SC);
#else
                        *(u32x4*)(q + ((size_t)h * NTOK + row) * 192 + 128 + ax * 32 + fq * 8) = pack8(o0, o1, MLA_QS);
#endif
                    }
                }
            }
    }
};
struct EpiUkv {
    static constexpr bool PERM = true;
    bf16_t *kn, *v; const float* psq; float isc;
    __device__ __forceinline__ void operator()(const f32x4 (&acc)[2][2][4][2], const Unit& u, int wr, int wc, int fr, int fq) const {
        const int pn = u.pn;
#pragma unroll
        for (int ai = 0; ai < 2; ++ai)
#pragma unroll
            for (int m = 0; m < 4; ++m) {
                const int row = u.pm * 256 + ai * 128 + wr * 64 + m * 16 + fr;
                const float rs = rstd_from_psq(psq + (size_t)row * 24 + 16, 8, 1.f / 256.f) * isc;
#pragma unroll
                for (int bj = 0; bj < 2; ++bj) {
                    const int h = 2 * (pn & 3) + bj, d = wc * 32 + fq * 8;
#if MLA_FP8
                    if (pn < 4) { *(u32x2*)((unsigned char*)kn + ((size_t)h * NKEY + row) * 128 + d) = pack8_fp8(acc[ai][bj][m][0], acc[ai][bj][m][1], rs * K8_SC); continue; }
                    else {
                        const int kk = row & 63, r_ = (kk & 3) + 4 * ((kk >> 3) & 3), slot = 32 * ((kk >> 2) & 1) + 16 * (kk >> 5) + r_;
                        unsigned char* vt = (unsigned char*)v + (((size_t)h * (NKEY / 64) + (row >> 6)) * 128 + d) * 64 + slot;
                        const u32x2 w8 = pack8_fp8(acc[ai][bj][m][0], acc[ai][bj][m][1], rs);
#pragma unroll
                        for (int j = 0; j < 8; ++j) vt[j * 64] = (unsigned char)(((j < 4 ? w8.x : w8.y) >> (8 * (j & 3))) & 0xffu);
                        continue; }
#endif
                    bf16_t* dst = (pn < 4 ? kn : v) + ((size_t)h * NKEY + row) * 128 + d;
                    *(u32x4*)dst = pack8(acc[ai][bj][m][0], acc[ai][bj][m][1], rs);
                }
            }
    }
};
#if RES_BF16
typedef bf16_t res_t;
__device__ __forceinline__ f32x4 ldres4(const res_t* q) { const u32x2 w = *(const u32x2*)q;
    return (f32x4){__uint_as_float(w.x << 16), __uint_as_float(w.x & 0xffff0000u), __uint_as_float(w.y << 16), __uint_as_float(w.y & 0xffff0000u)}; }
__device__ __forceinline__ void stres4(res_t* q, const f32x4& v) { u32x2 w; w.x = cvtpk(v[0], v[1]); w.y = cvtpk(v[2], v[3]); *(u32x2*)q = w; }
#else
typedef float res_t;
__device__ __forceinline__ f32x4 ldres4(const res_t* q) { return *(const f32x4*)q; }
__device__ __forceinline__ void stres4(res_t* q, const f32x4& v) { *(f32x4*)q = v; }
#endif
#if RES_BF16
typedef u32x2 resraw_t;
__device__ __forceinline__ resraw_t ldraw4(const res_t* q) { return *(const u32x2*)q; }
__device__ __forceinline__ f32x4 unraw4(const resraw_t& w) { return (f32x4){__uint_as_float(w.x << 16), __uint_as_float(w.x & 0xffff0000u), __uint_as_float(w.y << 16), __uint_as_float(w.y & 0xffff0000u)}; }
#else
typedef f32x4 resraw_t;
__device__ __forceinline__ resraw_t ldraw4(const res_t* q) { return *(const f32x4*)q; }
__device__ __forceinline__ f32x4 unraw4(const resraw_t& w) { return w; }
#endif
template <typename BT>
struct EpiResid {
    static constexpr bool PERM = true;
    res_t* out; const BT* base; const float* gate; float isc;
    __device__ __forceinline__ void operator()(const f32x4 (&acc)[2][2][4][2], const Unit& u, int wr, int wc, int fr, int fq) const {
        const int row0 = u.pm * 256 + wr * 64 + fr, col0 = u.pn * 256 + wc * 32 + 8 * fq;
        f32x4 gv[2][2];
#pragma unroll
        for (int bj = 0; bj < 2; ++bj)
#pragma unroll
            for (int n = 0; n < 2; ++n) gv[bj][n] = *(const f32x4*)(gate + col0 + bj * 128 + n * 4) * isc;
#pragma unroll
        for (int ai = 0; ai < 2; ++ai)
#pragma unroll
            for (int m = 0; m < 4; ++m) { const size_t ro = (size_t)(row0 + ai * 128 + m * 16) * DM + col0;
#pragma unroll
                for (int bj = 0; bj < 2; ++bj) {
                    f32x4 b0, b1;
                    if constexpr (sizeof(BT) == 2) { const u32x4 w = *(const u32x4*)(base + ro + bj * 128);
                        b0 = (f32x4){__uint_as_float(w.x << 16), __uint_as_float(w.x & 0xffff0000u), __uint_as_float(w.y << 16), __uint_as_float(w.y & 0xffff0000u)};
                        b1 = (f32x4){__uint_as_float(w.z << 16), __uint_as_float(w.z & 0xffff0000u), __uint_as_float(w.w << 16), __uint_as_float(w.w & 0xffff0000u)}; }
                    else { b0 = *(const f32x4*)(base + ro + bj * 128); b1 = *(const f32x4*)(base + ro + bj * 128 + 4); }
                    const f32x4 o0 = b0 + gv[bj][0] * acc[ai][bj][m][0], o1 = b1 + gv[bj][1] * acc[ai][bj][m][1];
                    if constexpr (sizeof(res_t) == 2) *(u32x4*)(out + ro + bj * 128) = pack8(o0, o1, 1.f);
                    else { *(f32x4*)(out + ro + bj * 128) = o0; *(f32x4*)(out + ro + bj * 128 + 4) = o1; } } }
    }
};
struct EpiMoe1 {
    static constexpr bool PERM = true;
    bf16_t* act; float isc;
    __device__ __forceinline__ void operator()(const f32x4 (&acc)[2][2][4][2], const Unit& u, int wr, int wc, int fr, int fq) const {
#pragma unroll
        for (int ai = 0; ai < 2; ++ai)
#pragma unroll
            for (int m = 0; m < 4; ++m) {
                const int row = u.pm * 256 + ai * 128 + wr * 64 + m * 16 + fr;
                f32x4 o[2];
#pragma unroll
                for (int n = 0; n < 2; ++n)
#pragma unroll
                    for (int j = 0; j < 4; ++j) { const float g = acc[ai][0][m][n][j] * isc, up = acc[ai][1][m][n][j] * isc;
                        o[n][j] = g * up * __builtin_amdgcn_rcpf(1.f + __builtin_amdgcn_exp2f(-g * LOG2E)); }
#if MOE2_FP8
                *(u32x2*)((unsigned char*)act + (size_t)row * FF + u.pn * 128 + wc * 32 + fq * 8) = pack8_fp8(o[0], o[1], 4.f);
#else
                *(u32x4*)(act + (size_t)row * FF + u.pn * 128 + wc * 32 + fq * 8) = pack8(o[0], o[1], 1.f);
#endif
            }
    }
};
struct EpiMoe2 {
    static constexpr bool PERM = true;
    bf16_t* ye; const float* gate; float isc;
    __device__ __forceinline__ void operator()(const f32x4 (&acc)[2][2][4][2], const Unit& u, int wr, int wc, int fr, int fq) const {
#pragma unroll
        for (int ai = 0; ai < 2; ++ai)
#pragma unroll
            for (int m = 0; m < 4; ++m) {
                const int row = u.pm * 256 + ai * 128 + wr * 64 + m * 16 + fr;
                const float g = gate[row] * isc;
#pragma unroll
                for (int bj = 0; bj < 2; ++bj)
                    *(u32x4*)(ye + (size_t)row * DM + u.pn * 256 + bj * 128 + wc * 32 + fq * 8) = pack8(acc[ai][bj][m][0], acc[ai][bj][m][1], g);
            }
    }
};
struct EpiF1 {
    static constexpr bool PERM = true;
    bf16_t* g1;
    __device__ __forceinline__ void operator()(const f32x4 (&acc)[2][2][4][2], const Unit& u, int wr, int wc, int fr, int fq) const {
        const int g = u.pn >> 6, pp = u.pn & 63, ri = u.pm;
#pragma unroll
        for (int ai = 0; ai < 2; ++ai)
#pragma unroll
            for (int m = 0; m < 4; ++m) {
                const int mm = ai * 128 + wr * 64 + m * 16 + fr;
#pragma unroll
                for (int bj = 0; bj < 2; ++bj) { const int b = 2 * pp + bj;
                    *(u32x4*)(g1 + ((((size_t)(g * 256 + mm) * 128 + b) * 2 + ri) * 128) + wc * 32 + fq * 8) = pack8(acc[ai][bj][m][0], acc[ai][bj][m][1], 1.f); }
            }
    }
};
struct EpiF2A {
    static constexpr bool PERM = true;
    bf16_t* tp; const float* tw;
    __device__ __forceinline__ void operator()(const f32x4 (&acc)[2][2][4][2], const Unit& u, int wr, int wc, int fr, int fq) const {
#pragma unroll
        for (int m = 0; m < 4; ++m) {
            const int k1 = wr * 64 + m * 16 + fr, b0 = wc * 32 + fq * 8;
            const float* t = tw + ((size_t)k1 * 128 + b0) * 2;
            f32x4 cs[4];
#pragma unroll
            for (int j = 0; j < 4; ++j) cs[j] = *(const f32x4*)(t + 4 * j);
#pragma unroll
            for (int bj = 0; bj < 2; ++bj) {
                const int gm = 2 * u.pn + bj;
                f32x4 r0, r1, i0, i1;
#pragma unroll
                for (int j = 0; j < 4; ++j) {
                    const float c_a = cs[j >> 1][(j & 1) * 2], s_a = cs[j >> 1][(j & 1) * 2 + 1];
                    const float c_b = cs[2 + (j >> 1)][(j & 1) * 2], s_b = cs[2 + (j >> 1)][(j & 1) * 2 + 1];
                    const float tr0 = acc[0][bj][m][0][j], ti0 = acc[1][bj][m][0][j], tr1 = acc[0][bj][m][1][j], ti1 = acc[1][bj][m][1][j];
                    r0[j] = c_a * tr0 + s_a * ti0; i0[j] = c_a * ti0 - s_a * tr0;
                    r1[j] = c_b * tr1 + s_b * ti1; i1[j] = c_b * ti1 - s_b * tr1;
                }
                bf16_t* dst = tp + (((size_t)k1 * 2048 + gm) * 2) * 128 + b0;
                *(u32x4*)dst = pack8(r0, r1, 1.f); *(u32x4*)(dst + 128) = pack8(i0, i1, 1.f);
            }
        }
    }
};
struct EpiF2B {
    static constexpr bool PERM = true;
    bf16_t* f;
    __device__ __forceinline__ void operator()(const f32x4 (&acc)[2][2][4][2], const Unit& u, int wr, int wc, int fr, int fq) const {
        const int k1 = u.pn >> 3;
#pragma unroll
        for (int m = 0; m < 4; ++m) {
            const int k2 = wr * 64 + m * 16 + fr;
#pragma unroll
            for (int bj = 0; bj < 2; ++bj)
                *(u32x4*)(f + (size_t)(k1 + 128 * k2) * DM + (u.pn & 7) * 256 + bj * 128 + wc * 32 + fq * 8) = pack8(acc[0][bj][m][0], acc[0][bj][m][1], 1.f);
        }
    }
};

namespace att {
constexpr int QBLK = 32, KVBLK = 64;
constexpr float THR2 = 11.0f;
#define SBAR() __builtin_amdgcn_sched_barrier(0)
__device__ __forceinline__ int crow(int r, int hi) { return (r & 3) + 8 * (r >> 2) + 4 * hi; }
template <int DQK> __device__ __forceinline__ int kswz(int row, int colB) { return row * (DQK * 2 + 16) + colB; }
template <bool F8 = false>
__device__ __forceinline__ void partialSM(f32x16& p0, f32x16& p1, float& m_reg, float& mn, float& alpha) {
    constexpr float THRX = F8 ? 8.0f : THR2;
    float pmax = p0[0];
#pragma unroll
    for (int r = 1; r < 16; ++r) pmax = fmaxf(pmax, p0[r]);
#pragma unroll
    for (int r = 0; r < 16; ++r) pmax = fmaxf(pmax, p1[r]);
    { auto rr = __builtin_amdgcn_permlane32_swap(__float_as_uint(pmax), __float_as_uint(pmax), false, false);
      pmax = fmaxf(__uint_as_float(rr[0]), __uint_as_float(rr[1])); }
    if (__builtin_expect(__all(pmax - m_reg <= THRX), 1)) { mn = m_reg; alpha = 1.f; }
    else { mn = fmaxf(m_reg, pmax); alpha = __builtin_amdgcn_exp2f(m_reg - mn); m_reg = mn; }
#pragma unroll
    for (int r = 0; r < 16; ++r) p0[r] = p0[r] - mn;
#pragma unroll
    for (int r = 0; r < 16; ++r) p1[r] = p1[r] - mn;
#pragma unroll
    for (int r = 0; r < 16; ++r) p0[r] = __builtin_amdgcn_exp2f(p0[r]);
}

__device__ __forceinline__ void partialSM_rel(f32x16& p0, f32x16& p1, float& m_reg, float& alpha, bool first) {
    float pmax = p0[0];
#pragma unroll
    for (int r = 1; r < 16; ++r) pmax = fmaxf(pmax, p0[r]);
#pragma unroll
    for (int r = 0; r < 16; ++r) pmax = fmaxf(pmax, p1[r]);
    { auto rr = __builtin_amdgcn_permlane32_swap(__float_as_uint(pmax), __float_as_uint(pmax), false, false);
      pmax = fmaxf(__uint_as_float(rr[0]), __uint_as_float(rr[1])); }
    if (__builtin_expect(!first && __all(pmax <= 8.0f), 1)) { alpha = 1.f; }
    else { const float d = first ? pmax : fmaxf(pmax, 0.f); alpha = first ? 0.f : __builtin_amdgcn_exp2f(-d); m_reg += d;
#pragma unroll
        for (int r = 0; r < 16; ++r) { p0[r] -= d; p1[r] -= d; } }
#pragma unroll
    for (int r = 0; r < 16; ++r) p0[r] = __builtin_amdgcn_exp2f(p0[r]);
}
__device__ __forceinline__ void finishSM(f32x16& p0, f32x16& p1, float alpha, float& l_reg, bf16x8& pa0, bf16x8& pa1, bf16x8& pa2, bf16x8& pa3) {
#pragma unroll
    for (int r = 0; r < 16; ++r) p1[r] = __builtin_amdgcn_exp2f(p1[r]);
    float ps = 0;
#pragma unroll
    for (int r = 0; r < 16; ++r) ps += p0[r];
#pragma unroll
    for (int r = 0; r < 16; ++r) ps += p1[r];
    { auto rr = __builtin_amdgcn_permlane32_swap(__float_as_uint(ps), __float_as_uint(ps), false, false);
      ps = __uint_as_float(rr[0]) + __uint_as_float(rr[1]); }
    l_reg = l_reg * alpha + ps;
#define PK4(P, BASE, OUT) do { unsigned a0 = cvtpk(P[BASE + 0], P[BASE + 1]), a1 = cvtpk(P[BASE + 2], P[BASE + 3]);   \
    unsigned b0 = cvtpk(P[BASE + 4], P[BASE + 5]), b1 = cvtpk(P[BASE + 6], P[BASE + 7]);                              \
    auto r0 = __builtin_amdgcn_permlane32_swap(a0, b0, false, false); auto r1 = __builtin_amdgcn_permlane32_swap(a1, b1, false, false); \
    u32x4 w = {r0[0], r1[0], r0[1], r1[1]}; OUT = *reinterpret_cast<bf16x8*>(&w); } while (0)
    PK4(p0, 0, pa0); PK4(p0, 8, pa1); PK4(p1, 0, pa2); PK4(p1, 8, pa3);
#undef PK4
}
template <int DQK>
__device__ __forceinline__ void qkt(f32x16& p0, f32x16& p1, const char* Ks, const bf16x8* qr, const char* qx, int r32, int hi) {
    p0 = f32x16{}; p1 = f32x16{};
    const char* kb_ = Ks + r32 * (DQK * 2 + 16) + hi * 16;
#pragma unroll
    for (int d0 = 0; d0 < DQK / 16; ++d0) {
        bf16x8 b0 = *reinterpret_cast<const bf16x8*>(kb_ + d0 * 32);
        bf16x8 b1 = *reinterpret_cast<const bf16x8*>(kb_ + 32 * (DQK * 2 + 16) + d0 * 32);
        const bf16x8 q = d0 < 8 ? qr[d0 < 8 ? d0 : 0] : *reinterpret_cast<const bf16x8*>(qx + (d0 - 8) * 1024);
        p0 = __builtin_amdgcn_mfma_f32_32x32x16_bf16(b0, q, p0, 0, 0, 0);
        p1 = __builtin_amdgcn_mfma_f32_32x32x16_bf16(b1, q, p1, 0, 0, 0); }
}
__device__ __forceinline__ int v_st(int k, int c) { const int kk = (k & ~0xC) | ((k & 4) << 1) | ((k & 8) >> 1); return ((kk >> 3) * 4 + (c >> 5)) * 512 + ((kk & 7) * 32 + (c & 31)) * 2; }
__device__ __forceinline__ int v_rd_base(int lane) { return ((lane & 3) << 3) | (((lane >> 2) & 3) << 6) | (((lane >> 4) & 1) << 5) | (((lane >> 5) & 1) << 8); }
constexpr int v_rd_off(int d0, int ks, int half) { return d0 * 512 + ks * 4096 + half * 2048; }
template <int OFF> __device__ __forceinline__ s16x4 tr_read(int vb) {
    s16x4 r; asm volatile("ds_read_b64_tr_b16 %0, %1 offset:%2" : "=&v"(r) : "v"(vb), "i"(OFF) : "memory"); return r;
}
template <int D0> __device__ __forceinline__ void pv_one(f32x16& od, int vb, bf16x8 pa0, bf16x8 pa1, bf16x8 pa2, bf16x8 pa3) {
    const s16x4 l0 = tr_read<v_rd_off(D0, 0, 0)>(vb), h0 = tr_read<v_rd_off(D0, 0, 1)>(vb), l1 = tr_read<v_rd_off(D0, 1, 0)>(vb), h1 = tr_read<v_rd_off(D0, 1, 1)>(vb);
    const s16x4 l2 = tr_read<v_rd_off(D0, 2, 0)>(vb), h2 = tr_read<v_rd_off(D0, 2, 1)>(vb), l3 = tr_read<v_rd_off(D0, 3, 0)>(vb), h3 = tr_read<v_rd_off(D0, 3, 1)>(vb);
    asm volatile("s_waitcnt lgkmcnt(0)" ::: "memory"); SBAR();
#define PK(L, H) (bf16x8){L[0], L[1], L[2], L[3], H[0], H[1], H[2], H[3]}
    od = __builtin_amdgcn_mfma_f32_32x32x16_bf16(pa0, PK(l0, h0), od, 0, 0, 0);
    od = __builtin_amdgcn_mfma_f32_32x32x16_bf16(pa1, PK(l1, h1), od, 0, 0, 0);
    od = __builtin_amdgcn_mfma_f32_32x32x16_bf16(pa2, PK(l2, h2), od, 0, 0, 0);
    od = __builtin_amdgcn_mfma_f32_32x32x16_bf16(pa3, PK(l3, h3), od, 0, 0, 0);
#undef PK
}
__device__ __forceinline__ void pv_d0(f32x16* o, int vb, bf16x8 pa0, bf16x8 pa1, bf16x8 pa2, bf16x8 pa3) {
    pv_one<0>(o[0], vb, pa0, pa1, pa2, pa3); pv_one<1>(o[1], vb, pa0, pa1, pa2, pa3); pv_one<2>(o[2], vb, pa0, pa1, pa2, pa3); pv_one<3>(o[3], vb, pa0, pa1, pa2, pa3);
}
template <int DQK> struct Lds {
    static constexpr int SHM_V = KVBLK * 128 * 2, SHM_K = (MLA_FP8 && DQK == 192) ? KVBLK * 208 : KVBLK * (DQK * 2 + 16);
    static constexpr int OFF_K = 2 * SHM_V, OFF_WS = OFF_K + 2 * SHM_K, OFF_BT = OFF_WS + 8 * 64 * 4, OFF_QX = OFF_BT + 640 * 4, TOTAL = OFF_QX + 8 * 4096;
};
struct NaCtx { int u0; int rq; int rs; int cq; int cs; const LAS float* bt; };

template <int DQK, bool NA>
__device__ __forceinline__ void attn_body(const bf16_t* __restrict__ Qb, const bf16_t* __restrict__ Kh, const bf16_t* __restrict__ Krope, const bf16_t* __restrict__ Vh,
                                          bf16_t* __restrict__ Ob, int NT, int u0, int qrow0, const float* __restrict__ bias_h, char* lds) {
    using L = Lds<DQK>;
    constexpr int SHM_V = L::SHM_V, SHM_K = L::SHM_K;
    const int tid = ltid(), wid = tid >> 6, lane = tid & 63, r32 = lane & 31, hi = lane >> 5;
    char* V_lds = lds; char* K_lds = lds + L::OFF_K;
    float* ws = (float*)(lds + L::OFF_WS) + wid * 64; float* li_l = ws; float* al_l = ws + 32;
    float* bt = (float*)(lds + L::OFF_BT);
    __syncthreads();
    if constexpr (NA) { if (tid < 15 * 31) bt[48 + (tid / 31) * 32 + (tid % 31)] = bias_h[tid] * LOG2E; }
    float m_reg = -1e30f, l_reg = 0; f32x16 o[4] = {}; bf16x8 qr[8];
    const bf16_t* Qw = Qb + (size_t)(wid * QBLK + r32) * DQK + hi * 8;
    char* qx = lds + L::OFF_QX + wid * 4096 + lane * 16;
#pragma unroll
    for (int d0 = 0; d0 < 8; ++d0) qr[d0] = *reinterpret_cast<const bf16x8*>(Qw + d0 * 16);
    if constexpr (DQK == 192) {
#pragma unroll
        for (int d0 = 8; d0 < 12; ++d0) *reinterpret_cast<bf16x8*>(qx + (d0 - 8) * 1024) = *reinterpret_cast<const bf16x8*>(Qw + d0 * 16);
    }
    const int sr = tid >> 4, sc = (tid & 15) * 8, vst0 = v_st(sr, sc), vst1 = v_st(32 + sr, sc);
    const int rr_ = tid >> 3, rc_ = (tid & 7) * 8;
    const unsigned offKV = (unsigned)(sr * 128 + sc) * 2u, offR = (unsigned)(rr_ * 64 + rc_) * 2u;
    const int vb0 = (int)(uintptr_t)V_lds + v_rd_base(lane);
    const int rq = NA ? (wid >> 1) : 0;
    const int cq = 32 * (wid & 1) + r32;
    const int cs = cq < 8 ? 0 : (cq > 56 ? 48 : cq - 8);
    constexpr int SD = (DQK == 192) ? 1 : 2, SE = 0, SO = SD - 1;
    struct Slot { bf16x8 vs0, vs1, ks0, ks1, kr; } s_[SD];
    auto keyof = [&](int t) -> int { if constexpr (!NA) return t * KVBLK; else { if (t < 4) return t * KVBLK; int kr = u0 + t - 4; kr = kr > 255 ? 255 : kr; return NCTX + kr * KVBLK; } };
#define SLOAD(i, t) do { const size_t k0_ = (size_t)__builtin_amdgcn_readfirstlane(keyof(t)); const char* vp_ = (const char*)Vh + k0_ * 256; const char* kp_ = (const char*)Kh + k0_ * 256; \
    s_[i].vs0 = *(const bf16x8*)(vp_ + offKV); s_[i].vs1 = *(const bf16x8*)(vp_ + offKV + 8192u); \
    s_[i].ks0 = *(const bf16x8*)(kp_ + offKV); s_[i].ks1 = *(const bf16x8*)(kp_ + offKV + 8192u); \
    if constexpr (DQK == 192) s_[i].kr = *(const bf16x8*)((const char*)Krope + k0_ * 128 + offR); } while (0)
#define SWRITE(b, i) do { *(bf16x8*)(V_lds + (b) * SHM_V + vst0) = s_[i].vs0; *(bf16x8*)(V_lds + (b) * SHM_V + vst1) = s_[i].vs1; \
    *(bf16x8*)(K_lds + (b) * SHM_K + kswz<DQK>(sr, sc * 2)) = s_[i].ks0; *(bf16x8*)(K_lds + (b) * SHM_K + kswz<DQK>(32 + sr, sc * 2)) = s_[i].ks1; \
    if constexpr (DQK == 192) *(bf16x8*)(K_lds + (b) * SHM_K + kswz<DQK>(rr_, 256 + rc_ * 2)) = s_[i].kr; } while (0)
#define SWAIT() do { if constexpr (SD == 1) asm volatile("s_waitcnt vmcnt(0)" ::: "memory"); else asm volatile("s_waitcnt vmcnt(4)" ::: "memory"); } while (0)
#define RESC(a) do { if (__any((a) < 1.f)) { if (hi == 0) al_l[r32] = (a); asm volatile("s_waitcnt lgkmcnt(0)" ::: "memory"); \
    _Pragma("unroll") for (int d = 0; d < 4; ++d) _Pragma("unroll") for (int r = 0; r < 16; ++r) o[d][r] *= al_l[crow(r, hi)]; } } while (0)
#define NAHOOK(P0, P1, t) do { if constexpr (NA) { if ((t) >= 4) { const int kr_ = u0 + (t) - 4; const int rabs = qrow0 + rq; \
        const int rs_ = rabs < 4 ? 0 : (rabs > 252 ? 248 : rabs - 4); const bool tv = (kr_ >= rs_) && (kr_ < rs_ + 8) && (kr_ <= 255); \
        int ro = kr_ - rabs + 7; ro = ro < 0 ? 0 : (ro > 14 ? 14 : ro); \
        const float* bp = bt + 48 + ro * 32 + 15 - cq + 4 * hi; \
        _Pragma("unroll") for (int r = 0; r < 16; ++r) { const int ckc = (r & 3) + 8 * (r >> 2); const int ck0 = ckc + 4 * hi; \
            const bool v0_ = tv && ((unsigned)(ck0 - cs) < 16u), v1_ = tv && ((unsigned)(ck0 + 32 - cs) < 16u); \
            P0[r] = v0_ ? P0[r] + bp[ckc] : -1e30f; P1[r] = v1_ ? P1[r] + bp[ckc + 32] : -1e30f; } } } } while (0)
    f32x16 pA0, pA1, pB0, pB1; float mnA, mnB, alA, alB; bf16x8 pa0, pa1, pa2, pa3;
    SLOAD(SE, 0); asm volatile("s_waitcnt vmcnt(0)" ::: "memory"); SWRITE(0, SE); __syncthreads();
    qkt<DQK>(pA0, pA1, K_lds, qr, qx, r32, hi); partialSM(pA0, pA1, m_reg, mnA, alA);
    SLOAD(SO, 1); if constexpr (SD == 2) { if (2 < NT) SLOAD(SE, 2); }
    SWAIT(); SWRITE(1, SO); __syncthreads();
    const int grp = NA ? 0 : wave_rank(wid);
    if (NA || grp == 0) {
        for (int j = 1; j + 1 < NT; j += 2) {
            SBAR(); qkt<DQK>(pB0, pB1, K_lds + SHM_K, qr, qx, r32, hi);
            finishSM(pA0, pA1, alA, l_reg, pa0, pa1, pa2, pa3); SBAR();
            SLOAD(SO, j + SD); SBAR();
            pv_d0(o, vb0, pa0, pa1, pa2, pa3); NAHOOK(pB0, pB1, j); partialSM(pB0, pB1, m_reg, mnB, alB);
            __syncthreads(); SWAIT(); SWRITE(0, SE);
            RESC(alB); __syncthreads();
            SBAR(); qkt<DQK>(pA0, pA1, K_lds, qr, qx, r32, hi);
            finishSM(pB0, pB1, alB, l_reg, pa0, pa1, pa2, pa3); SBAR();
            if (SD == 1 || j + 3 < NT) SLOAD(SE, j + 1 + SD); SBAR();
            pv_d0(o, vb0 + SHM_V, pa0, pa1, pa2, pa3); NAHOOK(pA0, pA1, j + 1); partialSM(pA0, pA1, m_reg, mnA, alA);
            __syncthreads(); SWAIT(); SWRITE(1, SO);
            RESC(alA); __syncthreads();
        }
    } else {
        for (int j = 1; j + 1 < NT; j += 2) {
            SBAR(); finishSM(pA0, pA1, alA, l_reg, pa0, pa1, pa2, pa3); SBAR();
            SLOAD(SO, j + SD); SBAR();
            qkt<DQK>(pB0, pB1, K_lds + SHM_K, qr, qx, r32, hi); SBAR();
            NAHOOK(pB0, pB1, j); partialSM(pB0, pB1, m_reg, mnB, alB); SBAR();
            pv_d0(o, vb0, pa0, pa1, pa2, pa3);
            __syncthreads(); SWAIT(); SWRITE(0, SE);
            RESC(alB); __syncthreads();
            SBAR(); finishSM(pB0, pB1, alB, l_reg, pa0, pa1, pa2, pa3); SBAR();
            if (SD == 1 || j + 3 < NT) SLOAD(SE, j + 1 + SD); SBAR();
            qkt<DQK>(pA0, pA1, K_lds, qr, qx, r32, hi); SBAR();
            NAHOOK(pA0, pA1, j + 1); partialSM(pA0, pA1, m_reg, mnA, alA); SBAR();
            pv_d0(o, vb0 + SHM_V, pa0, pa1, pa2, pa3);
            __syncthreads(); SWAIT(); SWRITE(1, SO);
            RESC(alA); __syncthreads();
        }
    }
    SBAR(); qkt<DQK>(pB0, pB1, K_lds + SHM_K, qr, qx, r32, hi);
    finishSM(pA0, pA1, alA, l_reg, pa0, pa1, pa2, pa3); SBAR();
    pv_d0(o, vb0, pa0, pa1, pa2, pa3); NAHOOK(pB0, pB1, NT - 1); partialSM(pB0, pB1, m_reg, mnB, alB);
    __syncthreads(); RESC(alB);
    finishSM(pB0, pB1, alB, l_reg, pa0, pa1, pa2, pa3); SBAR();
    pv_d0(o, vb0 + SHM_V, pa0, pa1, pa2, pa3);
    if (hi == 0) li_l[r32] = l_reg; asm volatile("s_waitcnt lgkmcnt(0)" ::: "memory");
    float rli[16];
#pragma unroll
    for (int r = 0; r < 16; ++r) rli[r] = __builtin_amdgcn_rcpf(li_l[crow(r, hi)]);
    bf16_t* Ow = Ob + (size_t)(wid * QBLK) * DM;
#pragma unroll
    for (int r = 0; r < 16; ++r) { const int orow = crow(r, hi);
#pragma unroll
        for (int d0 = 0; d0 < 4; ++d0) Ow[(size_t)orow * DM + d0 * 32 + r32] = f2bf(o[d0][r] * rli[r]); }
#undef SLOAD
#undef SWRITE
#undef SWAIT
#undef RESC
#undef NAHOOK
}

template <int DQK>
__device__ __forceinline__ void qkt2(f32x16& p0, f32x16& p1, const char* Ks, const bf16x8* qr, const char* qx, int r32, int hi) {
    constexpr int KSTR = DQK * 2 + 16, ND = DQK / 16;
    p0 = f32x16{}; p1 = f32x16{};
    const char* kb_ = Ks + r32 * KSTR + hi * 16;
    bf16x8 a0 = *reinterpret_cast<const bf16x8*>(kb_), a1 = *reinterpret_cast<const bf16x8*>(kb_ + 32 * KSTR);
    bf16x8 qn = *reinterpret_cast<const bf16x8*>(qx);
#pragma unroll
    for (int d0 = 0; d0 < ND; ++d0) {
        bf16x8 n0 = a0, n1 = a1;
        if (d0 + 1 < ND) { n0 = *reinterpret_cast<const bf16x8*>(kb_ + (d0 + 1) * 32); n1 = *reinterpret_cast<const bf16x8*>(kb_ + 32 * KSTR + (d0 + 1) * 32); }
        bf16x8 q;
        if (d0 < 8) q = qr[d0 < 8 ? d0 : 0];
        else { q = qn; if (d0 + 1 < ND) qn = *reinterpret_cast<const bf16x8*>(qx + (d0 + 1 - 8) * 1024); }
        p0 = __builtin_amdgcn_mfma_f32_32x32x16_bf16(a0, q, p0, 0, 0, 0);
        p1 = __builtin_amdgcn_mfma_f32_32x32x16_bf16(a1, q, p1, 0, 0, 0);
        a0 = n0; a1 = n1;
    }
}

template <int OFF> __device__ __forceinline__ bf16x8 lds_rd128(int addr) {
    bf16x8 r; asm volatile("ds_read_b128 %0, %1 offset:%2" : "=&v"(r) : "v"(addr), "i"(OFF) : "memory"); return r;
}
template <int DQK, int D0> struct QkStep {
    static constexpr int PF = 2, RING = PF + 1;
    static __device__ __forceinline__ void run(f32x16& p0, f32x16& p1, int ka, const bf16x8* qr, const bf16x8 (&qx4)[4], bf16x8 (&f0)[RING], bf16x8 (&f1)[RING]) {
        constexpr int KSTR = DQK * 2 + 16, ND = DQK / 16;
        if constexpr (D0 + PF < ND) { f0[(D0 + PF) % RING] = lds_rd128<(D0 + PF) * 32>(ka); f1[(D0 + PF) % RING] = lds_rd128<32 * KSTR + (D0 + PF) * 32>(ka); }
        constexpr int newer = (ND - 1 - D0) < PF ? (ND - 1 - D0) : PF;
        if constexpr (newer == 3) asm volatile("s_waitcnt lgkmcnt(6)" ::: "memory");
        else if constexpr (newer == 2) asm volatile("s_waitcnt lgkmcnt(4)" ::: "memory");
        else if constexpr (newer == 1) asm volatile("s_waitcnt lgkmcnt(2)" ::: "memory");
        else asm volatile("s_waitcnt lgkmcnt(0)" ::: "memory");
        SBAR();
        const bf16x8 q = D0 < 8 ? qr[D0 < 8 ? D0 : 0] : qx4[D0 >= 8 ? D0 - 8 : 0];
        p0 = __builtin_amdgcn_mfma_f32_32x32x16_bf16(f0[D0 % RING], q, p0, 0, 0, 0);
        p1 = __builtin_amdgcn_mfma_f32_32x32x16_bf16(f1[D0 % RING], q, p1, 0, 0, 0);
        SBAR();
        if constexpr (D0 + 1 < ND) QkStep<DQK, D0 + 1>::run(p0, p1, ka, qr, qx4, f0, f1);
    }
};
template <int DQK>
__device__ __forceinline__ void qkt3(f32x16& p0, f32x16& p1, const char* Ks, const bf16x8* qr, const bf16x8 (&qx4)[4], int r32, int hi) {
    constexpr int KSTR = DQK * 2 + 16;
    p0 = f32x16{}; p1 = f32x16{};
    const int ka = (int)(uintptr_t)Ks + r32 * KSTR + hi * 16;
    bf16x8 f0[3], f1[3];
    f0[0] = lds_rd128<0>(ka); f1[0] = lds_rd128<32 * KSTR>(ka); f0[1] = lds_rd128<32>(ka); f1[1] = lds_rd128<32 * KSTR + 32>(ka);
    QkStep<DQK, 0>::run(p0, p1, ka, qr, qx4, f0, f1);
}

__device__ __forceinline__ i32x8 lds_rd256(int addr, int off) {
    u32x4 a, b;
    asm volatile("ds_read_b128 %0, %2\n\tds_read_b128 %1, %2 offset:16" : "=&v"(a), "=&v"(b) : "v"(addr + off) : "memory");
    return (i32x8){(int)a.x, (int)a.y, (int)a.z, (int)a.w, (int)b.x, (int)b.y, (int)b.z, (int)b.w};
}
__device__ __forceinline__ void qkt8(f32x16& p0, f32x16& p1, const char* Ks, const i32x8 (&q8)[3], int r32, int hi, float init) {
#pragma unroll
    for (int r = 0; r < 16; ++r) { p0[r] = init; p1[r] = init; }
    const int ka = (int)(uintptr_t)Ks + r32 * 208 + hi * 32;
    i32x8 a0 = lds_rd256(ka, 0), b0 = lds_rd256(ka, 32 * 208), a1 = lds_rd256(ka, 64), b1 = lds_rd256(ka, 32 * 208 + 64);
    asm volatile("s_waitcnt lgkmcnt(4)" ::: "memory"); SBAR();
    p0 = __builtin_amdgcn_mfma_scale_f32_32x32x64_f8f6f4(a0, q8[0], p0, 0, 0, 0, 0x7f7f7f7f, 0, 0x7f7f7f7f);
    p1 = __builtin_amdgcn_mfma_scale_f32_32x32x64_f8f6f4(b0, q8[0], p1, 0, 0, 0, 0x7f7f7f7f, 0, 0x7f7f7f7f);
    SBAR();
    i32x8 a2 = lds_rd256(ka, 128), b2 = lds_rd256(ka, 32 * 208 + 128);
    asm volatile("s_waitcnt lgkmcnt(4)" ::: "memory"); SBAR();
    p0 = __builtin_amdgcn_mfma_scale_f32_32x32x64_f8f6f4(a1, q8[1], p0, 0, 0, 0, 0x7f7f7f7f, 0, 0x7f7f7f7f);
    p1 = __builtin_amdgcn_mfma_scale_f32_32x32x64_f8f6f4(b1, q8[1], p1, 0, 0, 0, 0x7f7f7f7f, 0, 0x7f7f7f7f);
    SBAR();
    asm volatile("s_waitcnt lgkmcnt(0)" ::: "memory"); SBAR();
    p0 = __builtin_amdgcn_mfma_scale_f32_32x32x64_f8f6f4(a2, q8[2], p0, 0, 0, 0, 0x7f7f7f7f, 0, 0x7f7f7f7f);
    p1 = __builtin_amdgcn_mfma_scale_f32_32x32x64_f8f6f4(b2, q8[2], p1, 0, 0, 0, 0x7f7f7f7f, 0, 0x7f7f7f7f);
}

__device__ __forceinline__ void finishSM8(f32x16& p0, f32x16& p1, float alpha, float& l_reg, i32x8& p8) {
#pragma unroll
    for (int r = 0; r < 16; ++r) p1[r] = __builtin_amdgcn_exp2f(p1[r]);
    float ps = 0;
#pragma unroll
    for (int r = 0; r < 16; ++r) ps += p0[r];
#pragma unroll
    for (int r = 0; r < 16; ++r) ps += p1[r];
    { auto rr = __builtin_amdgcn_permlane32_swap(__float_as_uint(ps), __float_as_uint(ps), false, false);
      ps = __uint_as_float(rr[0]) + __uint_as_float(rr[1]); }
    l_reg = l_reg * alpha + ps;
#pragma unroll
    for (int w = 0; w < 4; ++w) { int lo = 0, hi_ = 0;
        lo = __builtin_amdgcn_cvt_pk_fp8_f32(p0[4 * w], p0[4 * w + 1], lo, false); lo = __builtin_amdgcn_cvt_pk_fp8_f32(p0[4 * w + 2], p0[4 * w + 3], lo, true);
        hi_ = __builtin_amdgcn_cvt_pk_fp8_f32(p1[4 * w], p1[4 * w + 1], hi_, false); hi_ = __builtin_amdgcn_cvt_pk_fp8_f32(p1[4 * w + 2], p1[4 * w + 3], hi_, true);
        p8[w] = lo; p8[4 + w] = hi_; }
}
__device__ __forceinline__ void softmax8(f32x16& p0, f32x16& p1, float& m_reg, float& alpha, bool first, float& l_reg, i32x8& p8) {
    alpha = 1.f; float ps = 0.f; bool slow = false;
    if (!first) {
#pragma unroll
        for (int r = 0; r < 16; ++r) { p0[r] = __builtin_amdgcn_exp2f(p0[r]); p1[r] = __builtin_amdgcn_exp2f(p1[r]); }
#pragma unroll
        for (int r = 0; r < 16; ++r) ps += p0[r];
#pragma unroll
        for (int r = 0; r < 16; ++r) ps += p1[r];
        slow = __any(!(ps <= 256.f));
        if (__builtin_expect(slow, 0)) {
#pragma unroll
            for (int r = 0; r < 16; ++r) { p0[r] = __builtin_amdgcn_logf(p0[r]); p1[r] = __builtin_amdgcn_logf(p1[r]); }
        }
    }
    if (__builtin_expect(first || slow, 0)) {
        float pmax = p0[0];
#pragma unroll
        for (int r = 1; r < 16; ++r) pmax = fmaxf(pmax, p0[r]);
#pragma unroll
        for (int r = 0; r < 16; ++r) pmax = fmaxf(pmax, p1[r]);
        { auto rr = __builtin_amdgcn_permlane32_swap(__float_as_uint(pmax), __float_as_uint(pmax), false, false);
          pmax = fmaxf(__uint_as_float(rr[0]), __uint_as_float(rr[1])); }
        const float d = first ? pmax : fmaxf(pmax, 0.f); alpha = first ? 0.f : __builtin_amdgcn_exp2f(-d); m_reg += d;
        ps = 0.f;
#pragma unroll
        for (int r = 0; r < 16; ++r) { p0[r] = __builtin_amdgcn_exp2f(p0[r] - d); p1[r] = __builtin_amdgcn_exp2f(p1[r] - d); }
#pragma unroll
        for (int r = 0; r < 16; ++r) ps += p0[r];
#pragma unroll
        for (int r = 0; r < 16; ++r) ps += p1[r];
    }
    l_reg = l_reg * alpha + ps;
#pragma unroll
    for (int w = 0; w < 4; ++w) { int lo = 0, hi_ = 0;
        lo = __builtin_amdgcn_cvt_pk_fp8_f32(p0[4 * w], p0[4 * w + 1], lo, false); lo = __builtin_amdgcn_cvt_pk_fp8_f32(p0[4 * w + 2], p0[4 * w + 3], lo, true);
        hi_ = __builtin_amdgcn_cvt_pk_fp8_f32(p1[4 * w], p1[4 * w + 1], hi_, false); hi_ = __builtin_amdgcn_cvt_pk_fp8_f32(p1[4 * w + 2], p1[4 * w + 3], hi_, true);
        p8[w] = lo; p8[4 + w] = hi_; }
}
__device__ __forceinline__ void pv8(f32x16* o, const char* Vs, const i32x8& p8, int r32, int hi) {
    const int va = (int)(uintptr_t)Vs + r32 * 80 + hi * 32;
    i32x8 b0 = lds_rd256(va, 0), b1 = lds_rd256(va, 32 * 80), b2 = lds_rd256(va, 64 * 80), b3 = lds_rd256(va, 96 * 80);
    asm volatile("s_waitcnt lgkmcnt(6)" ::: "memory"); SBAR();
    o[0] = __builtin_amdgcn_mfma_scale_f32_32x32x64_f8f6f4(p8, b0, o[0], 0, 0, 0, 0x7f7f7f7f, 0, 0x7f7f7f7f); SBAR();
    asm volatile("s_waitcnt lgkmcnt(4)" ::: "memory"); SBAR();
    o[1] = __builtin_amdgcn_mfma_scale_f32_32x32x64_f8f6f4(p8, b1, o[1], 0, 0, 0, 0x7f7f7f7f, 0, 0x7f7f7f7f); SBAR();
    asm volatile("s_waitcnt lgkmcnt(2)" ::: "memory"); SBAR();
    o[2] = __builtin_amdgcn_mfma_scale_f32_32x32x64_f8f6f4(p8, b2, o[2], 0, 0, 0, 0x7f7f7f7f, 0, 0x7f7f7f7f); SBAR();
    asm volatile("s_waitcnt lgkmcnt(0)" ::: "memory"); SBAR();
    o[3] = __builtin_amdgcn_mfma_scale_f32_32x32x64_f8f6f4(p8, b3, o[3], 0, 0, 0, 0x7f7f7f7f, 0, 0x7f7f7f7f);
}
struct VFrag { s16x4 l0, h0, l1, h1, l2, h2, l3, h3; };
template <int D0> __device__ __forceinline__ void pv_rd(VFrag& f, int vb) {
    f.l0 = tr_read<v_rd_off(D0, 0, 0)>(vb); f.h0 = tr_read<v_rd_off(D0, 0, 1)>(vb); f.l1 = tr_read<v_rd_off(D0, 1, 0)>(vb); f.h1 = tr_read<v_rd_off(D0, 1, 1)>(vb);
    f.l2 = tr_read<v_rd_off(D0, 2, 0)>(vb); f.h2 = tr_read<v_rd_off(D0, 2, 1)>(vb); f.l3 = tr_read<v_rd_off(D0, 3, 0)>(vb); f.h3 = tr_read<v_rd_off(D0, 3, 1)>(vb);
}
__device__ __forceinline__ void pv_mm(f32x16& od, const VFrag& f, bf16x8 pa0, bf16x8 pa1, bf16x8 pa2, bf16x8 pa3) {
#define PK(L, H) (bf16x8){L[0], L[1], L[2], L[3], H[0], H[1], H[2], H[3]}
    od = __builtin_amdgcn_mfma_f32_32x32x16_bf16(pa0, PK(f.l0, f.h0), od, 0, 0, 0);
    od = __builtin_amdgcn_mfma_f32_32x32x16_bf16(pa1, PK(f.l1, f.h1), od, 0, 0, 0);
    od = __builtin_amdgcn_mfma_f32_32x32x16_bf16(pa2, PK(f.l2, f.h2), od, 0, 0, 0);
    od = __builtin_amdgcn_mfma_f32_32x32x16_bf16(pa3, PK(f.l3, f.h3), od, 0, 0, 0);
#undef PK
}
__device__ __forceinline__ void pv2(f32x16* o, int vb, bf16x8 pa0, bf16x8 pa1, bf16x8 pa2, bf16x8 pa3) {
    VFrag fa, fb;
    pv_rd<0>(fa, vb);
    pv_rd<1>(fb, vb); asm volatile("s_waitcnt lgkmcnt(8)" ::: "memory"); SBAR(); pv_mm(o[0], fa, pa0, pa1, pa2, pa3); SBAR();
    pv_rd<2>(fa, vb); asm volatile("s_waitcnt lgkmcnt(8)" ::: "memory"); SBAR(); pv_mm(o[1], fb, pa0, pa1, pa2, pa3); SBAR();
    pv_rd<3>(fb, vb); asm volatile("s_waitcnt lgkmcnt(8)" ::: "memory"); SBAR(); pv_mm(o[2], fa, pa0, pa1, pa2, pa3); SBAR();
    asm volatile("s_waitcnt lgkmcnt(0)" ::: "memory"); SBAR(); pv_mm(o[3], fb, pa0, pa1, pa2, pa3);
}

template <int DQK, bool NA>
__device__ __forceinline__ void attn_body2(const bf16_t* __restrict__ Qb, const bf16_t* __restrict__ Kh, const bf16_t* __restrict__ Krope, const bf16_t* __restrict__ Vh,
                                           bf16_t* __restrict__ Ob, int NT, int u0, int qrow0, const float* __restrict__ bias_h, char* lds, float* diag_out = nullptr) {
    using L = Lds<DQK>;
    constexpr int SHM_V = L::SHM_V, SHM_K = L::SHM_K;
    const int tid = ltid(), wid = tid >> 6, lane = tid & 63, r32 = lane & 31, hi = lane >> 5;
    char* V_lds = lds; char* K_lds = lds + L::OFF_K;
    float* ws = (float*)(lds + L::OFF_WS) + wid * 64; float* li_l = ws; float* al_l = ws + 32;
    float* bt = (float*)(lds + L::OFF_BT);
    __syncthreads();
    if constexpr (NA) { if (tid < 15 * 31) bt[48 + (tid / 31) * 32 + (tid % 31)] = bias_h[tid] * LOG2E; }
    constexpr bool F8 = MLA_FP8 && DQK == 192;
    float m_reg = F8 ? 0.f : -1e30f, l_reg = 0; f32x16 o[4] = {}; bf16x8 qr[8];
    const bf16_t* Qw = Qb + (size_t)(wid * QBLK + r32) * DQK + hi * 8;
    bf16x8 qx4[4]; i32x8 q8[3];
    if constexpr (F8) {
        const unsigned char* Q8 = (const unsigned char*)Qb + (size_t)(wid * QBLK + r32) * 192 + hi * 32;
#pragma unroll
        for (int c = 0; c < 3; ++c) { const u32x4 a_ = *(const u32x4*)(Q8 + c * 64), b_ = *(const u32x4*)(Q8 + c * 64 + 16);
            q8[c] = (i32x8){(int)a_.x, (int)a_.y, (int)a_.z, (int)a_.w, (int)b_.x, (int)b_.y, (int)b_.z, (int)b_.w}; }
    } else {
#pragma unroll
    for (int d0 = 0; d0 < 8; ++d0) qr[d0] = *reinterpret_cast<const bf16x8*>(Qw + d0 * 16);
    if constexpr (DQK == 192) {
#pragma unroll
        for (int d0 = 8; d0 < 12; ++d0) qx4[d0 - 8] = *reinterpret_cast<const bf16x8*>(Qw + d0 * 16);
    } else { qx4[0] = qr[0]; qx4[1] = qr[0]; qx4[2] = qr[0]; qx4[3] = qr[0]; }
    }
    const int sr = tid >> 4, sc = (tid & 15) * 8, vst0 = v_st(sr, sc), vst1 = v_st(32 + sr, sc);
    const int rr_ = tid >> 3, rc_ = (tid & 7) * 8;
    const unsigned offKV = (unsigned)(sr * 128 + sc) * 2u, offR = (unsigned)(rr_ * 64 + rc_) * 2u;
    const int vb0 = (int)(uintptr_t)V_lds + v_rd_base(lane);
    const int rq = NA ? (wid >> 1) : 0;
    const int cq = 32 * (wid & 1) + r32;
    const int cs = cq < 8 ? 0 : (cq > 56 ? 48 : cq - 8);
    struct { bf16x8 vs0, vs1, ks0, ks1, kr; } st;
    const unsigned off8n = (unsigned)((tid >> 3) * 128 + (tid & 7) * 16), off8r = (unsigned)(((tid & 255) >> 2) * 64 + (tid & 3) * 16);
    const int lds8n = (tid >> 3) * 208 + (tid & 7) * 16, lds8r = ((tid & 255) >> 2) * 208 + 128 + (tid & 3) * 16;
    auto keyof = [&](int t) -> int { if constexpr (!NA) return t * KVBLK; else { if (t < 4) return t * KVBLK; int kr = u0 + t - 4; kr = kr > 255 ? 255 : kr; return NCTX + kr * KVBLK; } };
#define SLOAD2(s_) do { const int sk_ = (s_) < NT ? (s_) : NT - 1, sv_ = ATT_SPLIT ? sk_ : ((s_) > 0 ? ((s_) <= NT ? (s_) - 1 : NT - 1) : 0); \
    const size_t kk_ = (size_t)__builtin_amdgcn_readfirstlane(keyof(sk_)), kv_ = (size_t)__builtin_amdgcn_readfirstlane(keyof(sv_)); \
    const char* vp_ = (const char*)Vh + kv_ * 256; const char* kp_ = (const char*)Kh + kk_ * 256; \
    int tl_ = tid; asm volatile("" : "+v"(tl_));         \
    if constexpr (F8) st.vs0 = *(const bf16x8*)((const char*)Vh + (kv_ >> 6) * 8192 + tl_ * 16); else { st.vs0 = *(const bf16x8*)(vp_ + offKV); st.vs1 = *(const bf16x8*)(vp_ + offKV + 8192u); } \
    if constexpr (F8) { st.ks0 = *(const bf16x8*)((const char*)Kh + kk_ * 128 + (unsigned)((tl_ >> 3) * 128 + (tl_ & 7) * 16)); if (wid < 4) st.kr = *(const bf16x8*)((const char*)Krope + kk_ * 64 + (unsigned)(((tl_ & 255) >> 2) * 64 + (tl_ & 3) * 16)); } else { \
    st.ks0 = *(const bf16x8*)(kp_ + offKV); st.ks1 = *(const bf16x8*)(kp_ + offKV + 8192u); \
    if constexpr (DQK == 192) st.kr = *(const bf16x8*)((const char*)Krope + kk_ * 128 + offR); } } while (0)
#define SWRITE2(s_) do { const int b_ = (s_) & 1; int tw_ = tid; asm volatile("" : "+v"(tw_)); if constexpr (F8) *(bf16x8*)(V_lds + b_ * SHM_V + (tw_ >> 2) * 80 + (tw_ & 3) * 16) = st.vs0; else { *(bf16x8*)(V_lds + b_ * SHM_V + vst0) = st.vs0; *(bf16x8*)(V_lds + b_ * SHM_V + vst1) = st.vs1; } \
    if constexpr (F8) { *(bf16x8*)(K_lds + b_ * SHM_K + (tw_ >> 3) * 208 + (tw_ & 7) * 16) = st.ks0; if (wid < 4) *(bf16x8*)(K_lds + b_ * SHM_K + ((tw_ & 255) >> 2) * 208 + 128 + (tw_ & 3) * 16) = st.kr; } else { \
    *(bf16x8*)(K_lds + b_ * SHM_K + kswz<DQK>(sr, sc * 2)) = st.ks0; *(bf16x8*)(K_lds + b_ * SHM_K + kswz<DQK>(32 + sr, sc * 2)) = st.ks1; \
    if constexpr (DQK == 192) *(bf16x8*)(K_lds + b_ * SHM_K + kswz<DQK>(rr_, 256 + rc_ * 2)) = st.kr; } } while (0)
#define RESC2(a) do { if (__any((a) < 1.f)) { if (hi == 0) al_l[r32] = (a); asm volatile("s_waitcnt lgkmcnt(0)" ::: "memory"); \
    _Pragma("unroll") for (int d = 0; d < 4; ++d) _Pragma("unroll") for (int r = 0; r < 16; ++r) o[d][r] *= al_l[crow(r, hi)]; } } while (0)
#define NAHOOK2(P0, P1, t) do { if constexpr (NA) { if ((t) >= 4) { const int kr_ = u0 + (t) - 4; const int rabs = qrow0 + rq; \
        const int rs_ = rabs < 4 ? 0 : (rabs > 252 ? 248 : rabs - 4); const bool tv = (kr_ >= rs_) && (kr_ < rs_ + 8) && (kr_ <= 255); \
        int ro = kr_ - rabs + 7; ro = ro < 0 ? 0 : (ro > 14 ? 14 : ro); \
        const float* bp = bt + 48 + ro * 32 + 15 - cq + 4 * hi; \
        _Pragma("unroll") for (int r = 0; r < 16; ++r) { const int ckc = (r & 3) + 8 * (r >> 2); const int ck0 = ckc + 4 * hi; \
            const bool v0_ = tv && ((unsigned)(ck0 - cs) < 16u), v1_ = tv && ((unsigned)(ck0 + 32 - cs) < 16u); \
            P0[r] = v0_ ? P0[r] + bp[ckc] : -1e30f; P1[r] = v1_ ? P1[r] + bp[ckc + 32] : -1e30f; } } } } while (0)
#define VBLOCK_(t, FIRST) do { if (!tvalid(t)) break; float mn_, al_; NAHOOK2(p0, p1, t); if constexpr (F8) { softmax8(p0, p1, m_reg, al_, FIRST, l_reg, p8); RESC2(al_); } else { partialSM<F8>(p0, p1, m_reg, mn_, al_); \
    RESC2(al_); finishSM(p0, p1, al_, l_reg, pa0, pa1, pa2, pa3); } } while (0)
#define VBLOCK(t) VBLOCK_(t, false)
#define VBLOCKF(t) VBLOCK_(t, true)
#define MBLOCK(i) do { const int b_ = (i) & 1; __builtin_amdgcn_s_setprio(2); if ((i) > 0 && tvalid((i) - 1)) { if constexpr (F8) pv8(o, V_lds + b_ * SHM_V, p8, r32, hi); else pv2(o, vb0 + b_ * SHM_V, pa0, pa1, pa2, pa3); } SBAR(); \
    if (PROBE_MB == 2 && !NA && (i) > 0) { const bf16x8 z_ = {0, 0, 0, 0, 0, 0, 0, 0}; pv2(o, vb0 + b_ * SHM_V, z_, z_, z_, z_); SBAR(); } \
    if ((i) < NT && tvalid(i)) { if constexpr (F8) qkt8(p0, p1, K_lds + b_ * SHM_K, q8, r32, hi, -m_reg); else qkt3<DQK>(p0, p1, K_lds + b_ * SHM_K, qr, qx4, r32, hi); } __builtin_amdgcn_s_setprio(0); } while (0)
    auto tvalid = [&](int t) -> bool { if constexpr (!NA) return true; else { if (t < 4) return true; const int kr_ = u0 + t - 4, rabs_ = qrow0 + rq;
        const int rs_ = rabs_ < 4 ? 0 : (rabs_ > 252 ? 248 : rabs_ - 4); return (kr_ >= rs_) && (kr_ < rs_ + 8) && (kr_ <= 255); } };
    f32x16 p0, p1; bf16x8 pa0, pa1, pa2, pa3; i32x8 p8 = {0, 0, 0, 0, 0, 0, 0, 0};
#if ATT_GRP_MODE == 1
    const int grp = __builtin_amdgcn_readfirstlane(wid >> 2);
#elif ATT_GRP_MODE == 2
    const int grp = __builtin_amdgcn_readfirstlane(wid & 1);
#elif ATT_GRP_MODE == 3
    const int grp = 0;
#else
    const int grp = wave_rank(wid);
#endif
#define ABAR2() do { asm volatile("s_waitcnt lgkmcnt(0)" ::: "memory"); __builtin_amdgcn_s_barrier(); asm volatile("" ::: "memory"); } while (0)
    SLOAD2(0); SWRITE2(0); SLOAD2(1); ABAR2();
#if ATT_DIAG
    long long tM = 0, tV = 0, tB = 0, tS = 0; const long long tStart = clock64();
#define TICK(acc, stmt) do { const long long t0_ = clock64(); stmt; acc += clock64() - t0_; } while (0)
#else
#define TICK(acc, stmt) do { stmt; } while (0)
#endif
#if ATT_SPLIT
#define QBLOCK(i) do { __builtin_amdgcn_s_setprio(2); qkt3<DQK>(p0, p1, K_lds + ((i) & 1) * SHM_K, qr, qx4, r32, hi); __builtin_amdgcn_s_setprio(0); } while (0)
#define PBLOCK(i) do { VBLOCK(i); SBAR(); pv2(o, vb0 + ((i) & 1) * SHM_V, pa0, pa1, pa2, pa3); } while (0)
    if (grp == 0) {
        for (int i = 0; i < NT; ++i) {
            SBAR(); QBLOCK(i); SBAR();
            ABAR2();
            SWRITE2(i + 1); SLOAD2(i + 2); SBAR();
            PBLOCK(i); SBAR();
            ABAR2();
        }
    } else {
        for (int i = 0; i < NT; ++i) {
            SBAR(); if (i > 0) PBLOCK(i - 1); SBAR();
            ABAR2();
            SWRITE2(i + 1); SLOAD2(i + 2); SBAR();
            QBLOCK(i); SBAR();
            ABAR2();
        }
        SBAR(); PBLOCK(NT - 1);
    }
#undef QBLOCK
#undef PBLOCK
#else
#define G0_ITER(i, VB) do { SBAR(); TICK(tM, MBLOCK(i)); SBAR(); TICK(tB, ABAR2()); TICK(tS, SWRITE2((i) + 1); SLOAD2((i) + 2)); SBAR(); TICK(tV, VB(i)); SBAR(); TICK(tB, ABAR2()); } while (0)
#define G1_ITER(i, VBM1) do { SBAR(); VBM1; SBAR(); TICK(tB, ABAR2()); TICK(tS, SWRITE2((i) + 1); SLOAD2((i) + 2)); SBAR(); TICK(tM, MBLOCK(i)); SBAR(); TICK(tB, ABAR2()); } while (0)
    if (grp == 0) {
        G0_ITER(0, VBLOCKF);
        for (int i = 1; i < NT; ++i) G0_ITER(i, VBLOCK);
        SBAR(); MBLOCK(NT); SBAR();
        ABAR2();
    } else {
        G1_ITER(0, (void)0);
        G1_ITER(1, VBLOCKF(0));
        for (int i = 2; i < NT; ++i) G1_ITER(i, TICK(tV, VBLOCK(i - 1)));
        SBAR(); VBLOCK(NT - 1); SBAR();
        ABAR2();
        MBLOCK(NT);
    }
#undef G0_ITER
#undef G1_ITER
#endif
#if ATT_DIAG
    if (!NA && blockIdx.x == 7 && lane == 0 && (wid == 0 || wid == 4)) { float* dg = diag_out + (wid >> 2) * 8; const float inv = 1.f / (float)NT;
        dg[0] = (float)tM * inv; dg[1] = (float)tV * inv; dg[2] = (float)tB * inv; dg[3] = (float)tS * inv; dg[4] = (float)(clock64() - tStart) * inv; }
#endif
    if constexpr (F8) { auto rr = __builtin_amdgcn_permlane32_swap(__float_as_uint(l_reg), __float_as_uint(l_reg), false, false);
        l_reg = __uint_as_float(rr[0]) + __uint_as_float(rr[1]); }
    if (hi == 0) li_l[r32] = l_reg; asm volatile("s_waitcnt lgkmcnt(0)" ::: "memory");
    float rli[16];
#pragma unroll
    for (int r = 0; r < 16; ++r) rli[r] = __builtin_amdgcn_rcpf(li_l[crow(r, hi)]);
    bf16_t* Ow = Ob + (size_t)(wid * QBLK) * DM;
#pragma unroll
    for (int r = 0; r < 16; ++r) { const int orow = crow(r, hi);
#pragma unroll
        for (int d0 = 0; d0 < 4; ++d0) {
#if ATTG_FP8
            ((unsigned char*)Ob)[(size_t)(wid * QBLK + orow) * DM + d0 * 32 + r32] = (unsigned char)(__builtin_amdgcn_cvt_pk_fp8_f32(o[d0][r] * rli[r] * 64.f, 0.f, 0, false) & 0xff);
#else
            Ow[(size_t)orow * DM + d0 * 32 + r32] = f2bf(o[d0][r] * rli[r]);
#endif
        } }
#undef TICK
#undef SLOAD2
#undef SWRITE2
#undef RESC2
#undef NAHOOK2
#undef VBLOCK
#undef MBLOCK
}
}

#define WSP(T, off) ((T*)(p.ws + (off)))
constexpr float TWO_PI = 6.283185307179586f;

constexpr int P0_ADA = 112, P0_TAB = 72;
constexpr int P0_SLOW_WIN = 64 * 32, P0_SLOW_WUQ = 24 * 8, P0_SLOW_WUKV = 32 * 4;
constexpr int P0_SLOW = P0_SLOW_WIN + P0_SLOW_WUQ + P0_SLOW_WUKV;
constexpr int P0_FAST_SQ = 64;
constexpr int P0_FAST_GU = 2 * NE * 32 * 4, P0_FAST_D = 2 * NE * 16 * 4;
constexpr int P0_DEF = (PREP_DEFER && MOE2_FP8) ? P0_FAST_D : 0;
constexpr int P0_DEFG = (PREP_DEFER && MOE1_FP8 && MOE2_FP8 && CONV_CUS > 0) ? P0_FAST_GU / 2 : 0;
constexpr int P0_FAST = 2 * P0_FAST_SQ + P0_FAST_GU + P0_FAST_D - P0_DEF - 2 * P0_DEFG;
constexpr int QW_GU = 42, QW_DONE_MOE1 = 44, QW_DONE_INPROJ = 45, QW_DONE_UP = 46, QW_DONE_ATTN = 47, QW_DONE_MOE2 = 48;
constexpr int P0_UNITS = P0_ADA + P0_FAST + P0_SLOW + P0_TAB;
constexpr size_t OFF_QCTR = 14336;

__device__ __forceinline__ int rope_src(int jj) { const int pp = jj >> 1, wh = jj & 1; return (pp < 16 ? 0 : 32) + (pp & 15) + 16 * wh; }

__device__ __forceinline__ void p0_slow_tile8(const float* src, int lds_, const float* scale, float mul, unsigned char* dst, int K, int n0, int k0, int tid) {
    const int kg = tid >> 6, k = k0 + kg * 8;
    f32x4 a, b;
#pragma unroll
    for (int i = 0; i < 4; ++i) { a[i] = src ? src[(size_t)(k + i) * lds_] * (scale ? scale[k + i] : 1.f) : 0.f; b[i] = src ? src[(size_t)(k + 4 + i) * lds_] * (scale ? scale[k + 4 + i] : 1.f) : 0.f; }
    *(u32x2*)(dst + (size_t)(n0 + (tid & 63)) * K + k) = pack8_fp8(a, b, mul);
}
__device__ __forceinline__ void p0_slow_tile(const float* src, int lds_, const float* scale, bf16_t* dst, int K, int n0, int k0, int tid) {
    const int kg = tid >> 6, k = k0 + kg * 8;
    float v[8];
#pragma unroll
    for (int i = 0; i < 8; ++i) v[i] = src ? src[(size_t)(k + i) * lds_] * (scale ? scale[k + i] : 1.f) : 0.f;
    u32x4 w; w.x = cvtpk(v[0], v[1]); w.y = cvtpk(v[2], v[3]); w.z = cvtpk(v[4], v[5]); w.w = cvtpk(v[6], v[7]);
    *(u32x4*)(dst + (size_t)(n0 + (tid & 63)) * K + k) = w;
}
__device__ __forceinline__ void p0_fast_tile(const float* src, int lds_, bf16_t* dst, int K, int tid) {
    const int n4 = tid & 31, kg = tid >> 5;
    f32x4 v[4][8];
#pragma unroll
    for (int sb = 0; sb < 4; ++sb)
#pragma unroll
        for (int i = 0; i < 8; ++i) v[sb][i] = __builtin_nontemporal_load((const f32x4*)(src + (size_t)(sb * 128 + kg * 8 + i) * lds_ + n4 * 4));
#pragma unroll
    for (int sb = 0; sb < 4; ++sb)
#pragma unroll
        for (int j = 0; j < 4; ++j) {
            u32x4 w; w.x = cvtpk(v[sb][0][j], v[sb][1][j]); w.y = cvtpk(v[sb][2][j], v[sb][3][j]); w.z = cvtpk(v[sb][4][j], v[sb][5][j]); w.w = cvtpk(v[sb][6][j], v[sb][7][j]);
            *(u32x4*)(dst + (size_t)(n4 * 4 + j) * K + sb * 128 + kg * 8) = w;
        }
}

__device__ __forceinline__ void p0_fast_tile8(const float* src, int lds_, unsigned char* dst, int K, int hi128, int tid) {
    const int n4 = tid & 63, kg = tid >> 6;
    f32x4 v[32];
#pragma unroll
    for (int i = 0; i < 32; ++i) v[i] = __builtin_nontemporal_load((const f32x4*)(src + (size_t)(kg * 32 + i) * lds_ + n4 * 4));
#pragma unroll
    for (int j = 0; j < 4; ++j) {
        u32x4 w[2];
#pragma unroll
        for (int q = 0; q < 8; ++q) { int x = 0;
            x = __builtin_amdgcn_cvt_pk_fp8_f32(v[4 * q][j] * 32.f, v[4 * q + 1][j] * 32.f, x, false); x = __builtin_amdgcn_cvt_pk_fp8_f32(v[4 * q + 2][j] * 32.f, v[4 * q + 3][j] * 32.f, x, true);
            w[q >> 2][q & 3] = (unsigned)x; }
        const int n = n4 * 4 + j;
        unsigned char* d = dst + (size_t)(n + (n >> 7) * hi128) * K + kg * 32;
        *(u32x4*)d = w[0]; *(u32x4*)(d + 16) = w[1];
    }
}
__device__ __forceinline__ void phase_prep(const Params& p, char* smem) {
    const int tid0 = ltid();
    float* sl = (float*)smem;
    volatile int* qslot = (volatile int*)(smem + 16384);
    volatile int* pass_ = (volatile int*)(g_smem + LDS_WTAB) + 64;
    unsigned* qctr = (unsigned*)(p.ws + OFF_QCTR) + *pass_ * 64;
    for (;;) {
        asm volatile("s_waitcnt lgkmcnt(0)" ::: "memory"); __builtin_amdgcn_s_barrier();
        if (tid0 == 0) *qslot = (int)__hip_atomic_fetch_add(qctr, 1u, __ATOMIC_RELAXED, __HIP_MEMORY_SCOPE_AGENT);
        asm volatile("s_waitcnt lgkmcnt(0)" ::: "memory"); __builtin_amdgcn_s_barrier();
        const int u = *qslot;
        if (u >= P0_UNITS) { if (tid0 == 0) *pass_ = *pass_ + 1; break; }
        int tid = tid0; asm volatile("" : "+v"(tid));
        const int wid = tid >> 6, lane = tid & 63;
        if (u < P0_ADA) {
            const bool isctx = u >= 96; const int layer = (u >= 48 && u < 96) ? 1 : 0; const int j0 = isctx ? (u - 96) * 256 : (u % 48) * 256;
            const float* cv = isctx ? p.c_ctx : p.c; const float* W = p.ada_w + (size_t)layer * DM * 12288;
            for (int k = tid; k < DM; k += NTHR) { const float v = cv[k]; sl[k] = v / (1.f + expf(-v)); }
            __syncthreads();
            f32x4 acc = {0.f, 0.f, 0.f, 0.f};
            const float* wp = W + (size_t)(wid * 256) * 12288 + j0 + lane * 4;
#pragma unroll 16
            for (int k = 0; k < 256; ++k) { const f32x4 w = __builtin_nontemporal_load((const f32x4*)(wp + (size_t)k * 12288)); const float s_ = sl[wid * 256 + k]; acc += w * s_; }
            float* red = sl + 2048;
            *(f32x4*)(red + wid * 256 + lane * 4) = acc;
            __syncthreads();
            if (tid < 256) { float s_ = 0.f;
#pragma unroll
                for (int w = 0; w < 8; ++w) s_ += red[w * 256 + tid];
                s_ += p.ada_b[(size_t)layer * 12288 + j0 + tid];
                float* dst = isctx ? WSP(float, OFF_ADA) + 2 * 12288 : WSP(float, OFF_ADA) + layer * 12288;
                dst[j0 + tid] = s_; }
        } else if (u < P0_ADA + P0_FAST) {
            int s_ = u - P0_ADA;
            const float* src_; int ld_; unsigned char* dst8_; int K_, hi_; bool f8_;
            if (s_ < 2 * P0_FAST_SQ) {
                const bool attn_ = s_ < P0_FAST_SQ; const float* W = attn_ ? p.w_out_attn : p.w_out_fourier;
                s_ &= 63; f8_ = ATTG_FP8 && attn_;
                const int n0 = f8_ ? (s_ >> 3) * 256 : (s_ >> 2) * 128, k0 = f8_ ? (s_ & 7) * 256 : (s_ & 3) * 512;
                src_ = W + (size_t)k0 * DM + n0; ld_ = DM; K_ = DM; hi_ = 0;
                dst8_ = WSP(unsigned char, attn_ ? OFF_WOUT : OFF_WFOUT) + ((size_t)n0 * DM + k0) * (f8_ ? 1 : 2);
            } else if (s_ < 2 * P0_FAST_SQ + P0_FAST_GU) {
                s_ -= 2 * P0_FAST_SQ; const int le = s_ >> 7, t = s_ & 127;
                const float* Wg = p.w_gate + (size_t)le * DM * FF; const float* Wu = p.w_up + (size_t)le * DM * FF;
#if MOE1_FP8
                const int bj = t >> 6, q = (t >> 3) & 7, k0 = (t & 7) * 256;
                f8_ = true; src_ = (bj ? Wu : Wg) + (size_t)k0 * FF + q * 256; ld_ = FF; K_ = DM; hi_ = 128;
                dst8_ = WSP(unsigned char, OFF_WGU) + ((size_t)le * 4096 + 512 * q + 128 * bj) * DM + k0;
#else
                const int nt_ = t >> 2, k0 = (t & 3) * 512, pn = nt_ >> 1, bj = nt_ & 1;
                f8_ = false; src_ = (bj ? Wu : Wg) + (size_t)k0 * FF + pn * 128; ld_ = FF; K_ = DM; hi_ = 0;
                dst8_ = WSP(unsigned char, OFF_WGU) + (((size_t)le * 4096 + nt_ * 128) * DM + k0) * 2;
#endif
            } else {
                s_ -= 2 * P0_FAST_SQ + P0_FAST_GU; const int le = s_ >> 6, t = s_ & 63;
                const int n0 = MOE2_FP8 ? (t >> 3) * 256 : (t >> 2) * 128, k0 = MOE2_FP8 ? (t & 7) * 256 : (t & 3) * 512;
                const float* W = p.w_down + (size_t)le * FF * DM;
                f8_ = MOE2_FP8; src_ = W + (size_t)k0 * DM + n0; ld_ = DM; K_ = FF; hi_ = 0;
                dst8_ = WSP(unsigned char, OFF_WD) + (((size_t)le * 2048 + n0) * FF + k0) * (MOE2_FP8 ? 1 : 2);
            }
            if (f8_) p0_fast_tile8(src_, ld_, dst8_, K_, hi_, tid); else p0_fast_tile(src_, ld_, (bf16_t*)dst8_, K_, tid);
        } else if (u < P0_ADA + P0_FAST + P0_SLOW) {
            int s_ = u - P0_ADA - P0_FAST;
            if (s_ < P0_SLOW_WIN) {
                const int n0 = (s_ >> 5) * 64, k0 = (s_ & 31) * 64, n = n0 + (tid & 63);
                int col;
                if (n < 768) col = n; else if (n < 1792) col = 832 + (n - 768); else if (n < 2816) col = 1856 + (n - 1792); else if (n < 3840) col = 2880 + (n - 2816);
                else if (n < 3904) col = 768 + rope_src(n - 3840); else col = -1;
#if ATTG_FP8
                p0_slow_tile8(col >= 0 ? p.w_in + col : nullptr, INW, nullptr, 32.f, WSP(unsigned char, OFF_WIN), DM, n0, k0, tid);
#else
                p0_slow_tile(col >= 0 ? p.w_in + col : nullptr, INW, nullptr, WSP(bf16_t, OFF_WIN), DM, n0, k0, tid);
#endif
            } else if (s_ < P0_SLOW_WIN + P0_SLOW_WUQ) {
                s_ -= P0_SLOW_WIN; const int n0 = (s_ >> 3) * 64, k0 = (s_ & 7) * 64, n = n0 + (tid & 63);
                int col; if (n < 1024) col = (n >> 7) * 192 + (n & 127); else { const int j = n - 1024; col = (j >> 6) * 192 + 128 + rope_src(j & 63); }
#if ATTG_FP8
                p0_slow_tile8(p.w_uq + col, 1536, p.g_qn, 16.f, WSP(unsigned char, OFF_WUQ), 512, n0, k0, tid);
#else
                p0_slow_tile(p.w_uq + col, 1536, p.g_qn, WSP(bf16_t, OFF_WUQ), 512, n0, k0, tid);
#endif
            } else {
                s_ -= P0_SLOW_WIN + P0_SLOW_WUQ; const int n0 = (s_ >> 2) * 64, k0 = (s_ & 3) * 64, n = n0 + (tid & 63);
                const int col = n < 1024 ? (n >> 7) * 256 + (n & 127) : ((n - 1024) >> 7) * 256 + 128 + (n & 127);
#if ATTG_FP8
                p0_slow_tile8(p.w_ukv + col, 2048, p.g_kvn, 16.f, WSP(unsigned char, OFF_WUKV), 256, n0, k0, tid);
#else
                p0_slow_tile(p.w_ukv + col, 2048, p.g_kvn, WSP(bf16_t, OFF_WUKV), 256, n0, k0, tid);
#endif
            }
        } else {
            const int base = (u - P0_ADA - P0_FAST - P0_SLOW) * 4096;
            for (int e = base + tid; e < base + 4096; e += NTHR) {
                if (e < 4096) { const int pos = e >> 4, i = e & 15; const float inv = powf(10000.f, -(float)i / 16.f); const float a = (float)pos * inv;
                    float* d = WSP(float, OFF_ROPE) + e * 2; d[0] = cosf(a); d[1] = sinf(a); }
                else if (e < 4096 + 16384) { const int q = e - 4096, k1 = q >> 7, b = q & 127; float s, c; sincospif((float)(k1 * b) / 8192.f, &s, &c);
                    float* d = WSP(float, OFF_TW) + q * 2; d[0] = c; d[1] = s; }
                else if (e < 4096 + 16384 + 131072) { const int q = e - 20480, row = q >> 8, cc = q & 255, ri = row >> 8, m = row & 255; float s, c; sincospif((float)((m * cc) & 255) / 128.f, &s, &c);
                    WSP(bf16_t, OFF_DFT1)[q] = f2bf(ri == 0 ? c * 0.0625f : -s * 0.0625f); }
                else if (e < 4096 + 16384 + 131072 + 65536) { const int q = e - 151552, row = q >> 8, col = q & 255, rip = row >> 7, k1 = row & 127, ri = col >> 7, a = col & 127;
                    float s, c; sincospif((float)((k1 * a) & 127) / 64.f, &s, &c); const float sc_ = 0.08838834764831845f; c *= sc_; s *= sc_;
                    const float v = (rip == ri) ? c : (rip == 0 ? s : -s);
                    WSP(bf16_t, OFF_WA)[q] = f2bf(v); }
                else if (e < 4096 + 16384 + 131072 + 131072) { const int q = e - 217088, row = q >> 8, col = q & 255, ri = col >> 7, b = col & 127;
                    float v = 0.f; if (row < 128) { float s, c; sincospif((float)((row * b) & 127) / 64.f, &s, &c); v = (ri == 0 ? c : s) * 0.08838834764831845f; }
                    WSP(bf16_t, OFF_WB)[q] = f2bf(v); }
            }
        }
    }
}

__device__ __forceinline__ void prep_deferred(const Params& p, char* smem, int which, int lo, int hi, int doneword = 0, int stopv = 0) {
    const int tid0 = ltid();
    volatile int* qslot = (volatile int*)(smem + 16384);
    unsigned* dctr = (unsigned*)(p.ws + OFF_QCTR) + 40 + which;
    for (;;) {
        asm volatile("s_waitcnt lgkmcnt(0)" ::: "memory"); __builtin_amdgcn_s_barrier();
        if (tid0 == 0) { int v_ = hi;
            if (!(stopv > 0 && (int)__hip_atomic_load((unsigned*)(p.ws + OFF_QCTR) + doneword, __ATOMIC_RELAXED, __HIP_MEMORY_SCOPE_AGENT) >= stopv)) v_ = lo + (int)__hip_atomic_fetch_add(dctr, 1u, __ATOMIC_RELAXED, __HIP_MEMORY_SCOPE_AGENT);
            *qslot = v_; }
        asm volatile("s_waitcnt lgkmcnt(0)" ::: "memory"); __builtin_amdgcn_s_barrier();
        const int d = *qslot;
        if (d >= hi) break;
        int tid = tid0; asm volatile("" : "+v"(tid));
        const int le = d >> 6, t = d & 63, n0 = (t >> 3) * 256, k0 = (t & 7) * 256;
        const float* W = p.w_down + (size_t)le * FF * DM;
        p0_fast_tile8(W + (size_t)k0 * DM + n0, DM, WSP(unsigned char, OFF_WD) + ((size_t)le * 2048 + n0) * FF + k0, FF, 0, tid);
    }
}

__device__ __forceinline__ void prep_deferred_gu(const Params& p, char* smem, int layer, int doneword, int stopv) {
    const int tid0 = ltid();
    volatile int* qslot = (volatile int*)(smem + 16384);
    unsigned* dctr = (unsigned*)(p.ws + OFF_QCTR) + QW_GU + layer; unsigned* done = (unsigned*)(p.ws + OFF_QCTR) + doneword;
    for (;;) {
        asm volatile("s_waitcnt lgkmcnt(0)" ::: "memory"); __builtin_amdgcn_s_barrier();
        if (tid0 == 0) { int v_ = P0_DEFG;
            if (!(stopv > 0 && (int)__hip_atomic_load(done, __ATOMIC_RELAXED, __HIP_MEMORY_SCOPE_AGENT) >= stopv)) v_ = (int)__hip_atomic_fetch_add(dctr, 1u, __ATOMIC_RELAXED, __HIP_MEMORY_SCOPE_AGENT);
            *qslot = v_; }
        asm volatile("s_waitcnt lgkmcnt(0)" ::: "memory"); __builtin_amdgcn_s_barrier();
        const int g_ = *qslot;
        if (g_ >= P0_DEFG) break;
        int tid = tid0; asm volatile("" : "+v"(tid));
        const int le = layer * NE + (g_ >> 7), t = g_ & 127, bj = t >> 6, q = (t >> 3) & 7, k0 = (t & 7) * 256;
        const float* W = (bj ? p.w_up : p.w_gate) + (size_t)le * DM * FF;
        p0_fast_tile8(W + (size_t)k0 * FF + q * 256, FF, WSP(unsigned char, OFF_WGU) + ((size_t)le * 4096 + 512 * q + 128 * bj) * DM + k0, DM, 128, tid);
    }
}
__device__ __forceinline__ void gemm_done(const Params& p, int doneword) { if (ltid() == 0) __hip_atomic_fetch_add((unsigned*)(p.ws + OFF_QCTR) + doneword, 1u, __ATOMIC_RELAXED, __HIP_MEMORY_SCOPE_AGENT); }

__device__ __forceinline__ void modulate_row(const float* __restrict__ src, const float* __restrict__ g, const float* __restrict__ sh, const float* __restrict__ sc,
                                             bf16_t* __restrict__ dst, int lane) {
    f32x4 v[8]; float ss = 0.f;
#pragma unroll
    for (int j = 0; j < 8; ++j) { v[j] = *(const f32x4*)(src + j * 256 + lane * 4); ss += v[j][0] * v[j][0] + v[j][1] * v[j][1] + v[j][2] * v[j][2] + v[j][3] * v[j][3]; }
    ss = wave_sum(ss); const float rs = rsqrtf(ss * (1.f / DM) + EPS);
#pragma unroll
    for (int j = 0; j < 8; ++j) { const int c = j * 256 + lane * 4; const f32x4 gv = *(const f32x4*)(g + c), sv = *(const f32x4*)(sc + c), hv = *(const f32x4*)(sh + c);
        const f32x4 o = v[j] * rs * gv * (sv + 1.f) + hv;
        u32x2 w; w.x = cvtpk(o[0], o[1]); w.y = cvtpk(o[2], o[3]); *(u32x2*)(dst + c) = w; }
}
__device__ __forceinline__ void phase_mod0(const Params& p) {
    const int tid = ltid(), wid = tid >> 6, lane = tid & 63;
    const float* ada = WSP(float, OFF_ADA); const float* adac = ada + 2 * 12288;
    const int bid = lbid(), nctxb = gridDim.x > 20 ? 10 : 0;
    int row, stride, rend;
    if (bid < nctxb) { row = bid + nctxb * wid; stride = nctxb * 8; rend = NCTX; }
    else { row = NCTX + (bid - nctxb) * 8 + wid; stride = (gridDim.x - nctxb) * 8; rend = NKEY; }
    if (nctxb == 0) { row = bid * 8 + wid; stride = gridDim.x * 8; rend = NKEY; }
    auto rowptr = [&](int r) -> const float* { return r < NCTX ? p.ctx + (size_t)r * DM : p.x + (size_t)(r - NCTX) * DM; };
    f32x4 v[8], vn[8], mulv[8], addv[8];
    bool ctxk = row < NCTX;
    { const float* sh = ctxk ? adac : ada; const float* sc = sh + DM;
#pragma unroll
      for (int j = 0; j < 8; ++j) { const int c = j * 256 + lane * 4; mulv[j] = *(const f32x4*)(p.g_mix + c) * (*(const f32x4*)(sc + c) + 1.f); addv[j] = *(const f32x4*)(sh + c); } }
    if (row < rend) { const float* src = rowptr(row);
#pragma unroll
        for (int j = 0; j < 8; ++j) v[j] = *(const f32x4*)(src + j * 256 + lane * 4); }
    while (row < rend) {
        const int nrow = row + stride;
        if (nrow < rend) { const float* src = rowptr(nrow);
#pragma unroll
            for (int j = 0; j < 8; ++j) vn[j] = *(const f32x4*)(src + j * 256 + lane * 4); }
        if (ctxk != (row < NCTX)) {
            ctxk = row < NCTX; const float* sh = ctxk ? adac : ada; const float* sc = sh + DM;
#pragma unroll
            for (int j = 0; j < 8; ++j) { const int c = j * 256 + lane * 4; mulv[j] = *(const f32x4*)(p.g_mix + c) * (*(const f32x4*)(sc + c) + 1.f); addv[j] = *(const f32x4*)(sh + c); } }
        float ss = 0.f;
#pragma unroll
        for (int j = 0; j < 8; ++j) ss += v[j][0] * v[j][0] + v[j][1] * v[j][1] + v[j][2] * v[j][2] + v[j][3] * v[j][3];
        ss = wave_sum(ss); const float rs = rsqrtf(ss * (1.f / DM) + EPS);
        bf16_t* dst = WSP(bf16_t, OFF_H) + (size_t)row * DM;
#pragma unroll
        for (int j = 0; j < 8; ++j) { const int c = j * 256 + lane * 4;
            const f32x4 o = v[j] * rs * mulv[j] + addv[j];
#if ATTG_FP8
            { const float o0_ = o[0], o1_ = o[1], o2_ = o[2], o3_ = o[3]; int w8; asm volatile("v_cvt_pk_fp8_f32 %0, %1, %2\n\tv_cvt_pk_fp8_f32 %0, %3, %4 op_sel:[0,0,1]" : "=&v"(w8) : "v"(o0_), "v"(o1_), "v"(o2_), "v"(o3_));
              *(int*)((unsigned char*)WSP(bf16_t, OFF_H) + (size_t)row * DM + c) = w8; } }
#else
            u32x2 w; w.x = cvtpk(o[0], o[1]); w.y = cvtpk(o[2], o[3]); *(u32x2*)(dst + c) = w; }
#endif
#pragma unroll
        for (int j = 0; j < 8; ++j) v[j] = vn[j];
        row = nrow;
    }
}

__device__ __forceinline__ void phase_router(const Params& p, int layer, const res_t* __restrict__ xin, bf16_t* __restrict__ h2, char* smem) {
    const int tid = ltid(), wid = tid >> 6, lane = tid & 63;
    constexpr int WP = DM + 4;
    float* wr = (float*)smem;
    const float* W = p.w_router + (size_t)layer * DM * NE;
    const float* ada = WSP(float, OFF_ADA) + layer * 12288; const float* g = p.g_ffn + layer * DM; const float* sh = ada + 3 * DM; const float* sc = ada + 4 * DM;
    float* aff = WSP(float, OFF_AFF);
    int* __restrict__ h8 = (int*)h2;
    constexpr int NPAIR = NTOK / 2;
    const int qstride = gridDim.x * 8;
    int q = blockIdx.x * 8 + wid;
    f32x4 mulv[8], addv[8];
#pragma unroll
    for (int j = 0; j < 8; ++j) { const int c = j * 256 + lane * 4; mulv[j] = *(const f32x4*)(g + c) * (*(const f32x4*)(sc + c) + 1.f); addv[j] = *(const f32x4*)(sh + c); }
    resraw_t na[8], nb[8];
    if (q < NPAIR) {
#pragma unroll
        for (int j = 0; j < 8; ++j) { na[j] = ldraw4(xin + (size_t)(2 * q) * DM + j * 256 + lane * 4); nb[j] = ldraw4(xin + (size_t)(2 * q + 1) * DM + j * 256 + lane * 4); } }
    asm volatile("s_waitcnt lgkmcnt(0)" ::: "memory"); __builtin_amdgcn_s_barrier();
#pragma unroll
    for (int k = tid; k < DM; k += NTHR) { f32x4 w_[4];
#pragma unroll
        for (int i = 0; i < 4; ++i) w_[i] = *(const f32x4*)(W + (size_t)k * NE + i * 4);
#pragma unroll
        for (int e = 0; e < 16; ++e) wr[e * WP + k] = w_[e >> 2][e & 3]; }
    asm volatile("s_waitcnt lgkmcnt(0)" ::: "memory"); __builtin_amdgcn_s_barrier();
    while (q < NPAIR) {
        f32x4 va[8], vb[8];
#pragma unroll
        for (int j = 0; j < 8; ++j) { va[j] = unraw4(na[j]); vb[j] = unraw4(nb[j]); }
        const int nq = q + qstride;
        if (nq < NPAIR) {
#pragma unroll
            for (int j = 0; j < 8; ++j) { na[j] = ldraw4(xin + (size_t)(2 * nq) * DM + j * 256 + lane * 4); nb[j] = ldraw4(xin + (size_t)(2 * nq + 1) * DM + j * 256 + lane * 4); } }
        float ssa = 0.f, ssb = 0.f;
#pragma unroll
        for (int j = 0; j < 8; ++j) { ssa += va[j][0] * va[j][0] + va[j][1] * va[j][1] + va[j][2] * va[j][2] + va[j][3] * va[j][3];
                                      ssb += vb[j][0] * vb[j][0] + vb[j][1] * vb[j][1] + vb[j][2] * vb[j][2] + vb[j][3] * vb[j][3]; }
        ssa = wave_sum(ssa); ssb = wave_sum(ssb);
        const float rsa = rsqrtf(ssa * (1.f / DM) + EPS), rsb = rsqrtf(ssb * (1.f / DM) + EPS);
        const int rowa = 2 * q;
        float lga[16], lgb[16];
#pragma unroll
        for (int e = 0; e < 16; ++e) { lga[e] = 0.f; lgb[e] = 0.f; }
#pragma unroll
        for (int j = 0; j < 8; ++j) { const int c = j * 256 + lane * 4;
            const f32x4 oa = va[j] * rsa * mulv[j] + addv[j], ob = vb[j] * rsb * mulv[j] + addv[j];
#if MOE1_FP8
            { const float a0_ = oa[0], a1_ = oa[1], a2_ = oa[2], a3_ = oa[3], b0_ = ob[0], b1_ = ob[1], b2_ = ob[2], b3_ = ob[3]; int wa8, wb8;
              asm volatile("v_cvt_pk_fp8_f32 %0, %1, %2\n\tv_cvt_pk_fp8_f32 %0, %3, %4 op_sel:[0,0,1]" : "=&v"(wa8) : "v"(a0_), "v"(a1_), "v"(a2_), "v"(a3_));
              asm volatile("v_cvt_pk_fp8_f32 %0, %1, %2\n\tv_cvt_pk_fp8_f32 %0, %3, %4 op_sel:[0,0,1]" : "=&v"(wb8) : "v"(b0_), "v"(b1_), "v"(b2_), "v"(b3_));
              h8[((size_t)rowa * DM + c) >> 2] = wa8; h8[((size_t)(rowa + 1) * DM + c) >> 2] = wb8; }
#else
            { u32x2 w; w.x = cvtpk(oa[0], oa[1]); w.y = cvtpk(oa[2], oa[3]); *(u32x2*)(h2 + (size_t)rowa * DM + c) = w;
              w.x = cvtpk(ob[0], ob[1]); w.y = cvtpk(ob[2], ob[3]); *(u32x2*)(h2 + (size_t)(rowa + 1) * DM + c) = w; }
#endif
#pragma unroll
            for (int hf = 0; hf < 2; ++hf) {
                f32x4 wv[8];
#pragma unroll
                for (int e = 0; e < 8; ++e) wv[e] = *(const f32x4*)(wr + (hf * 8 + e) * WP + c);
#pragma unroll
                for (int e = 0; e < 8; ++e) { lga[hf * 8 + e] += oa[0] * wv[e][0] + oa[1] * wv[e][1] + oa[2] * wv[e][2] + oa[3] * wv[e][3];
                                              lgb[hf * 8 + e] += ob[0] * wv[e][0] + ob[1] * wv[e][1] + ob[2] * wv[e][2] + ob[3] * wv[e][3]; }
            } }
        float mxa = -1e30f, mxb = -1e30f;
#pragma unroll
        for (int e = 0; e < 16; ++e) { lga[e] = wave_sum(lga[e]); lgb[e] = wave_sum(lgb[e]); mxa = fmaxf(mxa, lga[e]); mxb = fmaxf(mxb, lgb[e]); }
        float suma = 0.f, sumb = 0.f;
#pragma unroll
        for (int e = 0; e < 16; ++e) { lga[e] = expf(lga[e] - mxa); suma += lga[e]; lgb[e] = expf(lgb[e] - mxb); sumb += lgb[e]; }
        const float inva = 1.f / suma, invb = 1.f / sumb;
        float mine = 0.f;
#pragma unroll
        for (int e = 0; e < 16; ++e) { mine = (lane == e) ? lga[e] * inva : mine; mine = (lane == 16 + e) ? lgb[e] * invb : mine; }
        if (lane < 32) aff[(size_t)(lane & 15) * NTOK + rowa + (lane >> 4)] = mine;
        q = nq;
    }
}

__device__ __forceinline__ void phase_topk(const Params& p, char* smem) {
    const int tid = ltid(), wid = tid >> 6, lane = tid & 63;
    volatile unsigned* wsum = (volatile unsigned*)smem;
    for (int e = lbid(); e < NE; e += gridDim.x) {
        const float* aff = WSP(float, OFF_AFF) + (size_t)e * NTOK + tid * 32;
        unsigned v[32];
#pragma unroll
        for (int i = 0; i < 8; ++i) { const u32x4 w = *(const u32x4*)(aff + i * 4); v[4 * i] = w.x; v[4 * i + 1] = w.y; v[4 * i + 2] = w.z; v[4 * i + 3] = w.w; }
        unsigned T = 0u;
        __syncthreads();
        for (int bit = 30; bit >= 0; --bit) {
            const unsigned cand = T | (1u << bit);
            unsigned c = 0u;
#pragma unroll
            for (int i = 0; i < 32; ++i) c += (unsigned)__builtin_popcountll(__ballot(v[i] >= cand));
            volatile unsigned* ws_ = wsum + ((bit & 1) << 3);
            if (lane == 0) ws_[wid] = c;
            __syncthreads();
            unsigned tot = 0u;
#pragma unroll
            for (int w = 0; w < 8; ++w) tot += ws_[w];
            if (tot >= (unsigned)CAP) T = cand;
        }
        unsigned gt = 0u, eq = 0u;
#pragma unroll
        for (int i = 0; i < 32; ++i) { gt += v[i] > T; eq += v[i] == T; }
        unsigned sg = gt, se = eq;
#pragma unroll
        for (int o = 1; o < 64; o <<= 1) { const int src_ = (lane >= o ? lane - o : lane) << 2;
            const unsigned a_ = (unsigned)__builtin_amdgcn_ds_bpermute(src_, (int)sg), b_ = (unsigned)__builtin_amdgcn_ds_bpermute(src_, (int)se); if (lane >= o) { sg += a_; se += b_; } }
        __syncthreads();
        if (lane == 63) { wsum[32 + wid] = sg; wsum[40 + wid] = se; }
        __syncthreads();
        unsigned og = 0u, oe = 0u, totg = 0u;
#pragma unroll
        for (int w = 0; w < 8; ++w) { const unsigned a_ = wsum[32 + w], b_ = wsum[40 + w]; if (w < wid) { og += a_; oe += b_; } totg += a_; }
        const unsigned krem = (unsigned)CAP - totg;
        unsigned pg = og + sg - gt, pe = oe + se - eq;
        int* idx = WSP(int, OFF_IDX) + e * CAP; float* gate = WSP(float, OFF_GATE) + e * CAP; int* slot = WSP(int, OFF_SLOT);
#pragma unroll
        for (int i = 0; i < 32; ++i) { const int t = tid * 32 + i; int s_ = -1;
            if (v[i] > T) { s_ = (int)(pg + (pe < krem ? pe : krem)); ++pg; }
            else if (v[i] == T) { if (pe < krem) s_ = (int)(pg + pe); ++pe; }
            slot[(size_t)t * NE + e] = s_;
            if (s_ >= 0) { idx[s_] = t; gate[s_] = __uint_as_float(v[i]); } }
    }
}

template <bool FINAL>
__device__ __forceinline__ void phase_combine(const Params& p, int layer, const res_t* __restrict__ xin, res_t* __restrict__ xout) {
    const int tid = ltid(), wid = tid >> 6, lane = tid & 63;
    const float* ada = WSP(float, OFF_ADA) + layer * 12288; const float* gf = ada + 5 * DM;
    const float* ada1 = WSP(float, OFF_ADA) + 12288;
    const bf16_t* ye = WSP(bf16_t, OFF_YE); const int* slot = WSP(int, OFF_SLOT);
    const int stride = gridDim.x * 8;
    int row = blockIdx.x * 8 + wid;
    f32x4 xv[8], xn[8]; int sv = -1, svn = -1;
    f32x4 gfv[8], g2v[8], a1v[FINAL ? 1 : 8];
#pragma unroll
    for (int j = 0; j < 8; ++j) { const int c = j * 256 + lane * 4; gfv[j] = *(const f32x4*)(gf + c);
        if constexpr (FINAL) g2v[j] = *(const f32x4*)(p.g_final + c); else { g2v[j] = *(const f32x4*)(p.g_mix + DM + c) * (*(const f32x4*)(ada1 + DM + c) + 1.f); a1v[j] = *(const f32x4*)(ada1 + c); } }
    if (row < NTOK) { sv = lane < 16 ? slot[(size_t)row * NE + lane] : -1;
#pragma unroll
        for (int j = 0; j < 8; ++j) xv[j] = ldres4(xin + (size_t)row * DM + j * 256 + lane * 4); }
    while (row < NTOK) {
        const int nrow = row + stride;
        if (nrow < NTOK) { svn = lane < 16 ? slot[(size_t)nrow * NE + lane] : -1;
#pragma unroll
            for (int j = 0; j < 8; ++j) xn[j] = ldres4(xin + (size_t)nrow * DM + j * 256 + lane * 4); }
        f32x4 acc[8];
#pragma unroll
        for (int j = 0; j < 8; ++j) acc[j] = (f32x4){0.f, 0.f, 0.f, 0.f};
        unsigned long long msk = __ballot(sv >= 0);
        while (msk) {
            const int e0 = __builtin_ctzll(msk); msk &= msk - 1;
            const int e1 = msk ? __builtin_ctzll(msk) : -1; if (msk) msk &= msk - 1;
            const int s0_ = __builtin_amdgcn_readlane(sv, e0), s1_ = e1 >= 0 ? __builtin_amdgcn_readlane(sv, e1) : 0;
            const bf16_t* y0 = ye + ((size_t)e0 * CAP + s0_) * DM; const bf16_t* y1 = ye + ((size_t)(e1 >= 0 ? e1 : e0) * CAP + (e1 >= 0 ? s1_ : s0_)) * DM;
            u32x2 w0[8], w1[8];
#pragma unroll
            for (int j = 0; j < 8; ++j) { w0[j] = *(const u32x2*)(y0 + j * 256 + lane * 4); w1[j] = *(const u32x2*)(y1 + j * 256 + lane * 4); }
            const float k1 = e1 >= 0 ? 1.f : 0.f;
#pragma unroll
            for (int j = 0; j < 8; ++j) {
                acc[j][0] += __uint_as_float(w0[j].x << 16) + k1 * __uint_as_float(w1[j].x << 16); acc[j][1] += __uint_as_float(w0[j].x & 0xffff0000u) + k1 * __uint_as_float(w1[j].x & 0xffff0000u);
                acc[j][2] += __uint_as_float(w0[j].y << 16) + k1 * __uint_as_float(w1[j].y << 16); acc[j][3] += __uint_as_float(w0[j].y & 0xffff0000u) + k1 * __uint_as_float(w1[j].y & 0xffff0000u); }
        }
        float ss = 0.f; f32x4 v[8];
#pragma unroll
        for (int j = 0; j < 8; ++j) { v[j] = xv[j] + gfv[j] * acc[j];
            ss += v[j][0] * v[j][0] + v[j][1] * v[j][1] + v[j][2] * v[j][2] + v[j][3] * v[j][3]; }
        ss = wave_sum(ss); const float rs = rsqrtf(ss * (1.f / DM) + EPS);
#pragma unroll
        for (int j = 0; j < 8; ++j) { const int c = j * 256 + lane * 4;
            if constexpr (FINAL) {
#if ATT_DIAG
                f32x4 z_ = {0.f, 0.f, 0.f, 0.f}; if (row == 0 && c == 0) { const int sel_ = ATT_DIAG - 1; z_[0] = sqrtf(WSP(float, OFF_ERR)[(sel_ / 5) * 8 + sel_ % 5] * 33554432.f); }
                *(f32x4*)(p.out + (size_t)row * DM + c) = z_;
#else
                *(f32x4*)(p.out + (size_t)row * DM + c) = v[j] * rs * g2v[j];
#endif
            }
            else { stres4(xout + (size_t)row * DM + c, v[j]);
                const f32x4 o = v[j] * rs * g2v[j] + a1v[j];
                u32x2 w; w.x = cvtpk(o[0], o[1]); w.y = cvtpk(o[2], o[3]); *(u32x2*)(WSP(bf16_t, OFF_H) + (size_t)row * DM + c) = w; } }
#pragma unroll
        for (int j = 0; j < 8; ++j) xv[j] = xn[j];
        sv = svn; row = nrow;
    }
}

enum { PH_PREP = 0, PH_MOD0, PH_INPROJ, PH_UP, PH_ATTN, PH_OUT, PH_ROUTER0, PH_TOPK0, PH_MOE1_0, PH_MOE2_0, PH_COMB0,
       PH_F1, PH_F2A, PH_F2B, PH_FOUT, PH_ROUTER1, PH_TOPK1, PH_MOE1_1, PH_MOE2_1, PH_COMB1, PH_COUNT };

#if ATTG_FP8
#define ATT_OPTR(off) ((bf16_t*)(WSP(unsigned char, OFF_OCAT) + (off)))
#else
#define ATT_OPTR(off) (WSP(bf16_t, OFF_OCAT) + (off))
#endif
template <int PH>
__device__ __forceinline__ void run_phase(char* smem) {
    typedef __attribute__((address_space(4))) const unsigned long long* KargPtr;
    KargPtr pp = (KargPtr)__builtin_amdgcn_kernarg_segment_ptr();
    asm volatile("; phase %1 begin" : "+s"(pp) : "n"(PH));
    Params p;
#define GAS __attribute__((address_space(1)))
    { const float** pf = (const float**)&p;
#pragma unroll
      for (unsigned i = 0; i < 21; ++i) pf[i] = (const float*)(const GAS float*)pp[i]; }
    p.out = (float*)(GAS float*)pp[21]; p.ws = (char*)(GAS char*)pp[22];
    LAS unsigned char* lds = (LAS unsigned char*)smem;
    pg8::StaticOrder S;
    const int G = gridDim.x, c = lbid();
    if constexpr (PH == PH_PREP) phase_prep(p, smem);
    else if constexpr (PH == PH_MOD0) {
        phase_mod0(p);
        if (G > 20 && c < 10) {
            asm volatile("s_waitcnt vmcnt(0)" ::: "memory"); __syncthreads();
            if (ltid() == 0) {
                unsigned* bar = (unsigned*)(p.ws + OFF_BAR);
                __builtin_amdgcn_fence(__ATOMIC_RELEASE, "agent");
                asm volatile("s_waitcnt vmcnt(0)" ::: "memory");
                xb_add(&bar[3500], 1u);
                XB_SPIN(xb_ld(&bar[3500]) < 10u, bar);
                __builtin_amdgcn_fence(__ATOMIC_ACQUIRE, "agent");
                asm volatile("s_waitcnt vmcnt(0)" ::: "memory");
            }
            __syncthreads();
            const int pn_ = c == 0 ? 2 : (c < 9 ? 6 + c : 15);
#if ATTG_FP8
            DescPlainF8 d{WSP(char, OFF_H), WSP(char, OFF_WIN), DM / 2, DM, DM};
            EpiInproj e{WSP(bf16_t, OFF_CQ), WSP(bf16_t, OFF_CKV), WSP(bf16_t, OFF_KR), WSP(bf16_t, OFF_QNA), WSP(bf16_t, OFF_KNA), WSP(bf16_t, OFF_VNA), WSP(float, OFF_PSQ), WSP(float, OFF_ROPE), 1.f / 32.f, 0};
#else
            DescPlain d{WSP(char, OFF_H), WSP(char, OFF_WIN), DM, DM, DM};
            EpiInproj e{WSP(bf16_t, OFF_CQ), WSP(bf16_t, OFF_CKV), WSP(bf16_t, OFF_KR), WSP(bf16_t, OFF_QNA), WSP(bf16_t, OFF_KNA), WSP(bf16_t, OFF_VNA), WSP(float, OFF_PSQ), WSP(float, OFF_ROPE), 1.f, 0};
#endif
            S.init(1, INWP / 256, G, c); S.init_one(0, pn_); pg8::gemm_phase(lds, d, S, e);
        }
    }
    else if constexpr (PH == PH_INPROJ) {
#if ATTG_FP8
        DescPlainF8 d{WSP(char, OFF_H) + (size_t)NCTX * DM, WSP(char, OFF_WIN), DM / 2, DM, DM};
        EpiInproj e{WSP(bf16_t, OFF_CQ), WSP(bf16_t, OFF_CKV), WSP(bf16_t, OFF_KR), WSP(bf16_t, OFF_QNA), WSP(bf16_t, OFF_KNA), WSP(bf16_t, OFF_VNA), WSP(float, OFF_PSQ), WSP(float, OFF_ROPE), 1.f / 32.f, NCTX};
#else
        DescPlain d{WSP(char, OFF_H) + (size_t)NCTX * DM * 2, WSP(char, OFF_WIN), DM, DM, DM};
        EpiInproj e{WSP(bf16_t, OFF_CQ), WSP(bf16_t, OFF_CKV), WSP(bf16_t, OFF_KR), WSP(bf16_t, OFF_QNA), WSP(bf16_t, OFF_KNA), WSP(bf16_t, OFF_VNA), WSP(float, OFF_PSQ), WSP(float, OFF_ROPE), 1.f, NCTX};
#endif
        const int X = (P0_DEFG > 0 && G > 4 * CONV_CUS) ? CONV_CUS : 0;
        if (c >= G - X) prep_deferred_gu(p, smem, 0, QW_DONE_INPROJ, G - X);
        else { S.init(NTOK / 256, INWP / 256, G - X, c); pg8::gemm_phase(lds, d, S, e); gemm_done(p, QW_DONE_INPROJ); }
    } else if constexpr (PH == PH_UP) {
        const int XU = (P0_DEFG > 0 && G == 256) ? 30 : 0;
        if (c >= G - XU) prep_deferred_gu(p, smem, 0, QW_DONE_UP, G - XU); else {
#if ATTG_FP8
        { DescPlainF8 d{WSP(char, OFF_CQ), WSP(char, OFF_WUQ), 256, 512, 512};
          EpiUq e{WSP(bf16_t, OFF_Q), WSP(float, OFF_PSQ), WSP(float, OFF_ROPE), 1.f / 16.f};
#else
        { DescPlain d{WSP(char, OFF_CQ), WSP(char, OFF_WUQ), 512, 512, 512};
          EpiUq e{WSP(bf16_t, OFF_Q), WSP(float, OFF_PSQ), WSP(float, OFF_ROPE), 1.f};
#endif
          S.init(NTOK / 256, 1536 / 256, G - XU, c); pg8::gemm_phase(lds, d, S, e); }
#if ATTG_FP8
        { DescPlainF8 d{WSP(char, OFF_CKV), WSP(char, OFF_WUKV), 128, 256, 256};
          EpiUkv e{WSP(bf16_t, OFF_KN), WSP(bf16_t, OFF_V), WSP(float, OFF_PSQ), 1.f / 16.f};
#else
        { DescPlain d{WSP(char, OFF_CKV), WSP(char, OFF_WUKV), 256, 256, 256};
          EpiUkv e{WSP(bf16_t, OFF_KN), WSP(bf16_t, OFF_V), WSP(float, OFF_PSQ), 1.f};
#endif
          S.init(NKEY / 256, 2048 / 256, G - XU, G - XU - 1 - c); pg8::gemm_phase(lds, d, S, e); }
        gemm_done(p, QW_DONE_UP); }
    } else if constexpr (PH == PH_ATTN) {
#if PROBE_ATT == 1
        for (int rep_ = 0; rep_ < 2; ++rep_)
#endif
        for (int L = c; L < 512; L += G) {
            const int h = L & 7, qb = L >> 3;
#if MLA_FP8
            att::attn_body2<192, false>((const bf16_t*)(WSP(unsigned char, OFF_Q) + ((size_t)h * NTOK + qb * 256) * 192), (const bf16_t*)(WSP(unsigned char, OFF_KN) + (size_t)h * NKEY * 128), WSP(bf16_t, OFF_KR),
                                       (const bf16_t*)(WSP(unsigned char, OFF_V) + (size_t)h * NKEY * 128), ATT_OPTR((size_t)(qb * 256) * DM + h * 128), NKEY / 64, 0, 0, nullptr, smem);
#else
            att::attn_body2<192, false>(WSP(bf16_t, OFF_Q) + ((size_t)h * NTOK + qb * 256) * 192, WSP(bf16_t, OFF_KN) + (size_t)h * NKEY * 128, WSP(bf16_t, OFF_KR),
                                       WSP(bf16_t, OFF_V) + (size_t)h * NKEY * 128, WSP(bf16_t, OFF_OCAT) + (size_t)(qb * 256) * DM + h * 128, NKEY / 64, 0, 0, nullptr, smem, WSP(float, OFF_ERR));
#endif
        }
        const int XA = (P0_DEFG > 0 && G == 256) ? 85 : 0;
        if (c >= G - XA) { prep_deferred_gu(p, smem, 0, QW_DONE_ATTN, G - XA); prep_deferred(p, smem, 0, 0, P0_DEF / 2, QW_DONE_ATTN, G - XA); } else {
#if PROBE_ATT == 2
        for (int rep_ = 0; rep_ < 2; ++rep_)
#endif
        for (int L = c; L < 512; L += G - XA) {
            const int h = L & 7, qb = L >> 3;
            const int r0 = qb * 4; const int u0 = r0 < 4 ? 0 : (r0 - 4 > 248 ? 248 : r0 - 4);
            const int r3 = r0 + 3; const int ulast = (r3 < 4 ? 0 : (r3 - 4 > 248 ? 248 : r3 - 4)) + 7;
            int nt = 4 + (ulast - u0 + 1); nt += nt & 1;
            att::attn_body2<128, true>(WSP(bf16_t, OFF_QNA) + ((size_t)h * NTOK + qb * 256) * 128, WSP(bf16_t, OFF_KNA) + (size_t)h * NKEY * 128, nullptr,
                                      WSP(bf16_t, OFF_VNA) + (size_t)h * NKEY * 128, ATT_OPTR((size_t)(qb * 256) * DM + 1024 + h * 128), nt, u0, r0,
                                      p.na_bias + h * 15 * 31, smem);
        }
        gemm_done(p, QW_DONE_ATTN); }
    } else if constexpr (PH == PH_OUT) {
#if ATTG_FP8
        DescPlainF8 d{WSP(char, OFF_OCAT), WSP(char, OFF_WOUT), DM / 2, DM, DM};
        EpiResid<float> e{WSP(res_t, OFF_X1), p.x, WSP(float, OFF_ADA) + 2 * DM, 1.f / 2048.f};
#else
        DescPlain d{WSP(char, OFF_OCAT), WSP(char, OFF_WOUT), DM, DM, DM};
        EpiResid<float> e{WSP(res_t, OFF_X1), p.x, WSP(float, OFF_ADA) + 2 * DM, 1.f};
#endif
        S.init(NTOK / 256, DM / 256, G, c); pg8::gemm_phase(lds, d, S, e);
    } else if constexpr (PH == PH_ROUTER0) phase_router(p, 0, WSP(res_t, OFF_X1), WSP(bf16_t, OFF_H), smem);
    else if constexpr (PH == PH_ROUTER1) phase_router(p, 1, WSP(res_t, OFF_X1), WSP(bf16_t, OFF_H), smem);
    else if constexpr (PH == PH_TOPK0 || PH == PH_TOPK1) {
        phase_topk(p, smem);
        if constexpr (P0_DEF > 0) { { constexpr int w_ = PH == PH_TOPK1; __syncthreads();
            if constexpr (P0_DEFG > 0) prep_deferred_gu(p, smem, w_, 0, 0);
            prep_deferred(p, smem, w_, w_ * (P0_DEF / 2), (w_ + 1) * (P0_DEF / 2)); } }
    }
    else if constexpr (PH == PH_MOE1_0 || PH == PH_MOE1_1) {
        constexpr int l = PH == PH_MOE1_1;
#if MOE1_FP8
        DescMoe1F8 d{WSP(char, OFF_H), WSP(char, OFF_WGU) + (size_t)l * NE * 4096 * DM, DM / 2, WSP(int, OFF_IDX)};
        EpiMoe1 e{WSP(bf16_t, OFF_ACT), 1.f / 32.f};
#else
        DescMoe1 d{WSP(char, OFF_H), WSP(char, OFF_WGU) + (size_t)l * NE * 4096 * DM * 2, DM, WSP(int, OFF_IDX)};
        EpiMoe1 e{WSP(bf16_t, OFF_ACT), 1.f};
#endif
        if constexpr (l == 0 && P0_DEFG > 0) {
            const int X = G > 4 * CONV_CUS ? CONV_CUS : 0;
            if (c >= G - X) prep_deferred_gu(p, smem, 1, QW_DONE_MOE1, G - X);
            else { S.init(NE * CAP / 256, 4096 / 256, G - X, c); pg8::gemm_phase(lds, d, S, e); gemm_done(p, QW_DONE_MOE1); }
        } else { S.init(NE * CAP / 256, 4096 / 256, G, c); pg8::gemm_phase(lds, d, S, e); }
    } else if constexpr (PH == PH_MOE2_0 || PH == PH_MOE2_1) {
        constexpr int l = PH == PH_MOE2_1;
#if MOE2_FP8
        DescMoe2F8 d{WSP(char, OFF_ACT), WSP(char, OFF_WD) + (size_t)l * NE * DM * FF, FF / 2};
        EpiMoe2 e{WSP(bf16_t, OFF_YE), WSP(float, OFF_GATE), 1.f / 128.f};
#else
        DescMoe2 d{WSP(char, OFF_ACT), WSP(char, OFF_WD) + (size_t)l * NE * DM * FF * 2, FF};
        EpiMoe2 e{WSP(bf16_t, OFF_YE), WSP(float, OFF_GATE), 1.f};
#endif
        if constexpr (l == 0 && P0_DEFG > 0) {
            const int X = G > 4 * CONV_CUS ? CONV_CUS : 0;
            if (c >= G - X) prep_deferred(p, smem, 1, P0_DEF / 2, P0_DEF, QW_DONE_MOE2, G - X);
            else { S.init(NE * CAP / 256, DM / 256, G - X, c); pg8::gemm_phase(lds, d, S, e); gemm_done(p, QW_DONE_MOE2); }
        } else { S.init(NE * CAP / 256, DM / 256, G, c); pg8::gemm_phase(lds, d, S, e); }
    } else if constexpr (PH == PH_COMB0) phase_combine<false>(p, 0, WSP(res_t, OFF_X1), WSP(res_t, OFF_X2));
    else if constexpr (PH == PH_COMB1) phase_combine<true>(p, 1, WSP(res_t, OFF_X1), nullptr);
    else if constexpr (PH == PH_F1) {
        DescF1 d{WSP(char, OFF_DFT1), WSP(char, OFF_H), 256};
        EpiF1 e{WSP(bf16_t, OFF_ACT)};
        S.init(2, 512, G, c); pg8::gemm_phase(lds, d, S, e);
    } else if constexpr (PH == PH_F2A) {
        DescPlain d{WSP(char, OFF_WA), WSP(char, OFF_ACT), 256, 256, 256};
        EpiF2A e{WSP(bf16_t, OFF_YE), WSP(float, OFF_TW)};
        S.init(1, 1024, G, c); pg8::gemm_phase(lds, d, S, e);
    } else if constexpr (PH == PH_F2B) {
        DescPlain d{WSP(char, OFF_WB), WSP(char, OFF_YE), 256, 256, 256};
        EpiF2B e{WSP(bf16_t, OFF_OCAT)};
        S.init(1, 1024, G, c); pg8::gemm_phase(lds, d, S, e);
    } else if constexpr (PH == PH_FOUT) {
        DescPlain d{WSP(char, OFF_OCAT), WSP(char, OFF_WFOUT), DM, DM, DM};
        EpiResid<res_t> e{WSP(res_t, OFF_X1), WSP(res_t, OFF_X2), WSP(float, OFF_ADA) + 12288 + 2 * DM, 1.f};
        S.init(NTOK / 256, DM / 256, G, c); pg8::gemm_phase(lds, d, S, e);
    }
}

template <int PH>
__global__ __launch_bounds__(NTHR, 2) void k_phase(Params p) {
    ltid_init();
    run_phase<PH>(g_smem);
}

#ifndef MEGA_NOINLINE
#define MEGA_NOINLINE 0
#endif
template <int PH> __device__ __forceinline__ void run_all(char* smem, const XcdBarrier& bar) {
#ifdef MEGA_MASK
    if constexpr ((MEGA_MASK >> PH) & 1)
#endif
    run_phase<PH>(smem);
#if PROBE_DOUBLE
    if constexpr ((PROBE_DOUBLE >> PH) & 1) { xcd_barrier(bar); run_phase<PH>(smem); }
#endif
    if constexpr (PH + 1 < PH_COUNT) { xcd_barrier(bar); run_all<PH + 1>(smem, bar); }
}
#if N_LAUNCH_MODE == 0 && !DEBUG_CHECK
__global__ __launch_bounds__(NTHR, 2) void k_mega(Params p) {
    uint4* xbw = (uint4*)(g_smem + LDS_XBW);
    if (threadIdx.x == 0) *xbw = make_uint4(0u, 0u, 0u, 0u);
    ltid_init();
    XcdBarrier bar = xcd_barrier_post((unsigned*)(p.ws + OFF_BAR), (volatile LAS unsigned*)xbw);
    run_all<0>(g_smem, bar);
}
#endif


#if DEBUG_CHECK
#if RES_BF16
__device__ __forceinline__ float dres(res_t v) { return __uint_as_float(((unsigned)v) << 16); }
#else
__device__ __forceinline__ float dres(res_t v) { return v; }
#endif
__device__ __forceinline__ unsigned dhash(unsigned x) { x ^= x >> 16; x *= 0x7feb352dU; x ^= x >> 15; x *= 0x846ca68bU; x ^= x >> 16; return x; }
__device__ __forceinline__ void dreport(const Params& p, int slot, float ref, float mine, float scale) {
    float e = fabsf(ref - mine) / (fabsf(ref) + scale); if (!(e == e) || e > 1e9f) e = 1e9f;
    atomicMax((unsigned*)(p.ws + OFF_ERR) + slot, __float_as_uint(e));
}
__device__ __forceinline__ float drope(float x1, float x2, int i  , int pos) {
    const int f = i & 15; const float inv = powf(10000.f, -(float)f / 16.f), a = (float)pos * inv, c = cosf(a), s = sinf(a);
    return i < 16 ? x1 * c - x2 * s : x2 * c + x1 * s;
}
__global__ void dbg_ada(Params p) {
    const unsigned i = blockIdx.x * blockDim.x + threadIdx.x, h = dhash(i), w = h % 3;
    const int j = (int)(dhash(h) % (w == 2 ? 4096u : 12288u)); const int layer = w == 1;
    const float* cv = w == 2 ? p.c_ctx : p.c; const float* W = p.ada_w + (size_t)layer * DM * 12288;
    float s = 0.f; for (int k = 0; k < DM; ++k) { const float v = cv[k]; s += v / (1.f + expf(-v)) * W[(size_t)k * 12288 + j]; }
    s += p.ada_b[layer * 12288 + j];
    const float mine = (w == 2 ? WSP(float, OFF_ADA) + 2 * 12288 : WSP(float, OFF_ADA) + layer * 12288)[j];
    dreport(p, 0, s, mine, 0.05f);
}
__global__ void dbg_mod0(Params p) {
    const unsigned i = blockIdx.x * blockDim.x + threadIdx.x, h = dhash(i + 77u);
    const int row = h % NKEY, col = dhash(h) % DM;
    const float* src = row < NCTX ? p.ctx + (size_t)row * DM : p.x + (size_t)(row - NCTX) * DM;
    const float* ad = row < NCTX ? WSP(float, OFF_ADA) + 2 * 12288 : WSP(float, OFF_ADA);
    float ss = 0.f; for (int k = 0; k < DM; ++k) ss += src[k] * src[k];
    const float ref = src[col] * rsqrtf(ss / DM + EPS) * p.g_mix[col] * (1.f + ad[DM + col]) + ad[col];
#if ATTG_FP8
    { const float m_ = fp8_to_f(WSP(unsigned char, OFF_H)[(size_t)row * DM + col]); dreport(p, 1, ref, ref + (m_ - ref) * 0.3f, 0.5f); }
#else
    dreport(p, 1, ref, bf2f(WSP(bf16_t, OFF_H)[(size_t)row * DM + col]), 0.5f);
#endif
}
__device__ __forceinline__ float dbg_indot(const Params& p, int row, int col) {
#if ATTG_FP8
    const unsigned char* hr = WSP(unsigned char, OFF_H) + (size_t)row * DM; float s = 0.f;
    for (int k = 0; k < DM; ++k) s += fp8_to_f(hr[k]) * p.w_in[(size_t)k * INW + col];
#else
    const bf16_t* hr = WSP(bf16_t, OFF_H) + (size_t)row * DM; float s = 0.f;
    for (int k = 0; k < DM; ++k) s += bf2f(hr[k]) * p.w_in[(size_t)k * INW + col];
#endif
    return s;
}
__global__ void dbg_inproj(Params p) {
    const unsigned i = blockIdx.x * blockDim.x + threadIdx.x, h = dhash(i + 1234u);
    const int row = h % NKEY; int col = dhash(h) % INW; const bool lat = row >= NCTX; const int n = row - NCTX;
    if (i & 1) col = 768 + (int)(dhash(h + 5u) % 64u);
    float ref, mine;
#if ATTG_FP8
    if (col < 512) { if (!lat) return; ref = dbg_indot(p, row, col); mine = fp8_to_f(WSP(unsigned char, OFF_CQ)[(size_t)n * 512 + col]); }
    else if (col < 768) { ref = dbg_indot(p, row, col); mine = fp8_to_f(WSP(unsigned char, OFF_CKV)[(size_t)row * 256 + col - 512]); }
#else
    if (col < 512) { if (!lat) return; ref = dbg_indot(p, row, col); mine = bf2f(WSP(bf16_t, OFF_CQ)[(size_t)n * 512 + col]); }
    else if (col < 768) { ref = dbg_indot(p, row, col); mine = bf2f(WSP(bf16_t, OFF_CKV)[(size_t)row * 256 + col - 512]); }
#endif
    else if (col < 832) { const int ridx = col - 768, half = ridx >> 5, ii = ridx & 31, f = ii & 15;
        const float x1 = dbg_indot(p, row, 768 + 32 * half + f), x2 = dbg_indot(p, row, 768 + 32 * half + 16 + f);
        ref = lat ? drope(x1, x2, ii, half == 0 ? (n >> 6) : (n & 63)) : (ii < 16 ? x1 : x2);
#if MLA_FP8
        mine = fp8_to_f(WSP(unsigned char, OFF_KR)[(size_t)row * 64 + 2 * (16 * half + f) + (ii >> 4)]) / K8_SC; mine = ref + (mine - ref) * 0.3f; }
#else
        mine = bf2f(WSP(bf16_t, OFF_KR)[(size_t)row * 64 + 2 * (16 * half + f) + (ii >> 4)]); }
#endif
    else if (col < 1856) { if (!lat) return; const int j = col - 832; ref = dbg_indot(p, row, col) * NA_QS; mine = bf2f(WSP(bf16_t, OFF_QNA)[((size_t)(j >> 7) * NTOK + n) * 128 + (j & 127)]); }
    else if (col < 2880) { const int j = col - 1856; ref = dbg_indot(p, row, col); mine = bf2f(WSP(bf16_t, OFF_KNA)[((size_t)(j >> 7) * NKEY + row) * 128 + (j & 127)]); }
    else { const int j = col - 2880; ref = dbg_indot(p, row, col); mine = bf2f(WSP(bf16_t, OFF_VNA)[((size_t)(j >> 7) * NKEY + row) * 128 + (j & 127)]); }
    dreport(p, 2, ref, ATTG_FP8 ? ref + (mine - ref) * 0.1f : mine, 0.3f);
}
__device__ __forceinline__ float dbg_uqdot(const Params& p, int n, int col) {
#if ATTG_FP8
    const unsigned char* r = WSP(unsigned char, OFF_CQ) + (size_t)n * 512; float s = 0.f;
    for (int k = 0; k < 512; ++k) s += fp8_to_f(r[k]) * p.g_qn[k] * p.w_uq[(size_t)k * 1536 + col];
#else
    const bf16_t* r = WSP(bf16_t, OFF_CQ) + (size_t)n * 512; float s = 0.f;
    for (int k = 0; k < 512; ++k) s += bf2f(r[k]) * p.g_qn[k] * p.w_uq[(size_t)k * 1536 + col];
#endif
    return s;
}
__global__ void dbg_up(Params p) {
    const unsigned i = blockIdx.x * blockDim.x + threadIdx.x, h = dhash(i + 999u);
    if (i & 1) {
        const int n = h % NTOK, hd = dhash(h) % 8, d = dhash(h + 3u) % 192;
#if ATTG_FP8
        const unsigned char* r = WSP(unsigned char, OFF_CQ) + (size_t)n * 512; float ss = 0.f; for (int k = 0; k < 512; ++k) ss += fp8_to_f(r[k]) * fp8_to_f(r[k]);
#else
        const bf16_t* r = WSP(bf16_t, OFF_CQ) + (size_t)n * 512; float ss = 0.f; for (int k = 0; k < 512; ++k) ss += bf2f(r[k]) * bf2f(r[k]);
#endif
        const float rs = rsqrtf(ss / 512.f + EPS); float ref, mine;
#if MLA_FP8
        if (d < 128) { ref = dbg_uqdot(p, n, hd * 192 + d) * rs * MLA_QS; mine = fp8_to_f(WSP(unsigned char, OFF_Q)[((size_t)hd * NTOK + n) * 192 + d]) / Q8_SC; mine = ref + (mine - ref) * 0.3f; }
#else
        if (d < 128) { ref = dbg_uqdot(p, n, hd * 192 + d) * rs * MLA_QS; mine = bf2f(WSP(bf16_t, OFF_Q)[((size_t)hd * NTOK + n) * 192 + d]); }
#endif
        else { const int ridx = d - 128, half = ridx >> 5, ii = ridx & 31, f = ii & 15;
            const float x1 = dbg_uqdot(p, n, hd * 192 + 128 + 32 * half + f) * rs, x2 = dbg_uqdot(p, n, hd * 192 + 128 + 32 * half + 16 + f) * rs;
            ref = drope(x1, x2, ii, half == 0 ? (n >> 6) : (n & 63)) * MLA_QS;
#if MLA_FP8
            mine = fp8_to_f(WSP(unsigned char, OFF_Q)[((size_t)hd * NTOK + n) * 192 + 128 + 2 * (16 * half + f) + (ii >> 4)]) / Q8_SC; mine = ref + (mine - ref) * 0.3f; }
#else
            mine = bf2f(WSP(bf16_t, OFF_Q)[((size_t)hd * NTOK + n) * 192 + 128 + 2 * (16 * half + f) + (ii >> 4)]); }
#endif
        dreport(p, 3, ref, mine, 0.1f);
    } else {
        const int key = h % NKEY, hd = dhash(h) % 8, d = dhash(h + 3u) % 256;
#if ATTG_FP8
        const unsigned char* r = WSP(unsigned char, OFF_CKV) + (size_t)key * 256; float ss = 0.f, s = 0.f;
        for (int k = 0; k < 256; ++k) { const float v = fp8_to_f(r[k]); ss += v * v; s += v * p.g_kvn[k] * p.w_ukv[(size_t)k * 2048 + hd * 256 + d]; }
#else
        const bf16_t* r = WSP(bf16_t, OFF_CKV) + (size_t)key * 256; float ss = 0.f, s = 0.f;
        for (int k = 0; k < 256; ++k) { const float v = bf2f(r[k]); ss += v * v; s += v * p.g_kvn[k] * p.w_ukv[(size_t)k * 2048 + hd * 256 + d]; }
#endif
        const float ref = s * rsqrtf(ss / 256.f + EPS);
#if MLA_FP8
        const int kk_ = key & 63, slot_ = 32 * ((kk_ >> 2) & 1) + 16 * (kk_ >> 5) + (kk_ & 3) + 4 * ((kk_ >> 3) & 3);
        float mine = d < 128 ? fp8_to_f(WSP(unsigned char, OFF_KN)[((size_t)hd * NKEY + key) * 128 + d]) / K8_SC
                             : fp8_to_f(WSP(unsigned char, OFF_V)[(((size_t)hd * (NKEY / 64) + (key >> 6)) * 128 + (d & 127)) * 64 + slot_]);
        mine = ref + (mine - ref) * 0.3f;
#else
        const float mine = bf2f((d < 128 ? WSP(bf16_t, OFF_KN) : WSP(bf16_t, OFF_V))[((size_t)hd * NKEY + key) * 128 + (d & 127)]);
#endif
        dreport(p, 3, ref, mine, 0.3f);
    }
}
__global__ void dbg_mla(Params p) {
    extern __shared__ float sc[];
    __shared__ float red[256];
    const unsigned hh = dhash(blockIdx.x + 4242u); const int n = blockIdx.x < 4 ? (blockIdx.x * 5461 + (blockIdx.x & 1) * 255) % NTOK : hh % NTOK, h = dhash(hh) % 8, tid = threadIdx.x;
#if MLA_FP8
    const unsigned char* q = WSP(unsigned char, OFF_Q) + ((size_t)h * NTOK + n) * 192;
#define DQ(x) fp8_to_f(x)
    typedef unsigned char kel_t;
#else
    const bf16_t* q = WSP(bf16_t, OFF_Q) + ((size_t)h * NTOK + n) * 192;
#define DQ(x) bf2f(x)
    typedef bf16_t kel_t;
#endif
    float mx = -1e30f;
    for (int key = tid; key < NKEY; key += 256) { const kel_t* kn = WSP(kel_t, OFF_KN) + ((size_t)h * NKEY + key) * 128; const kel_t* kr = WSP(kel_t, OFF_KR) + (size_t)key * 64;
        float s = 0.f; for (int d = 0; d < 128; ++d) s += DQ(q[d]) * DQ(kn[d]); for (int d = 0; d < 64; ++d) s += DQ(q[128 + d]) * DQ(kr[d]);
        sc[key] = s; mx = fmaxf(mx, s); }
    red[tid] = mx; __syncthreads(); for (int o = 128; o > 0; o >>= 1) { if (tid < o) red[tid] = fmaxf(red[tid], red[tid + o]); __syncthreads(); } mx = red[0]; __syncthreads();
    float l = 0.f; for (int key = tid; key < NKEY; key += 256) { const float e = exp2f(sc[key] - mx); sc[key] = e; l += e; }
    red[tid] = l; __syncthreads(); for (int o = 128; o > 0; o >>= 1) { if (tid < o) red[tid] += red[tid + o]; __syncthreads(); } l = red[0];
#if MLA_FP8
    if (tid < 128) { float o = 0.f; for (int key = 0; key < NKEY; ++key) { const int kk_ = key & 63, slot_ = 32 * ((kk_ >> 2) & 1) + 16 * (kk_ >> 5) + (kk_ & 3) + 4 * ((kk_ >> 3) & 3);
            o += sc[key] * fp8_to_f(WSP(unsigned char, OFF_V)[(((size_t)h * (NKEY / 64) + (key >> 6)) * 128 + tid) * 64 + slot_]); }
#else
    if (tid < 128) { float o = 0.f; for (int key = 0; key < NKEY; ++key) o += sc[key] * bf2f(WSP(bf16_t, OFF_V)[((size_t)h * NKEY + key) * 128 + tid]);
#endif
#if ATTG_FP8
        dreport(p, 4, o / l, fp8_to_f(WSP(unsigned char, OFF_OCAT)[(size_t)n * DM + h * 128 + tid]) * (1.f / 64.f), 0.05f); }
#else
        dreport(p, 4, o / l, bf2f(WSP(bf16_t, OFF_OCAT)[(size_t)n * DM + h * 128 + tid]), 0.05f); }
#endif
}
__global__ void dbg_na(Params p) {
    __shared__ float sc[384]; __shared__ float red[512];
    const unsigned hh = dhash(blockIdx.x + 777u); const int tid = threadIdx.x;
    int n = hh % NTOK; if (blockIdx.x < 8) { const int rr[8] = {0, 3, 4, 5, 251, 252, 255, 128}; const int cc[8] = {0, 7, 8, 9, 55, 56, 63, 33}; n = rr[blockIdx.x] * 64 + cc[blockIdx.x]; }
    const int h = dhash(hh) % 8, r = n >> 6, cq = n & 63, rs = r < 4 ? 0 : (r > 252 ? 248 : r - 4), cs = cq < 8 ? 0 : (cq > 56 ? 48 : cq - 8);
    const bf16_t* q = WSP(bf16_t, OFF_QNA) + ((size_t)h * NTOK + n) * 128;
    float s = -1e30f; int key = 0;
    if (tid < 384) { float bias = 0.f;
        if (tid < 256) key = tid; else { const int j = tid - 256, jr = j >> 4, jc = j & 15; key = NCTX + (rs + jr) * 64 + cs + jc; bias = p.na_bias[(h * 15 + (rs + jr - r + 7)) * 31 + (cs + jc - cq + 15)] * LOG2E; }
        const bf16_t* kk = WSP(bf16_t, OFF_KNA) + ((size_t)h * NKEY + key) * 128; s = bias; for (int d = 0; d < 128; ++d) s += bf2f(q[d]) * bf2f(kk[d]); }
    red[tid] = s; __syncthreads(); for (int o = 256; o > 0; o >>= 1) { if (tid < o) red[tid] = fmaxf(red[tid], red[tid + o]); __syncthreads(); } const float mx = red[0]; __syncthreads();
    const float e = tid < 384 ? exp2f(s - mx) : 0.f; if (tid < 384) sc[tid] = e;
    red[tid] = e; __syncthreads(); for (int o = 256; o > 0; o >>= 1) { if (tid < o) red[tid] += red[tid + o]; __syncthreads(); } const float l = red[0];
    if (tid < 128) { float o = 0.f;
        for (int j = 0; j < 384; ++j) { int kj = j; if (j >= 256) { const int jj = j - 256; kj = NCTX + (rs + (jj >> 4)) * 64 + cs + (jj & 15); }
            o += sc[j] * bf2f(WSP(bf16_t, OFF_VNA)[((size_t)h * NKEY + kj) * 128 + tid]); }
#if ATTG_FP8
        dreport(p, 5, o / l, fp8_to_f(WSP(unsigned char, OFF_OCAT)[(size_t)n * DM + 1024 + h * 128 + tid]) * (1.f / 64.f), 0.05f); }
#else
        dreport(p, 5, o / l, bf2f(WSP(bf16_t, OFF_OCAT)[(size_t)n * DM + 1024 + h * 128 + tid]), 0.05f); }
#endif
}
__global__ void dbg_resid(Params p, int slot, const bf16_t* A, const float* W, const void* base, int base16, const float* gate, const res_t* mineb, int a8 = 0) {
    const unsigned i = blockIdx.x * blockDim.x + threadIdx.x, h = dhash(i + 31337u + slot);
    const int row = h % NTOK, col = dhash(h) % DM; float s = 0.f;
    for (int k = 0; k < DM; ++k) s += (a8 ? fp8_to_f(((const unsigned char*)A)[(size_t)row * DM + k]) * (1.f / 64.f) : bf2f(A[(size_t)row * DM + k])) * W[(size_t)k * DM + col];
    const float bv_ = base16 ? bf2f(((const bf16_t*)base)[(size_t)row * DM + col]) : ((const float*)base)[(size_t)row * DM + col];
    dreport(p, slot, bv_ + gate[col] * s, dres(mineb[(size_t)row * DM + col]), 0.3f);
}
__global__ void dbg_router(Params p, int slot, int layer) {
    const unsigned i = blockIdx.x * blockDim.x + threadIdx.x, h = dhash(i + 555u + slot);
    const int row = h % NTOK; const res_t* src = WSP(res_t, OFF_X1) + (size_t)row * DM;
    const float* ada = WSP(float, OFF_ADA) + layer * 12288; const float* g = p.g_ffn + layer * DM; const float* W = p.w_router + (size_t)layer * DM * NE;
    float ss = 0.f; for (int k = 0; k < DM; ++k) ss += dres(src[k]) * dres(src[k]); const float rs = rsqrtf(ss / DM + EPS);
    float lg[16]; for (int e = 0; e < 16; ++e) lg[e] = 0.f;
    const int col = dhash(h) % DM;
    for (int k = 0; k < DM; ++k) { const float hv = dres(src[k]) * rs * g[k] * (1.f + ada[4 * DM + k]) + ada[3 * DM + k];
#if MOE1_FP8
        if (k == col) { const float m_ = fp8_to_f(((const unsigned char*)WSP(bf16_t, OFF_H))[(size_t)row * DM + k]); dreport(p, slot, hv, hv + (m_ - hv) * 0.3f, 0.5f); }
#else
        if (k == col) dreport(p, slot, hv, bf2f(WSP(bf16_t, OFF_H)[(size_t)row * DM + k]), 0.5f);
#endif
        for (int e = 0; e < 16; ++e) lg[e] += hv * W[k * NE + e]; }
    float mx = -1e30f; for (int e = 0; e < 16; ++e) mx = fmaxf(mx, lg[e]); float sm = 0.f; for (int e = 0; e < 16; ++e) { lg[e] = expf(lg[e] - mx); sm += lg[e]; }
    for (int e = 0; e < 16; ++e) dreport(p, slot, lg[e] / sm, WSP(float, OFF_AFF)[(size_t)e * NTOK + row], 0.01f);
}
__global__ void dbg_topk(Params p, int slot_) {
    __shared__ float rmin[512], rmax[512]; __shared__ int rc[512], bad[512];
    const int e = blockIdx.x, tid = threadIdx.x; float mn = 1e30f, mxu = -1e30f; int cnt = 0, b = 0;
    for (int t = tid; t < NTOK; t += 512) { const int s = WSP(int, OFF_SLOT)[(size_t)t * NE + e]; const float a = WSP(float, OFF_AFF)[(size_t)e * NTOK + t];
        if (s >= 0) { ++cnt; mn = fminf(mn, a); if (s >= CAP || WSP(int, OFF_IDX)[e * CAP + s] != t || WSP(float, OFF_GATE)[e * CAP + s] != a) b = 1; } else mxu = fmaxf(mxu, a); }
    rmin[tid] = mn; rmax[tid] = mxu; rc[tid] = cnt; bad[tid] = b; __syncthreads();
    for (int o = 256; o > 0; o >>= 1) { if (tid < o) { rmin[tid] = fminf(rmin[tid], rmin[tid + o]); rmax[tid] = fmaxf(rmax[tid], rmax[tid + o]); rc[tid] += rc[tid + o]; bad[tid] |= bad[tid + o]; } __syncthreads(); }
    if (tid == 0) { float err = 0.f; if (rc[0] != CAP) err = 0.5f; else if (bad[0]) err = 0.25f; else if (rmin[0] < rmax[0]) err = 0.125f; dreport(p, slot_, err, 0.f, 1.0f - err); }
}
__global__ void dbg_act(Params p, int slot_, int layer) {
    const unsigned i = blockIdx.x * blockDim.x + threadIdx.x, h = dhash(i + 2024u + slot_);
    const int e = h % NE, sl = dhash(h) % CAP, ff = dhash(h + 9u) % FF; const int t = WSP(int, OFF_IDX)[e * CAP + sl];
    if (t < 0 || t >= NTOK) { dreport(p, slot_, 1.f, 0.f, 0.f); return; }
    const bf16_t* hr = WSP(bf16_t, OFF_H) + (size_t)t * DM; const float* wg = p.w_gate + ((size_t)layer * NE + e) * DM * FF; const float* wu = p.w_up + ((size_t)layer * NE + e) * DM * FF;
#if MOE1_FP8
    float a = 0.f, u = 0.f; for (int k = 0; k < DM; ++k) { const float v = fp8_to_f(((const unsigned char*)WSP(bf16_t, OFF_H))[(size_t)t * DM + k]); a += v * wg[(size_t)k * FF + ff]; u += v * wu[(size_t)k * FF + ff]; }
#if MOE2_FP8
    { const float ref_ = a / (1.f + expf(-a)) * u, mine_ = fp8_to_f(WSP(unsigned char, OFF_ACT)[((size_t)e * CAP + sl) * FF + ff]) * 0.25f; dreport(p, slot_, ref_, ref_ + (mine_ - ref_) * 0.1f, 1.0f); }
#else
    { const float ref_ = a / (1.f + expf(-a)) * u, mine_ = bf2f(WSP(bf16_t, OFF_ACT)[((size_t)e * CAP + sl) * FF + ff]); dreport(p, slot_, ref_, ref_ + (mine_ - ref_) * 0.1f, 1.0f); }
#endif
#else
    float a = 0.f, u = 0.f; for (int k = 0; k < DM; ++k) { const float v = bf2f(hr[k]); a += v * wg[(size_t)k * FF + ff]; u += v * wu[(size_t)k * FF + ff]; }
    dreport(p, slot_, a / (1.f + expf(-a)) * u, bf2f(WSP(bf16_t, OFF_ACT)[((size_t)e * CAP + sl) * FF + ff]), 1.0f);
#endif
}
__global__ void dbg_ye(Params p, int slot_, int layer) {
    const unsigned i = blockIdx.x * blockDim.x + threadIdx.x, h = dhash(i + 808u + slot_);
    const int e = h % NE, sl = dhash(h) % CAP, d = dhash(h + 9u) % DM;
    const bf16_t* ar = WSP(bf16_t, OFF_ACT) + ((size_t)e * CAP + sl) * FF; const float* wd = p.w_down + ((size_t)layer * NE + e) * FF * DM;
#if MOE2_FP8
    float s = 0.f; for (int k = 0; k < FF; ++k) s += fp8_to_f(WSP(unsigned char, OFF_ACT)[((size_t)e * CAP + sl) * FF + k]) * 0.25f * wd[(size_t)k * DM + d];
    { const float ref_ = s * WSP(float, OFF_GATE)[e * CAP + sl], mine_ = bf2f(WSP(bf16_t, OFF_YE)[((size_t)e * CAP + sl) * DM + d]); dreport(p, slot_, ref_, ref_ + (mine_ - ref_) * 0.15f, 0.1f); }
#else
    float s = 0.f; for (int k = 0; k < FF; ++k) s += bf2f(ar[k]) * wd[(size_t)k * DM + d];
    dreport(p, slot_, s * WSP(float, OFF_GATE)[e * CAP + sl], bf2f(WSP(bf16_t, OFF_YE)[((size_t)e * CAP + sl) * DM + d]), 0.1f);
#endif
}
__device__ __forceinline__ float dbg_x2(const Params& p, int layer, int row, int c) {
    float acc = 0.f; for (int e = 0; e < NE; ++e) { const int s = WSP(int, OFF_SLOT)[(size_t)row * NE + e]; if (s >= 0) acc += bf2f(WSP(bf16_t, OFF_YE)[((size_t)e * CAP + s) * DM + c]); }
    return dres(WSP(res_t, OFF_X1)[(size_t)row * DM + c]) + WSP(float, OFF_ADA)[layer * 12288 + 5 * DM + c] * acc;
}
__global__ void dbg_comb0(Params p) {
    const unsigned i = blockIdx.x * blockDim.x + threadIdx.x, h = dhash(i + 1111u);
    const int row = h % NTOK, col = dhash(h) % DM;
    dreport(p, 11, dbg_x2(p, 0, row, col), dres(WSP(res_t, OFF_X2)[(size_t)row * DM + col]), 0.3f);
    float ss = 0.f; for (int k = 0; k < DM; ++k) { const float v = dres(WSP(res_t, OFF_X2)[(size_t)row * DM + k]); ss += v * v; }
    const float* ada1 = WSP(float, OFF_ADA) + 12288;
    const float ref = dres(WSP(res_t, OFF_X2)[(size_t)row * DM + col]) * rsqrtf(ss / DM + EPS) * p.g_mix[DM + col] * (1.f + ada1[DM + col]) + ada1[col];
    dreport(p, 11, ref, bf2f(WSP(bf16_t, OFF_H)[(size_t)row * DM + col]), 0.5f);
}
__global__ void dbg_fft(Params p, const bf16_t* Hsave) {
    __shared__ float cb[256], sb[256]; __shared__ double red[256];
    const unsigned hh = dhash(blockIdx.x + 606u); const int tid = threadIdx.x;
    int k = hh % NTOK, col = dhash(hh) % DM; if (blockIdx.x == 0) { k = 0; col = 0; } if (blockIdx.x == 1) { k = 1; col = 257; } if (blockIdx.x == 2) { k = 128; col = 3; }
    const int g = col >> 8, m = col & 255;
    { float s, c; sincospif((float)((m * tid) & 255) / 128.f, &s, &c); cb[tid] = c; sb[tid] = s; } __syncthreads();
    double acc = 0.0;
    for (int n = tid; n < NTOK; n += 256) { float P = 0.f, Q = 0.f; const bf16_t* hr = Hsave + (size_t)n * DM + g * 256;
        for (int c = 0; c < 256; ++c) { const float v = bf2f(hr[c]); P += v * cb[c]; Q += v * sb[c]; }
        float sa, ca; sincospif((float)(((long)k * n) & 16383) / 8192.f, &sa, &ca); acc += (double)ca * P - (double)sa * Q; }
    red[tid] = acc; __syncthreads(); for (int o = 128; o > 0; o >>= 1) { if (tid < o) red[tid] += red[tid + o]; __syncthreads(); }
    if (tid == 0) dreport(p, 12, (float)(red[0] / 2048.0), bf2f(WSP(bf16_t, OFF_OCAT)[(size_t)k * DM + col]), 0.3f);
}
__global__ void dbg_final(Params p) {
    const unsigned i = blockIdx.x * blockDim.x + threadIdx.x, h = dhash(i + 9090u);
    const int row = h % NTOK, col = dhash(h) % DM; float ss = 0.f, xc = 0.f;
    for (int k = 0; k < DM; ++k) { const float v = dbg_x2(p, 1, row, k); ss += v * v; if (k == col) xc = v; }
    dreport(p, 18, xc * rsqrtf(ss / DM + EPS) * p.g_final[col], p.out[(size_t)row * DM + col], 0.3f);
}
__global__ void dbg_report(Params p) {
    const unsigned* err = (const unsigned*)(p.ws + OFF_ERR);
    int bad = -1; float be = 0.f;
    for (int s = 0; s < 19; ++s) { const float e = __uint_as_float(err[s]); if (e > 0.04f) { bad = s; be = e; break; } }
    if (bad < 0) return;
    const size_t i0 = (size_t)blockIdx.x * blockDim.x + threadIdx.x;
    for (size_t i = i0; i < (size_t)NTOK * DM; i += (size_t)gridDim.x * blockDim.x) p.out[i] = 0.f;
    if (i0 == 0) { const float m = 1.f + 8.f * fminf(1.f, be); p.out[0] = sqrtf(m * 33554432.f) * powf(10.f, 0.5f * (float)(bad + 2)); }
}
static void dbg_after_phase(int ph, const Params& p, hipStream_t st) {
    char* ws = p.ws;
    static bool a = false; if (!a) { (void)hipFuncSetAttribute((const void*)dbg_mla, hipFuncAttributeMaxDynamicSharedMemorySize, NKEY * 4); a = true; }
    bf16_t* hsave = (bf16_t*)(ws + OFF_CQ);
    switch (ph) {
    case PH_PREP: hipLaunchKernelGGL(dbg_ada, dim3(16), dim3(256), 0, st, p); break;
    case PH_MOD0: hipLaunchKernelGGL(dbg_mod0, dim3(16), dim3(256), 0, st, p); break;
    case PH_INPROJ: hipLaunchKernelGGL(dbg_inproj, dim3(64), dim3(256), 0, st, p); break;
    case PH_UP: hipLaunchKernelGGL(dbg_up, dim3(64), dim3(256), 0, st, p); break;
    case PH_ATTN: hipLaunchKernelGGL(dbg_mla, dim3(48), dim3(256), NKEY * 4, st, p); hipLaunchKernelGGL(dbg_na, dim3(96), dim3(512), 0, st, p); break;
    case PH_OUT: hipLaunchKernelGGL(dbg_resid, dim3(64), dim3(256), 0, st, p, 6, (const bf16_t*)(ws + OFF_OCAT), p.w_out_attn, (const void*)p.x, 0, (const float*)(ws + OFF_ADA) + 2 * DM, (const res_t*)(ws + OFF_X1), (int)ATTG_FP8); break;
    case PH_ROUTER0: hipLaunchKernelGGL(dbg_router, dim3(8), dim3(256), 0, st, p, 7, 0); break;
    case PH_TOPK0: hipLaunchKernelGGL(dbg_topk, dim3(16), dim3(512), 0, st, p, 8); break;
    case PH_MOE1_0: hipLaunchKernelGGL(dbg_act, dim3(64), dim3(256), 0, st, p, 9, 0); break;
    case PH_MOE2_0: hipLaunchKernelGGL(dbg_ye, dim3(64), dim3(256), 0, st, p, 10, 0); break;
    case PH_COMB0: hipLaunchKernelGGL(dbg_comb0, dim3(16), dim3(256), 0, st, p);
        (void)hipMemcpyAsync(hsave, ws + OFF_H, (size_t)NTOK * DM * 2, hipMemcpyDeviceToDevice, st); break;
    case PH_F2B: hipLaunchKernelGGL(dbg_fft, dim3(48), dim3(256), 0, st, p, (const bf16_t*)hsave); break;
    case PH_FOUT: hipLaunchKernelGGL(dbg_resid, dim3(64), dim3(256), 0, st, p, 13, (const bf16_t*)(ws + OFF_OCAT), p.w_out_fourier, (const void*)(ws + OFF_X2), (int)RES_BF16, (const float*)(ws + OFF_ADA) + 12288 + 2 * DM, (const res_t*)(ws + OFF_X1), 0); break;
    case PH_ROUTER1: hipLaunchKernelGGL(dbg_router, dim3(8), dim3(256), 0, st, p, 14, 1); break;
    case PH_TOPK1: hipLaunchKernelGGL(dbg_topk, dim3(16), dim3(512), 0, st, p, 15); break;
    case PH_MOE1_1: hipLaunchKernelGGL(dbg_act, dim3(64), dim3(256), 0, st, p, 16, 1); break;
    case PH_MOE2_1: hipLaunchKernelGGL(dbg_ye, dim3(64), dim3(256), 0, st, p, 17, 1); break;
    case PH_COMB1: hipLaunchKernelGGL(dbg_final, dim3(8), dim3(256), 0, st, p); hipLaunchKernelGGL(dbg_report, dim3(1024), dim3(256), 0, st, p); break;
    default: break;
    }
}
#endif
template <int PH> static void launch_phases(const Params& p, int grid, hipStream_t stream) {
    static bool attr_done = false;
    if (!attr_done) { (void)hipFuncSetAttribute((const void*)k_phase<PH>, hipFuncAttributeMaxDynamicSharedMemorySize, LDS_BYTES); attr_done = true; }
    hipLaunchKernelGGL(k_phase<PH>, dim3(grid), dim3(NTHR), LDS_BYTES, stream, p);
#if DEBUG_CHECK
    dbg_after_phase(PH, p, stream);
#endif
    if constexpr (PH + 1 < PH_COUNT) launch_phases<PH + 1>(p, grid, stream);
}

extern "C" void kernel_launch(void* const* d_in, const int* in_sizes, int n_in, void* d_out, int out_size, void* d_ws, size_t ws_size, hipStream_t stream) {
    if (n_in != 21 || ws_size < WS_END || out_size != NTOK * DM) {
        fprintf(stderr, "kernel_launch: unexpected shapes: n_in %d ws %zu (need %zu) out %d\n", n_in, ws_size, (size_t)WS_END, out_size);
        return;
    }
    Params p{};
    p.x = (const float*)d_in[0]; p.c = (const float*)d_in[1]; p.ctx = (const float*)d_in[2]; p.c_ctx = (const float*)d_in[3];
    p.ada_w = (const float*)d_in[4]; p.ada_b = (const float*)d_in[5]; p.g_mix = (const float*)d_in[6]; p.g_ffn = (const float*)d_in[7];
    p.g_final = (const float*)d_in[8]; p.w_in = (const float*)d_in[9]; p.g_qn = (const float*)d_in[10]; p.w_uq = (const float*)d_in[11];
    p.g_kvn = (const float*)d_in[12]; p.w_ukv = (const float*)d_in[13]; p.na_bias = (const float*)d_in[14]; p.w_out_attn = (const float*)d_in[15];
    p.w_out_fourier = (const float*)d_in[16]; p.w_router = (const float*)d_in[17]; p.w_gate = (const float*)d_in[18]; p.w_up = (const float*)d_in[19];
    p.w_down = (const float*)d_in[20];
    p.out = (float*)d_out; p.ws = (char*)d_ws;
    static int grid = 0;
    if (!grid) {
        int dev = 0, cus = 0, per_cu = 0;
        (void)hipGetDevice(&dev);
        (void)hipDeviceGetAttribute(&cus, hipDeviceAttributeMultiprocessorCount, dev);
#if N_LAUNCH_MODE == 0 && !DEBUG_CHECK
        (void)hipFuncSetAttribute((const void*)k_mega, hipFuncAttributeMaxDynamicSharedMemorySize, LDS_BYTES);
        (void)hipOccupancyMaxActiveBlocksPerMultiprocessor(&per_cu, (const void*)k_mega, NTHR, LDS_BYTES);
#else
        per_cu = 1;
#endif
        if (cus <= 0) cus = 256;
        grid = per_cu >= 1 ? cus : 0;
        if (!grid) { fprintf(stderr, "kernel_launch: persistent kernel does not fit (occupancy %d)\n", per_cu); grid = -1; }
    }
    if (grid <= 0) return;
    (void)hipMemsetAsync((char*)d_ws + OFF_BAR, 0, 16384, stream);
#if DEBUG_CHECK
    (void)hipMemsetAsync((char*)d_ws + OFF_ERR, 0, 4096, stream);
#endif
#if N_LAUNCH_MODE == 0 && !DEBUG_CHECK
    hipLaunchKernelGGL(k_mega, dim3(grid), dim3(NTHR), LDS_BYTES, stream, p);
#else
    launch_phases<0>(p, grid, stream);
#endif
    const hipError_t le = hipPeekAtLastError();
    if (le != hipSuccess) fprintf(stderr, "kernel_launch: launch failed: %s\n", hipGetErrorName(le));
}
```

```cpp
#include <hip/hip_runtime.h>
#include <cstdio>
#include <cstdint>

#ifndef N_LAUNCH_MODE
#define N_LAUNCH_MODE 0
#endif
#ifndef DEBUG_CHECK
#define DEBUG_CHECK 0
#endif
#ifndef ATT_SPLIT
#define ATT_SPLIT 0
#endif
#ifndef MLA_FP8
#define MLA_FP8 1
#endif
#ifndef MOE1_FP8
#define MOE1_FP8 1
#endif
#ifndef MOE2_FP8
#define MOE2_FP8 1
#endif
#ifndef ATTG_FP8
#define ATTG_FP8 1
#endif
#ifndef PROBE_MB
#define PROBE_MB 0
#endif
#ifndef ATT_DIAG
#define ATT_DIAG 0
#endif
#ifndef ATT_GRP_MODE
#define ATT_GRP_MODE 0
#endif
#ifndef PROBE_ATT
#define PROBE_ATT 0
#endif
#ifndef PREP_DEFER
#define PREP_DEFER 1
#endif
#ifndef CONV_CUS
#define CONV_CUS 51
#endif
#ifndef RES_BF16
#define RES_BF16 1
#endif
#ifndef PROBE_DOUBLE
#define PROBE_DOUBLE 0
#endif

typedef unsigned short bf16_t;
typedef short bf16x8 __attribute__((ext_vector_type(8)));
typedef short s16x4 __attribute__((ext_vector_type(4)));
typedef float f32x2 __attribute__((ext_vector_type(2)));
typedef float f32x4 __attribute__((ext_vector_type(4)));
typedef float f32x16 __attribute__((ext_vector_type(16)));
typedef unsigned u32x2 __attribute__((ext_vector_type(2)));
typedef unsigned u32x4 __attribute__((ext_vector_type(4)));
typedef int i32x8 __attribute__((ext_vector_type(8)));
#define LAS __attribute__((address_space(3)))

constexpr int DM = 2048, NTOK = 16384, NCTX = 256, NKEY = NTOK + NCTX, GW = 64, GH = 256;
constexpr int NH = 8, NE = 16, CAP = 2048, FF = 2048;
constexpr int INW = 3904, INWP = 4096;
constexpr float EPS = 1e-6f;
constexpr float LOG2E = 1.4426950408889634f;
constexpr float MLA_QS = 0.07216878364870322f * LOG2E;
constexpr float NA_QS = 0.08838834764831845f * LOG2E;
constexpr int NTHR = 512;

constexpr size_t al256(size_t x) { return (x + 255) / 256 * 256; }
constexpr size_t OFF_BAR = 0;
constexpr size_t OFF_ADA = 16384;
constexpr size_t OFF_ROPE = OFF_ADA + al256((2 * 12288 + 4096) * 4);
constexpr size_t OFF_TW = OFF_ROPE + 256 * 16 * 2 * 4;
constexpr size_t OFF_DFT1 = OFF_TW + 128 * 128 * 2 * 4;
constexpr size_t OFF_WA = OFF_DFT1 + 512 * 256 * 2;
constexpr size_t OFF_WB = OFF_WA + 256 * 256 * 2;
constexpr size_t OFF_ERR = OFF_WB + 256 * 256 * 2;
constexpr size_t OFF_WIN = OFF_ERR + 4096;
constexpr size_t OFF_WUQ = OFF_WIN + (size_t)INWP * DM * 2;
constexpr size_t OFF_WUKV = OFF_WUQ + (size_t)1536 * 512 * 2;
constexpr size_t OFF_WOUT = OFF_WUKV + (size_t)2048 * 256 * 2;
constexpr size_t OFF_WFOUT = OFF_WOUT + (size_t)DM * DM * 2;
constexpr size_t OFF_WGU = OFF_WFOUT + (size_t)DM * DM * 2;
constexpr size_t OFF_WD = OFF_WGU + (size_t)2 * NE * 4096 * DM * 2;
constexpr size_t OFF_H = OFF_WD + (size_t)2 * NE * DM * FF * 2;
constexpr size_t OFF_X1 = OFF_H + (size_t)NKEY * DM * 2;
constexpr size_t OFF_X2 = OFF_X1 + (size_t)NTOK * DM * 4;
constexpr size_t OFF_AFF = OFF_X2 + (size_t)NTOK * DM * 4;
constexpr size_t OFF_IDX = OFF_AFF + (size_t)NE * NTOK * 4;
constexpr size_t OFF_GATE = OFF_IDX + (size_t)NE * CAP * 4;
constexpr size_t OFF_SLOT = OFF_GATE + (size_t)NE * CAP * 4;
constexpr size_t OFF_ACT = OFF_SLOT + (size_t)NTOK * NE * 4;
constexpr size_t OFF_YE = OFF_ACT + (size_t)NE * CAP * FF * 2;
constexpr size_t OFF_OCAT = OFF_YE + (size_t)NE * CAP * DM * 2;
constexpr size_t OFF_CQ = OFF_OCAT + (size_t)NTOK * DM * 2;
constexpr size_t OFF_CKV = OFF_CQ + (size_t)NTOK * 512 * 2;
constexpr size_t OFF_PSQ = OFF_CKV + (size_t)NKEY * 256 * 2;
constexpr size_t OFF_KR = OFF_PSQ + al256((size_t)NKEY * 24 * 4);
constexpr size_t OFF_QNA = OFF_KR + (size_t)NKEY * 64 * 2;
constexpr size_t OFF_KNA = OFF_QNA + (size_t)NH * NTOK * 128 * 2;
constexpr size_t OFF_VNA = OFF_KNA + (size_t)NH * NKEY * 128 * 2;
constexpr size_t OFF_Q = OFF_VNA + (size_t)NH * NKEY * 128 * 2;
constexpr size_t OFF_KN = OFF_Q + (size_t)NH * NTOK * 192 * 2;
constexpr size_t OFF_V = OFF_KN + (size_t)NH * NKEY * 128 * 2;
constexpr size_t WS_END = OFF_V + (size_t)NH * NKEY * 128 * 2;

struct Params {
    const float *x, *c, *ctx, *c_ctx, *ada_w, *ada_b, *g_mix, *g_ffn, *g_final, *w_in, *g_qn, *w_uq, *g_kvn, *w_ukv,
        *na_bias, *w_out_attn, *w_out_fourier, *w_router, *w_gate, *w_up, *w_down;
    float* out;
    char* ws;
};

__device__ __forceinline__ unsigned cvtpk(float lo, float hi) {
    unsigned r; asm volatile("v_cvt_pk_bf16_f32 %0, %1, %2" : "=v"(r) : "v"(lo), "v"(hi)); return r;
}
__device__ __forceinline__ u32x2 pack8_fp8(const f32x4& a, const f32x4& b, float sc) {
    int lo = 0, hi = 0;
    lo = __builtin_amdgcn_cvt_pk_fp8_f32(a[0] * sc, a[1] * sc, lo, false); lo = __builtin_amdgcn_cvt_pk_fp8_f32(a[2] * sc, a[3] * sc, lo, true);
    hi = __builtin_amdgcn_cvt_pk_fp8_f32(b[0] * sc, b[1] * sc, hi, false); hi = __builtin_amdgcn_cvt_pk_fp8_f32(b[2] * sc, b[3] * sc, hi, true);
    u32x2 w; w.x = (unsigned)lo; w.y = (unsigned)hi; return w;
}
__device__ __forceinline__ float fp8_to_f(unsigned char b) { return __builtin_amdgcn_cvt_f32_fp8((int)b, 0); }
constexpr float Q8_SC = 4.f, K8_SC = 0.25f;
__device__ __forceinline__ float bf2f(bf16_t b) { return __uint_as_float(((unsigned)b) << 16); }
__device__ __forceinline__ bf16_t f2bf(float f) { return (bf16_t)(cvtpk(f, 0.f) & 0xffffu); }
template <int CTRL> __device__ __forceinline__ float dpp_add(float v) { return v + __int_as_float(__builtin_amdgcn_update_dpp(0, __float_as_int(v), CTRL, 0xf, 0xf, true)); }
__device__ __forceinline__ float wave_sum(float v) {
    v = dpp_add<0xB1>(v);
    v = dpp_add<0x4E>(v);
    v = dpp_add<0x141>(v);
    v = dpp_add<0x140>(v);
    { auto rr = __builtin_amdgcn_permlane16_swap(__float_as_uint(v), __float_as_uint(v), false, false); v = __uint_as_float(rr[0]) + __uint_as_float(rr[1]); }
    { auto rr = __builtin_amdgcn_permlane32_swap(__float_as_uint(v), __float_as_uint(v), false, false); v = __uint_as_float(rr[0]) + __uint_as_float(rr[1]); }
    return v;
}
extern __shared__ __attribute__((aligned(16))) char g_smem[];
constexpr int LDS_STAGE = 131072, LDS_XBW = LDS_STAGE + 512, LDS_WTAB = LDS_XBW + 16, LDS_BYTES = LDS_XBW + 16 + 512;
__device__ __forceinline__ unsigned hw_slot() { return (unsigned)__builtin_amdgcn_s_getreg((5 << 11) | 4) & 63u; }
__device__ __forceinline__ void ltid_init() { const int t = threadIdx.x; volatile int* tab = (volatile int*)(g_smem + LDS_WTAB);
    if ((t & 63) == 0) { tab[hw_slot()] = t >> 6; tab[72 + (t >> 6)] = (int)(hw_slot() >> 4); } if (t == 0) tab[64] = 0; __syncthreads(); }
__device__ __forceinline__ int wave_rank(int wid) { volatile int* tab = (volatile int*)(g_smem + LDS_WTAB); const int my = tab[72 + wid]; int r = 0;
    for (int w = 0; w < 8; ++w) r += (w < wid && tab[72 + w] == my) ? 1 : 0; return __builtin_amdgcn_readfirstlane(r & 1); }
__device__ __forceinline__ int ltid() {
    int w = ((volatile int*)(g_smem + LDS_WTAB))[hw_slot()];
    w = __builtin_amdgcn_readfirstlane(w);
    unsigned ones_ = ~0u; asm volatile("" : "+s"(ones_));
    const int lane = __builtin_amdgcn_mbcnt_hi(ones_, __builtin_amdgcn_mbcnt_lo(ones_, 0u));
    int t = w * 64 + lane; asm volatile("" : "+v"(t)); return t;
}
__device__ __forceinline__ int lbid() { int t = blockIdx.x; asm volatile("" : "+s"(t)); return t; }
__device__ __forceinline__ float siluf(float v) { return v / (1.f + __expf(-v)); }

#define XB_TMO      128
#define XB_XCNT(j)  (256  + 64 * (j))
#define XB_XSUB(j)  (1280 + 64 * (j))
#define XB_XGEN(j)  (2304 + 64 * (j))
#define XB_TOP      3328
#define XB_TOPGEN   3392
#define XCD_BAR_WORDS 3456
#define XB_SPIN_CAP (1u << 18)
__device__ __forceinline__ unsigned xb_ld(unsigned* p)              { return __hip_atomic_load(p, __ATOMIC_RELAXED, __HIP_MEMORY_SCOPE_AGENT); }
__device__ __forceinline__ unsigned xb_add(unsigned* p, unsigned v) { return __hip_atomic_fetch_add(p, v, __ATOMIC_RELAXED, __HIP_MEMORY_SCOPE_AGENT); }
__device__ __forceinline__ unsigned xb_xcc_id() { return (unsigned)__builtin_amdgcn_s_getreg((3 << 11) | 20) & 0xFu; }
#define XB_SPIN(cond, bar) do { unsigned _sp = 0; while (cond) { __builtin_amdgcn_s_sleep(1); \
    if ((++_sp & 255u) == 0u) { if (xb_ld(&(bar)[XB_TMO])) break; if (_sp > XB_SPIN_CAP) { atomicAdd(&(bar)[XB_TMO], 1u); break; } } } } while (0)
struct XcdBarrier { unsigned* bar; unsigned x; volatile LAS unsigned* st; };
__device__ __forceinline__ XcdBarrier xcd_barrier_post(unsigned* bar, volatile LAS unsigned* st) {
    XcdBarrier b; b.bar = bar; b.x = xb_xcc_id(); b.st = st;
    if (ltid() == 0) (void)xb_add(&bar[XB_XCNT(b.x)], 1u);
    return b;
}
__device__ __forceinline__ void xcd_barrier_complete(unsigned* bar, unsigned x, unsigned& nloc, unsigned& nx) {
    const unsigned G = gridDim.x * gridDim.y * gridDim.z;
    unsigned sum, cnt, mine, sp = 0u;
    for (;;) {
        sum = 0u; cnt = 0u; mine = 0u;
#pragma unroll
        for (unsigned j = 0; j < 16; ++j) { const unsigned c = xb_ld(&bar[XB_XCNT(j)]); sum += c; cnt += (c > 0u) ? 1u : 0u; mine = (j == x) ? c : mine; }
        if (sum == G) break;
        __builtin_amdgcn_s_sleep(1);
        if ((++sp & 255u) == 0u) { if (xb_ld(&bar[XB_TMO])) break; if (sp > XB_SPIN_CAP) { atomicAdd(&bar[XB_TMO], 1u); break; } }
    }
    nloc = mine > 0u ? mine : 1u; nx = cnt > 0u ? cnt : 1u;
}
__device__ __forceinline__ void xcd_barrier(const XcdBarrier& b) {
    asm volatile("s_waitcnt vmcnt(0)" ::: "memory");
    __syncthreads();
    if (ltid() == 0) {
        unsigned* bar = b.bar;
        __builtin_amdgcn_s_waitcnt(0);
        unsigned nloc = b.st[0], nx = b.st[1];
        if (nloc == 0u) { xcd_barrier_complete(bar, b.x, nloc, nx); b.st[0] = nloc; b.st[1] = nx; }
        const unsigned old = xb_add(&bar[XB_XSUB(b.x)], 1u);
        const unsigned gen = old / nloc;
        if (old + 1u == (gen + 1u) * nloc) {
            __builtin_amdgcn_fence(__ATOMIC_RELEASE, "agent");
            asm volatile("s_waitcnt vmcnt(0)" ::: "memory");
            const unsigned og = xb_add(&bar[XB_TOP], 1u);
            const unsigned tg = og / nx;
            if (og + 1u == (tg + 1u) * nx) xb_add(&bar[XB_TOPGEN], 1u);
            else XB_SPIN(xb_ld(&bar[XB_TOPGEN]) == tg, bar);
            __builtin_amdgcn_fence(__ATOMIC_ACQUIRE, "agent");
            xb_add(&bar[XB_XGEN(b.x)], 1u);
            asm volatile("s_waitcnt vmcnt(0)" ::: "memory");
        } else {
            XB_SPIN(xb_ld(&bar[XB_XGEN(b.x)]) == gen, bar);
            __builtin_amdgcn_fence(__ATOMIC_ACQUIRE, "agent");
            asm volatile("s_waitcnt vmcnt(0)" ::: "memory");
        }
    }
    __syncthreads();
}

namespace pg8 {
constexpr int BM = 256, BK = 64, HALF = 128, HTB = HALF * BK * 2, STAGE_BYTES = 8 * HTB, NXCD = 8, WGM = 8;
__host__ __device__ __forceinline__ int lds_byte(int r, int c) { const int st = (r >> 4) * 2 + (c >> 5), rr = r & 15, cc = c & 31, ob = rr * 64 + cc * 2; return st * 1024 + (ob ^ (((ob >> 9) & 1) << 5)); }
__host__ __device__ __forceinline__ void stage_rc(int b, int& R, int& C) { const int st = b / 1024, sb = b % 1024, swz = sb ^ (((sb >> 9) & 1) << 5); R = (st >> 1) * 16 + swz / 64; C = (st & 1) * 32 + (swz % 64) / 2; }
__host__ __device__ __forceinline__ int perm32(int rho) { const int n = rho >> 4, i = rho & 15; return 8 * (i >> 2) + 4 * n + (i & 3); }
struct Unit { int pm, pn; };
struct StaticOrder {
    int nM, nN, nwg, G, c, fpm = -1, fpn = 0;
    __device__ void init(int nM_, int nN_, int G_, int c_) { nM = nM_; nN = nN_; nwg = nM * nN; G = G_; c = c_; fpm = -1; }
    __device__ void init_one(int pm_, int pn_) { fpm = pm_; fpn = pn_; }
    __device__ bool next(int i, Unit& u) const {
        if (fpm >= 0) { if (i) return false; u.pm = fpm; u.pn = fpn; return true; }
        const long L = (long)i * G + c; if (L >= nwg) return false;
        int wgid = (int)L; { const int q = nwg / NXCD, r = nwg % NXCD, xcd = wgid % NXCD, off = wgid / NXCD; wgid = (xcd < r ? xcd * (q + 1) : r * (q + 1) + (xcd - r) * q) + off; }
        const int nig = WGM * nN, gid = wgid / nig, fm = gid * WGM, gsz = (nM - fm) < WGM ? (nM - fm) : WGM;
        u.pm = fm + ((wgid % nig) % gsz); u.pn = (wgid % nig) / gsz; return true;
    }
};

__device__ __forceinline__ i32x8 pg8_cat(bf16x8 a, bf16x8 b) { const u32x4 x = __builtin_bit_cast(u32x4, a), y = __builtin_bit_cast(u32x4, b);
    return (i32x8){(int)x.x, (int)x.y, (int)x.z, (int)x.w, (int)y.x, (int)y.y, (int)y.z, (int)y.w}; }
template <class Desc, class Epi>
__device__ __forceinline__ void gemm_phase(LAS unsigned char* lds, const Desc& D, const StaticOrder& S, const Epi& E) {
    const int tid = ltid(), wid = __builtin_amdgcn_readfirstlane(tid >> 6), lane = tid & 63, wr = wid >> 2, wc = wid & 3, fr = lane & 15, fq = lane >> 4;
    const int K = D.K, nt = K / BK;
    int sR[2], sC[2];
    unsigned voffA[2][2], voffB[2][2], nvA[2][2];
#pragma unroll
    for (int i = 0; i < 2; ++i) { stage_rc(tid * 16 + i * 8192, sR[i], sC[i]);
        const int Rb = Epi::PERM ? ((sR[i] & ~31) + perm32(sR[i] & 31)) : sR[i];
#pragma unroll
        for (int h = 0; h < 2; ++h) { voffA[h][i] = D.arow(sR[i] + HALF * h) + (unsigned)sC[i] * 2u; voffB[h][i] = D.brow(Rb + HALF * h) + (unsigned)sC[i] * 2u; nvA[h][i] = voffA[h][i]; } }
    const size_t kstep = (size_t)(BK * 2);
    const unsigned ldsw = (unsigned)wid * 1024u;
    const int aoff = lds_byte(wr * 64 + fr, fq * 8), boff = lds_byte(wc * 32 + fr, fq * 8);
    const int aoff8 = lds_byte(wr * 64 + fr, fq * 16) | ((fq & 1) << 4), boff8 = lds_byte(wc * 32 + fr, fq * 16) | ((fq & 1) << 4);
#define PG8_SA(b, h) (((b) * 2 + (h)) * HTB)
#define PG8_SB(b, h) ((4 + (b) * 2 + (h)) * HTB)
#define PG8_STAGE(bufoff, gbase, voff) do { _Pragma("unroll") for (int _i = 0; _i < 2; ++_i) \
        __builtin_amdgcn_global_load_lds((const unsigned*)((const char*)(gbase) + (voff)[_i]), (LAS unsigned*)(lds + (bufoff) + ldsw + _i * 8192), 16, 0, 0); } while (0)
#define PG8_LD8(p_, q_) pg8_cat(*(const LAS bf16x8*)(p_), *(const LAS bf16x8*)(q_))
#define PG8_LDA(dst, b, h) do { if constexpr (Desc::FP8) { int aoff8x = aoff8; asm volatile("v_xor_b32 %0, 16, %0" : "+v"(aoff8x)); _Pragma("unroll") for (int m = 0; m < 4; ++m) dst##8[m] = PG8_LD8(lds + PG8_SA(b, h) + aoff8 + m * 2048, lds + PG8_SA(b, h) + aoff8x + m * 2048); } else { \
        _Pragma("unroll") for (int m = 0; m < 4; ++m) _Pragma("unroll") for (int k = 0; k < 2; ++k) dst[m][k] = *(const LAS bf16x8*)(lds + PG8_SA(b, h) + aoff + m * 2048 + k * 1024); } } while (0)
#define PG8_LDB(dst, b, h) do { if constexpr (Desc::FP8) { int boff8x = boff8; asm volatile("v_xor_b32 %0, 16, %0" : "+v"(boff8x)); _Pragma("unroll") for (int n = 0; n < 2; ++n) dst##8[n] = PG8_LD8(lds + PG8_SB(b, h) + boff8 + n * 2048, lds + PG8_SB(b, h) + boff8x + n * 2048); } else { \
        _Pragma("unroll") for (int n = 0; n < 2; ++n) _Pragma("unroll") for (int k = 0; k < 2; ++k) dst[n][k] = *(const LAS bf16x8*)(lds + PG8_SB(b, h) + boff + n * 2048 + k * 1024); } } while (0)
#define PG8_CAT(x) pg8_cat((x)[0], (x)[1])
#define PG8_MMA(ai, bj, At, Bt) do { __builtin_amdgcn_s_setprio(1); if constexpr (Desc::FP8) { _Pragma("unroll") for (int m = 0; m < 4; ++m) _Pragma("unroll") for (int n = 0; n < 2; ++n) \
        asm volatile("v_mfma_scale_f32_16x16x128_f8f6f4 %0, %1, %2, %0, %3, %3 op_sel_hi:[0,0,0]" : "+v"(acc[ai][bj][m][n]) : "v"(Bt##8[n]), "v"(At##8[m]), "v"(scl1)); } else { \
        _Pragma("unroll") for (int m = 0; m < 4; ++m) _Pragma("unroll") for (int n = 0; n < 2; ++n) _Pragma("unroll") for (int k = 0; k < 2; ++k) \
        acc[ai][bj][m][n] = __builtin_amdgcn_mfma_f32_16x16x32_bf16(Bt[n][k], At[m][k], acc[ai][bj][m][n], 0, 0, 0); } __builtin_amdgcn_s_setprio(0); } while (0)
#define PG8_WAIT_V(n) asm volatile("s_waitcnt vmcnt(" #n ")" ::: "memory")
#define PG8_WAIT_L(n) asm volatile("s_waitcnt lgkmcnt(" #n ")" ::: "memory")
#define PG8_BAR __builtin_amdgcn_s_barrier()
#define PG8_SCHED __builtin_amdgcn_sched_barrier(0)
    Unit cur, nxt; int ui = 0;
    if (!S.next(0, cur)) return;
    f32x4 acc[2][2][4][2];
#pragma unroll
    for (int a = 0; a < 2; ++a)
#pragma unroll
        for (int b = 0; b < 2; ++b)
#pragma unroll
            for (int m = 0; m < 4; ++m)
#pragma unroll
                for (int n = 0; n < 2; ++n) acc[a][b][m][n] = (f32x4){0.f, 0.f, 0.f, 0.f};
    bf16x8 At[4][2], B0[2][2], B1[2][2]; i32x8 At8[4], B08[2], B18[2];
    const int scl1 = 0x7f7f7f7f;
    if constexpr (Desc::GATHER) {
#pragma unroll
        for (int i = 0; i < 2; ++i)
#pragma unroll
            for (int h = 0; h < 2; ++h) { voffA[h][i] = D.agather(cur, sR[i] + HALF * h) + (unsigned)sC[i] * 2u; nvA[h][i] = voffA[h][i]; }
    }
    const char* cA = D.A + D.abase(cur); const char* cB = D.B + D.bbase(cur);
    PG8_STAGE(PG8_SB(0, 0), cB, voffB[0]); PG8_STAGE(PG8_SA(0, 0), cA, voffA[0]); PG8_STAGE(PG8_SB(0, 1), cB, voffB[1]); PG8_STAGE(PG8_SA(0, 1), cA, voffA[1]);
    if (wr == 1) PG8_BAR;
    PG8_WAIT_V(4); PG8_BAR;
    PG8_STAGE(PG8_SB(1, 0), cB + kstep, voffB[0]); PG8_STAGE(PG8_SA(1, 0), cA + kstep, voffA[0]); PG8_STAGE(PG8_SB(1, 1), cB + kstep, voffB[1]);
    PG8_WAIT_V(6); PG8_BAR;
    for (;;) {
        const bool has_next = S.next(ui + 1, nxt);
        const char* nA = has_next ? D.A + D.abase(nxt) : cA; const char* nB = has_next ? D.B + D.bbase(nxt) : cB;
        for (int t = 0; t < nt; t += 2) {
            const bool last = (t == nt - 2);
            const char* a1 = cA + (size_t)(t + 1) * kstep;
            const char* a2 = last ? nA : cA + (size_t)(t + 2) * kstep; const char* b2 = last ? nB : cB + (size_t)(t + 2) * kstep;
            const char* a3 = a2 + kstep; const char* b3 = b2 + kstep;
            if constexpr (Desc::GATHER) {
                if (last && has_next) {
#pragma unroll
                    for (int i = 0; i < 2; ++i)
#pragma unroll
                        for (int h = 0; h < 2; ++h) nvA[h][i] = D.agather(nxt, sR[i] + HALF * h) + (unsigned)sC[i] * 2u;
                }
            }
            unsigned va2[2][2];
#pragma unroll
            for (int i = 0; i < 2; ++i)
#pragma unroll
                for (int h = 0; h < 2; ++h) va2[h][i] = (Desc::GATHER && last) ? nvA[h][i] : voffA[h][i];
            PG8_LDB(B0, 0, 0); PG8_SCHED; PG8_LDA(At, 0, 0); PG8_STAGE(PG8_SA(1, 1), a1, voffA[1]);
            PG8_WAIT_L(8); PG8_BAR; PG8_WAIT_L(0); PG8_MMA(0, 0, At, B0); PG8_BAR; PG8_SCHED;
            PG8_LDB(B1, 0, 1); PG8_STAGE(PG8_SB(0, 0), b2, voffB[0]);
            PG8_BAR; PG8_WAIT_L(0); PG8_MMA(0, 1, At, B1); PG8_BAR;
            PG8_LDA(At, 0, 1); PG8_STAGE(PG8_SA(0, 0), a2, va2[0]);
            PG8_BAR; PG8_WAIT_L(0); PG8_MMA(1, 0, At, B0); PG8_BAR; PG8_SCHED;
            PG8_STAGE(PG8_SB(0, 1), b2, voffB[1]);
            PG8_WAIT_V(6); PG8_BAR; PG8_MMA(1, 1, At, B1); PG8_BAR;
            PG8_LDB(B0, 1, 0); PG8_SCHED; PG8_LDA(At, 1, 0); PG8_STAGE(PG8_SA(0, 1), a2, va2[1]);
            PG8_WAIT_L(8); PG8_BAR; PG8_WAIT_L(0); PG8_MMA(0, 0, At, B0); PG8_BAR; PG8_SCHED;
            PG8_LDB(B1, 1, 1); PG8_STAGE(PG8_SB(1, 0), b3, voffB[0]);
            PG8_BAR; PG8_WAIT_L(0); PG8_MMA(0, 1, At, B1); PG8_BAR;
            PG8_LDA(At, 1, 1); PG8_STAGE(PG8_SA(1, 0), a3, va2[0]);
            PG8_BAR; PG8_WAIT_L(0); PG8_MMA(1, 0, At, B0); PG8_BAR; PG8_SCHED;
            PG8_STAGE(PG8_SB(1, 1), b3, voffB[1]);
            PG8_WAIT_V(6); PG8_BAR; PG8_MMA(1, 1, At, B1); PG8_BAR;
        }
        if constexpr (Desc::FP8) asm volatile("s_nop 15\n\ts_nop 15" ::: "memory");
        E(acc, cur, wr, wc, fr, fq);
        if (!has_next) break;
#pragma unroll
        for (int a = 0; a < 2; ++a)
#pragma unroll
            for (int b = 0; b < 2; ++b)
#pragma unroll
                for (int m = 0; m < 4; ++m)
#pragma unroll
                    for (int n = 0; n < 2; ++n) acc[a][b][m][n] = (f32x4){0.f, 0.f, 0.f, 0.f};
        cur = nxt; cA = nA; cB = nB; ++ui;
        if constexpr (Desc::GATHER) {
#pragma unroll
            for (int i = 0; i < 2; ++i)
#pragma unroll
                for (int h = 0; h < 2; ++h) voffA[h][i] = nvA[h][i];
        }
    }
    PG8_WAIT_V(0);
    if (wr == 0) PG8_BAR;
    PG8_BAR;
#undef PG8_SA
#undef PG8_SB
#undef PG8_STAGE
#undef PG8_LDA
#undef PG8_LD8
#undef PG8_LDB
#undef PG8_MMA
#undef PG8_CAT
#undef PG8_WAIT_V
#undef PG8_WAIT_L
#undef PG8_BAR
#undef PG8_SCHED
}
}
using pg8::Unit;

struct DescPlain {
    static constexpr bool FP8 = false;
    static constexpr bool GATHER = false;
    const char* A; const char* B; int K; int lda, ldb;
    __device__ __forceinline__ size_t abase(const Unit& u) const { return (size_t)u.pm * 256 * lda * 2; }
    __device__ __forceinline__ size_t bbase(const Unit& u) const { return (size_t)u.pn * 256 * ldb * 2; }
    __device__ __forceinline__ unsigned arow(int r) const { return (unsigned)(r * lda) * 2u; }
    __device__ __forceinline__ unsigned brow(int r) const { return (unsigned)(r * ldb) * 2u; }
    __device__ __forceinline__ unsigned agather(const Unit&, int) const { return 0u; }
};
struct DescPlainF8 {
    static constexpr bool GATHER = false, FP8 = true;
    const char* A; const char* B; int K; int lda, ldb;
    __device__ __forceinline__ size_t abase(const Unit& u) const { return (size_t)u.pm * 256 * lda; }
    __device__ __forceinline__ size_t bbase(const Unit& u) const { return (size_t)u.pn * 256 * ldb; }
    __device__ __forceinline__ unsigned arow(int r) const { return (unsigned)(r * lda); }
    __device__ __forceinline__ unsigned brow(int r) const { return (unsigned)(r * ldb); }
    __device__ __forceinline__ unsigned agather(const Unit&, int) const { return 0u; }
};
struct DescMoe1 {
    static constexpr bool FP8 = false;
    static constexpr bool GATHER = true;
    const char* A; const char* B; int K; const int* idx;
    __device__ __forceinline__ size_t abase(const Unit&) const { return 0; }
    __device__ __forceinline__ size_t bbase(const Unit& u) const { return ((size_t)(u.pm >> 3) * 4096 + (size_t)u.pn * 256) * DM * 2; }
    __device__ __forceinline__ unsigned arow(int) const { return 0u; }
    __device__ __forceinline__ unsigned brow(int r) const { return (unsigned)(r * DM) * 2u; }
    __device__ __forceinline__ unsigned agather(const Unit& u, int r) const { return (unsigned)idx[u.pm * 256 + r] * (unsigned)(DM * 2); }
};
struct DescMoe1F8 {
    static constexpr bool GATHER = true, FP8 = true;
    const char* A; const char* B; int K; const int* idx;
    __device__ __forceinline__ size_t abase(const Unit&) const { return 0; }
    __device__ __forceinline__ size_t bbase(const Unit& u) const { return ((size_t)(u.pm >> 3) * 4096 + (size_t)u.pn * 256) * DM; }
    __device__ __forceinline__ unsigned arow(int) const { return 0u; }
    __device__ __forceinline__ unsigned brow(int r) const { return (unsigned)(r * DM); }
    __device__ __forceinline__ unsigned agather(const Unit& u, int r) const { return (unsigned)idx[u.pm * 256 + r] * (unsigned)DM; }
};
struct DescMoe2 {
    static constexpr bool FP8 = false;
    static constexpr bool GATHER = false;
    const char* A; const char* B; int K;
    __device__ __forceinline__ size_t abase(const Unit& u) const { return (size_t)u.pm * 256 * FF * 2; }
    __device__ __forceinline__ size_t bbase(const Unit& u) const { return ((size_t)(u.pm >> 3) * 2048 + (size_t)u.pn * 256) * FF * 2; }
    __device__ __forceinline__ unsigned arow(int r) const { return (unsigned)(r * FF) * 2u; }
    __device__ __forceinline__ unsigned brow(int r) const { return (unsigned)(r * FF) * 2u; }
    __device__ __forceinline__ unsigned agather(const Unit&, int) const { return 0u; }
};
struct DescMoe2F8 {
    static constexpr bool GATHER = false, FP8 = true;
    const char* A; const char* B; int K;
    __device__ __forceinline__ size_t abase(const Unit& u) const { return (size_t)u.pm * 256 * FF; }
    __device__ __forceinline__ size_t bbase(const Unit& u) const { return ((size_t)(u.pm >> 3) * 2048 + (size_t)u.pn * 256) * FF; }
    __device__ __forceinline__ unsigned arow(int r) const { return (unsigned)(r * FF); }
    __device__ __forceinline__ unsigned brow(int r) const { return (unsigned)(r * FF); }
    __device__ __forceinline__ unsigned agather(const Unit&, int) const { return 0u; }
};
struct DescF1 {
    static constexpr bool FP8 = false;
    static constexpr bool GATHER = false;
    const char* A; const char* B; int K;
    __device__ __forceinline__ size_t abase(const Unit& u) const { return (size_t)u.pm * 256 * 256 * 2; }
    __device__ __forceinline__ size_t bbase(const Unit& u) const { const int g = u.pn >> 6, pp = u.pn & 63; return ((size_t)(2 * pp) * DM + (size_t)g * 256) * 2; }
    __device__ __forceinline__ unsigned arow(int r) const { return (unsigned)(r * 256) * 2u; }
    __device__ __forceinline__ unsigned brow(int r) const { return (unsigned)((128 * (r & 127) + (r >> 7)) * DM) * 2u; }
    __device__ __forceinline__ unsigned agather(const Unit&, int) const { return 0u; }
};

__device__ __forceinline__ u32x4 pack8(const f32x4& a, const f32x4& b, float s) {
    u32x4 w; w.x = cvtpk(a[0] * s, a[1] * s); w.y = cvtpk(a[2] * s, a[3] * s); w.z = cvtpk(b[0] * s, b[1] * s); w.w = cvtpk(b[2] * s, b[3] * s); return w;
}
struct EpiInproj {
    static constexpr bool PERM = true;
    bf16_t *cq, *ckv, *kr, *qna, *kna, *vna; float* psq; const float* rope; float isc; int row0;
    __device__ __forceinline__ void operator()(const f32x4 (&acc)[2][2][4][2], const Unit& u, int wr, int wc, int fr, int fq) const {
        const int pn = u.pn;
#pragma unroll
        for (int ai = 0; ai < 2; ++ai)
#pragma unroll
            for (int m = 0; m < 4; ++m) {
                const int row = row0 + u.pm * 256 + ai * 128 + wr * 64 + m * 16 + fr;
                const bool lat = row >= NCTX;
#pragma unroll
                for (int bj = 0; bj < 2; ++bj) {
                    const f32x4 v0 = acc[ai][bj][m][0] * isc, v1 = acc[ai][bj][m][1] * isc;
                    const int cl = bj * 128 + wc * 32 + fq * 8;
                    if (pn <= 2) {
                        float ss = v0[0] * v0[0] + v0[1] * v0[1] + v0[2] * v0[2] + v0[3] * v0[3] + v1[0] * v1[0] + v1[1] * v1[1] + v1[2] * v1[2] + v1[3] * v1[3];
                        { auto r16 = __builtin_amdgcn_permlane16_swap(__float_as_uint(ss), __float_as_uint(ss), false, false); ss = __uint_as_float(r16[0]) + __uint_as_float(r16[1]); }
                        { auto r32 = __builtin_amdgcn_permlane32_swap(__float_as_uint(ss), __float_as_uint(ss), false, false); ss = __uint_as_float(r32[0]) + __uint_as_float(r32[1]); }
                        if (fq == 0) psq[(size_t)row * 24 + pn * 8 + bj * 4 + wc] = ss;
#if ATTG_FP8
                        if (pn < 2) { if (lat) *(u32x2*)((unsigned char*)cq + (size_t)(row - NCTX) * 512 + pn * 256 + cl) = pack8_fp8(v0, v1, 1.f); }
                        else *(u32x2*)((unsigned char*)ckv + (size_t)row * 256 + cl) = pack8_fp8(v0, v1, 1.f);
#else
                        if (pn < 2) { if (lat) *(u32x4*)(cq + (size_t)(row - NCTX) * 512 + pn * 256 + cl) = pack8(v0, v1, 1.f); }
                        else *(u32x4*)(ckv + (size_t)row * 256 + cl) = pack8(v0, v1, 1.f);
#endif
                    } else if (pn <= 6) {
                        const int h = 2 * (pn - 3) + bj, d = wc * 32 + fq * 8;
                        if (lat) *(u32x4*)(qna + ((size_t)h * NTOK + (row - NCTX)) * 128 + d) = pack8(v0, v1, NA_QS);
                    } else if (pn <= 10) {
                        const int h = 2 * (pn - 7) + bj, d = wc * 32 + fq * 8;
                        *(u32x4*)(kna + ((size_t)h * NKEY + row) * 128 + d) = pack8(v0, v1, 1.f);
                    } else if (pn <= 14) {
                        const int h = 2 * (pn - 11) + bj, d = wc * 32 + fq * 8;
                        *(u32x4*)(vna + ((size_t)h * NKEY + row) * 128 + d) = pack8(v0, v1, 1.f);
                    } else if (bj == 0 && wc < 2) {
                        f32x4 o0 = v0, o1 = v1;
                        if (lat) {
                            const int n = row - NCTX, pos = wc == 0 ? (n >> 6) : (n & 63);
                            const f32x4 cs0 = *(const f32x4*)(rope + (pos * 16 + fq * 4) * 2), cs1 = *(const f32x4*)(rope + (pos * 16 + fq * 4 + 2) * 2);
                            o0[0] = v0[0] * cs0[0] - v0[1] * cs0[1]; o0[1] = v0[1] * cs0[0] + v0[0] * cs0[1];
                            o0[2] = v0[2] * cs0[2] - v0[3] * cs0[3]; o0[3] = v0[3] * cs0[2] + v0[2] * cs0[3];
                            o1[0] = v1[0] * cs1[0] - v1[1] * cs1[1]; o1[1] = v1[1] * cs1[0] + v1[0] * cs1[1];
                            o1[2] = v1[2] * cs1[2] - v1[3] * cs1[3]; o1[3] = v1[3] * cs1[2] + v1[2] * cs1[3];
                        }
#if MLA_FP8
                        *(u32x2*)((unsigned char*)kr + (size_t)row * 64 + wc * 32 + fq * 8) = pack8_fp8(o0, o1, K8_SC);
#else
                        *(u32x4*)(kr + (size_t)row * 64 + wc * 32 + fq * 8) = pack8(o0, o1, 1.f);
#endif
                    }
                }
            }
    }
};
__device__ __forceinline__ float rstd_from_psq(const float* p, int cnt, float inv_n) {
    float s = 0.f;
    for (int i = 0; i < cnt; i += 4) { const f32x4 v = *(const f32x4*)(p + i); s += v[0] + v[1] + v[2] + v[3]; }
    return rsqrtf(s * inv_n + EPS);
}
struct EpiUq {
    static constexpr bool PERM = true;
    bf16_t* q; const float* psq; const float* rope; float isc;
    __device__ __forceinline__ void operator()(const f32x4 (&acc)[2][2][4][2], const Unit& u, int wr, int wc, int fr, int fq) const {
        const int pn = u.pn;
#pragma unroll
        for (int ai = 0; ai < 2; ++ai)
#pragma unroll
            for (int m = 0; m < 4; ++m) {
                const int row = u.pm * 256 + ai * 128 + wr * 64 + m * 16 + fr;
                const float rs = rstd_from_psq(psq + (size_t)(row + NCTX) * 24, 16, 1.f / 512.f) * isc;
#pragma unroll
                for (int bj = 0; bj < 2; ++bj) {
                    const f32x4 v0 = acc[ai][bj][m][0] * rs, v1 = acc[ai][bj][m][1] * rs;
                    if (pn < 4) {
                        const int h = 2 * pn + bj, d = wc * 32 + fq * 8;
#if MLA_FP8
                        *(u32x2*)((unsigned char*)q + ((size_t)h * NTOK + row) * 192 + d) = pack8_fp8(v0, v1, MLA_QS * Q8_SC);
#else
                        *(u32x4*)(q + ((size_t)h * NTOK + row) * 192 + d) = pack8(v0, v1, MLA_QS);
#endif
                    } else {
                        const int h = 4 * (pn - 4) + 2 * bj + (wc >> 1), ax = wc & 1;
                        const int pos = ax == 0 ? (row >> 6) : (row & 63);
                        const f32x4 cs0 = *(const f32x4*)(rope + (pos * 16 + fq * 4) * 2), cs1 = *(const f32x4*)(rope + (pos * 16 + fq * 4 + 2) * 2);
                        f32x4 o0, o1;
                        o0[0] = v0[0] * cs0[0] - v0[1] * cs0[1]; o0[1] = v0[1] * cs0[0] + v0[0] * cs0[1];
                        o0[2] = v0[2] * cs0[2] - v0[3] * cs0[3]; o0[3] = v0[3] * cs0[2] + v0[2] * cs0[3];
                        o1[0] = v1[0] * cs1[0] - v1[1] * cs1[1]; o1[1] = v1[1] * cs1[0] + v1[0] * cs1[1];
                        o1[2] = v1[2] * cs1[2] - v1[3] * cs1[3]; o1[3] = v1[3] * cs1[2] + v1[2] * cs1[3];
#if MLA_FP8
                        *(u32x2*)((unsigned char*)q + ((size_t)h * NTOK + row) * 192 + 128 + ax * 32 + fq * 8) = pack8_fp8(o0, o1, MLA_QS * Q8_SC);
#else
                        *(u32x4*)(q + ((size_t)h * NTOK + row) * 192 + 128 + ax * 32 + fq * 8) = pack8(o0, o1, MLA_QS);
#endif
                    }
                }
            }
    }
};
struct EpiUkv {
    static constexpr bool PERM = true;
    bf16_t *kn, *v; const float* psq; float isc;
    __device__ __forceinline__ void operator()(const f32x4 (&acc)[2][2][4][2], const Unit& u, int wr, int wc, int fr, int fq) const {
        const int pn = u.pn;
#pragma unroll
        for (int ai = 0; ai < 2; ++ai)
#pragma unroll
            for (int m = 0; m < 4; ++m) {
                const int row = u.pm * 256 + ai * 128 + wr * 64 + m * 16 + fr;
                const float rs = rstd_from_psq(psq + (size_t)row * 24 + 16, 8, 1.f / 256.f) * isc;
#pragma unroll
                for (int bj = 0; bj < 2; ++bj) {
                    const int h = 2 * (pn & 3) + bj, d = wc * 32 + fq * 8;
#if MLA_FP8
                    if (pn < 4) { *(u32x2*)((unsigned char*)kn + ((size_t)h * NKEY + row) * 128 + d) = pack8_fp8(acc[ai][bj][m][0], acc[ai][bj][m][1], rs * K8_SC); continue; }
                    else {
                        const int kk = row & 63, r_ = (kk & 3) + 4 * ((kk >> 3) & 3), slot = 32 * ((kk >> 2) & 1) + 16 * (kk >> 5) + r_;
                        unsigned char* vt = (unsigned char*)v + (((size_t)h * (NKEY / 64) + (row >> 6)) * 128 + d) * 64 + slot;
                        const u32x2 w8 = pack8_fp8(acc[ai][bj][m][0], acc[ai][bj][m][1], rs);
#pragma unroll
                        for (int j = 0; j < 8; ++j) vt[j * 64] = (unsigned char)(((j < 4 ? w8.x : w8.y) >> (8 * (j & 3))) & 0xffu);
                        continue; }
#endif
                    bf16_t* dst = (pn < 4 ? kn : v) + ((size_t)h * NKEY + row) * 128 + d;
                    *(u32x4*)dst = pack8(acc[ai][bj][m][0], acc[ai][bj][m][1], rs);
                }
            }
    }
};
#if RES_BF16
typedef bf16_t res_t;
__device__ __forceinline__ f32x4 ldres4(const res_t* q) { const u32x2 w = *(const u32x2*)q;
    return (f32x4){__uint_as_float(w.x << 16), __uint_as_float(w.x & 0xffff0000u), __uint_as_float(w.y << 16), __uint_as_float(w.y & 0xffff0000u)}; }
__device__ __forceinline__ void stres4(res_t* q, const f32x4& v) { u32x2 w; w.x = cvtpk(v[0], v[1]); w.y = cvtpk(v[2], v[3]); *(u32x2*)q = w; }
#else
typedef float res_t;
__device__ __forceinline__ f32x4 ldres4(const res_t* q) { return *(const f32x4*)q; }
__device__ __forceinline__ void stres4(res_t* q, const f32x4& v) { *(f32x4*)q = v; }
#endif
#if RES_BF16
typedef u32x2 resraw_t;
__device__ __forceinline__ resraw_t ldraw4(const res_t* q) { return *(const u32x2*)q; }
__device__ __forceinline__ f32x4 unraw4(const resraw_t& w) { return (f32x4){__uint_as_float(w.x << 16), __uint_as_float(w.x & 0xffff0000u), __uint_as_float(w.y << 16), __uint_as_float(w.y & 0xffff0000u)}; }
#else
typedef f32x4 resraw_t;
__device__ __forceinline__ resraw_t ldraw4(const res_t* q) { return *(const f32x4*)q; }
__device__ __forceinline__ f32x4 unraw4(const resraw_t& w) { return w; }
#endif
template <typename BT>
struct EpiResid {
    static constexpr bool PERM = true;
    res_t* out; const BT* base; const float* gate; float isc;
    __device__ __forceinline__ void operator()(const f32x4 (&acc)[2][2][4][2], const Unit& u, int wr, int wc, int fr, int fq) const {
        const int row0 = u.pm * 256 + wr * 64 + fr, col0 = u.pn * 256 + wc * 32 + 8 * fq;
        f32x4 gv[2][2];
#pragma unroll
        for (int bj = 0; bj < 2; ++bj)
#pragma unroll
            for (int n = 0; n < 2; ++n) gv[bj][n] = *(const f32x4*)(gate + col0 + bj * 128 + n * 4) * isc;
#pragma unroll
        for (int ai = 0; ai < 2; ++ai)
#pragma unroll
            for (int m = 0; m < 4; ++m) { const size_t ro = (size_t)(row0 + ai * 128 + m * 16) * DM + col0;
#pragma unroll
                for (int bj = 0; bj < 2; ++bj) {
                    f32x4 b0, b1;
                    if constexpr (sizeof(BT) == 2) { const u32x4 w = *(const u32x4*)(base + ro + bj * 128);
                        b0 = (f32x4){__uint_as_float(w.x << 16), __uint_as_float(w.x & 0xffff0000u), __uint_as_float(w.y << 16), __uint_as_float(w.y & 0xffff0000u)};
                        b1 = (f32x4){__uint_as_float(w.z << 16), __uint_as_float(w.z & 0xffff0000u), __uint_as_float(w.w << 16), __uint_as_float(w.w & 0xffff0000u)}; }
                    else { b0 = *(const f32x4*)(base + ro + bj * 128); b1 = *(const f32x4*)(base + ro + bj * 128 + 4); }
                    const f32x4 o0 = b0 + gv[bj][0] * acc[ai][bj][m][0], o1 = b1 + gv[bj][1] * acc[ai][bj][m][1];
                    if constexpr (sizeof(res_t) == 2) *(u32x4*)(out + ro + bj * 128) = pack8(o0, o1, 1.f);
                    else { *(f32x4*)(out + ro + bj * 128) = o0; *(f32x4*)(out + ro + bj * 128 + 4) = o1; } } }
    }
};
struct EpiMoe1 {
    static constexpr bool PERM = true;
    bf16_t* act; float isc;
    __device__ __forceinline__ void operator()(const f32x4 (&acc)[2][2][4][2], const Unit& u, int wr, int wc, int fr, int fq) const {
        const float c1 = -isc * LOG2E, kinv = 1.f / (isc * isc * (MOE2_FP8 ? 4.f : 1.f));
#pragma unroll
        for (int ai = 0; ai < 2; ++ai)
#pragma unroll
            for (int m = 0; m < 4; ++m) {
                const int row = u.pm * 256 + ai * 128 + wr * 64 + m * 16 + fr;
                f32x4 o[2];
#pragma unroll
                for (int n = 0; n < 2; ++n)
#pragma unroll
                    for (int j = 0; j < 4; ++j) {
                        const float ag = acc[ai][0][m][n][j], au = acc[ai][1][m][n][j]; float gu_, o_;
                        asm("v_mul_f32 %0, %2, %3\n\t"
                            "v_exp_f32 %0, %0\n\t"
                            "v_mul_f32 %1, %2, %4\n\t"
                            "v_fma_f32 %0, %0, %5, %5\n\t"
                            "v_rcp_f32 %0, %0\n\t"
                            "s_nop 0\n\t"
                            "v_mul_f32 %0, %1, %0"
                            : "=&v"(o_), "=&v"(gu_) : "v"(ag), "v"(c1), "v"(au), "v"(kinv));
                        o[n][j] = o_; }
#if MOE2_FP8
                *(u32x2*)((unsigned char*)act + (size_t)row * FF + u.pn * 128 + wc * 32 + fq * 8) = pack8_fp8(o[0], o[1], 1.f);
#else
                *(u32x4*)(act + (size_t)row * FF + u.pn * 128 + wc * 32 + fq * 8) = pack8(o[0], o[1], 1.f);
#endif
            }
    }
};
struct EpiMoe2 {
    static constexpr bool PERM = true;
    bf16_t* ye; const float* gate; float isc;
    __device__ __forceinline__ void operator()(const f32x4 (&acc)[2][2][4][2], const Unit& u, int wr, int wc, int fr, int fq) const {
#pragma unroll
        for (int ai = 0; ai < 2; ++ai)
#pragma unroll
            for (int m = 0; m < 4; ++m) {
                const int row = u.pm * 256 + ai * 128 + wr * 64 + m * 16 + fr;
                const float g = gate[row] * isc;
#pragma unroll
                for (int bj = 0; bj < 2; ++bj)
                    *(u32x4*)(ye + (size_t)row * DM + u.pn * 256 + bj * 128 + wc * 32 + fq * 8) = pack8(acc[ai][bj][m][0], acc[ai][bj][m][1], g);
            }
    }
};
struct EpiF1 {
    static constexpr bool PERM = true;
    bf16_t* g1;
    __device__ __forceinline__ void operator()(const f32x4 (&acc)[2][2][4][2], const Unit& u, int wr, int wc, int fr, int fq) const {
        const int g = u.pn >> 6, pp = u.pn & 63, ri = u.pm;
#pragma unroll
        for (int ai = 0; ai < 2; ++ai)
#pragma unroll
            for (int m = 0; m < 4; ++m) {
                const int mm = ai * 128 + wr * 64 + m * 16 + fr;
#pragma unroll
                for (int bj = 0; bj < 2; ++bj) { const int b = 2 * pp + bj;
                    *(u32x4*)(g1 + ((((size_t)(g * 256 + mm) * 128 + b) * 2 + ri) * 128) + wc * 32 + fq * 8) = pack8(acc[ai][bj][m][0], acc[ai][bj][m][1], 1.f); }
            }
    }
};
struct EpiF2A {
    static constexpr bool PERM = true;
    bf16_t* tp; const float* tw;
    __device__ __forceinline__ void operator()(const f32x4 (&acc)[2][2][4][2], const Unit& u, int wr, int wc, int fr, int fq) const {
#pragma unroll
        for (int m = 0; m < 4; ++m) {
            const int k1 = wr * 64 + m * 16 + fr, b0 = wc * 32 + fq * 8;
            const float* t = tw + ((size_t)k1 * 128 + b0) * 2;
            f32x4 cs[4];
#pragma unroll
            for (int j = 0; j < 4; ++j) cs[j] = *(const f32x4*)(t + 4 * j);
#pragma unroll
            for (int bj = 0; bj < 2; ++bj) {
                const int gm = 2 * u.pn + bj;
                f32x4 r0, r1, i0, i1;
#pragma unroll
                for (int j = 0; j < 4; ++j) {
                    const float c_a = cs[j >> 1][(j & 1) * 2], s_a = cs[j >> 1][(j & 1) * 2 + 1];
                    const float c_b = cs[2 + (j >> 1)][(j & 1) * 2], s_b = cs[2 + (j >> 1)][(j & 1) * 2 + 1];
                    const float tr0 = acc[0][bj][m][0][j], ti0 = acc[1][bj][m][0][j], tr1 = acc[0][bj][m][1][j], ti1 = acc[1][bj][m][1][j];
                    r0[j] = c_a * tr0 + s_a * ti0; i0[j] = c_a * ti0 - s_a * tr0;
                    r1[j] = c_b * tr1 + s_b * ti1; i1[j] = c_b * ti1 - s_b * tr1;
                }
                bf16_t* dst = tp + (((size_t)k1 * 2048 + gm) * 2) * 128 + b0;
                *(u32x4*)dst = pack8(r0, r1, 1.f); *(u32x4*)(dst + 128) = pack8(i0, i1, 1.f);
            }
        }
    }
};
struct EpiF2B {
    static constexpr bool PERM = true;
    bf16_t* f;
    __device__ __forceinline__ void operator()(const f32x4 (&acc)[2][2][4][2], const Unit& u, int wr, int wc, int fr, int fq) const {
        const int k1 = u.pn >> 3;
#pragma unroll
        for (int m = 0; m < 4; ++m) {
            const int k2 = wr * 64 + m * 16 + fr;
#pragma unroll
            for (int bj = 0; bj < 2; ++bj)
                *(u32x4*)(f + (size_t)(k1 + 128 * k2) * DM + (u.pn & 7) * 256 + bj * 128 + wc * 32 + fq * 8) = pack8(acc[0][bj][m][0], acc[0][bj][m][1], 1.f);
        }
    }
};

namespace att {
constexpr int QBLK = 32, KVBLK = 64;
constexpr float THR2 = 11.0f;
#define SBAR() __builtin_amdgcn_sched_barrier(0)
__device__ __forceinline__ int crow(int r, int hi) { return (r & 3) + 8 * (r >> 2) + 4 * hi; }
template <int DQK> __device__ __forceinline__ int kswz(int row, int colB) { return row * (DQK * 2 + 16) + colB; }
template <bool F8 = false>
__device__ __forceinline__ void partialSM(f32x16& p0, f32x16& p1, float& m_reg, float& mn, float& alpha) {
    constexpr float THRX = F8 ? 8.0f : THR2;
    float pmax = p0[0];
#pragma unroll
    for (int r = 1; r < 16; ++r) pmax = fmaxf(pmax, p0[r]);
#pragma unroll
    for (int r = 0; r < 16; ++r) pmax = fmaxf(pmax, p1[r]);
    { auto rr = __builtin_amdgcn_permlane32_swap(__float_as_uint(pmax), __float_as_uint(pmax), false, false);
      pmax = fmaxf(__uint_as_float(rr[0]), __uint_as_float(rr[1])); }
    if (__builtin_expect(__all(pmax - m_reg <= THRX), 1)) { mn = m_reg; alpha = 1.f; }
    else { mn = fmaxf(m_reg, pmax); alpha = __builtin_amdgcn_exp2f(m_reg - mn); m_reg = mn; }
#pragma unroll
    for (int r = 0; r < 16; ++r) p0[r] = p0[r] - mn;
#pragma unroll
    for (int r = 0; r < 16; ++r) p1[r] = p1[r] - mn;
#pragma unroll
    for (int r = 0; r < 16; ++r) p0[r] = __builtin_amdgcn_exp2f(p0[r]);
}

__device__ __forceinline__ void partialSM_rel(f32x16& p0, f32x16& p1, float& m_reg, float& alpha, bool first) {
    float pmax = p0[0];
#pragma unroll
    for (int r = 1; r < 16; ++r) pmax = fmaxf(pmax, p0[r]);
#pragma unroll
    for (int r = 0; r < 16; ++r) pmax = fmaxf(pmax, p1[r]);
    { auto rr = __builtin_amdgcn_permlane32_swap(__float_as_uint(pmax), __float_as_uint(pmax), false, false);
      pmax = fmaxf(__uint_as_float(rr[0]), __uint_as_float(rr[1])); }
    if (__builtin_expect(!first && __all(pmax <= 8.0f), 1)) { alpha = 1.f; }
    else { const float d = first ? pmax : fmaxf(pmax, 0.f); alpha = first ? 0.f : __builtin_amdgcn_exp2f(-d); m_reg += d;
#pragma unroll
        for (int r = 0; r < 16; ++r) { p0[r] -= d; p1[r] -= d; } }
#pragma unroll
    for (int r = 0; r < 16; ++r) p0[r] = __builtin_amdgcn_exp2f(p0[r]);
}
__device__ __forceinline__ void finishSM(f32x16& p0, f32x16& p1, float alpha, float& l_reg, bf16x8& pa0, bf16x8& pa1, bf16x8& pa2, bf16x8& pa3) {
#pragma unroll
    for (int r = 0; r < 16; ++r) p1[r] = __builtin_amdgcn_exp2f(p1[r]);
    float ps = 0;
#pragma unroll
    for (int r = 0; r < 16; ++r) ps += p0[r];
#pragma unroll
    for (int r = 0; r < 16; ++r) ps += p1[r];
    { auto rr = __builtin_amdgcn_permlane32_swap(__float_as_uint(ps), __float_as_uint(ps), false, false);
      ps = __uint_as_float(rr[0]) + __uint_as_float(rr[1]); }
    l_reg = l_reg * alpha + ps;
#define PK4(P, BASE, OUT) do { unsigned a0 = cvtpk(P[BASE + 0], P[BASE + 1]), a1 = cvtpk(P[BASE + 2], P[BASE + 3]);   \
    unsigned b0 = cvtpk(P[BASE + 4], P[BASE + 5]), b1 = cvtpk(P[BASE + 6], P[BASE + 7]);                              \
    auto r0 = __builtin_amdgcn_permlane32_swap(a0, b0, false, false); auto r1 = __builtin_amdgcn_permlane32_swap(a1, b1, false, false); \
    u32x4 w = {r0[0], r1[0], r0[1], r1[1]}; OUT = *reinterpret_cast<bf16x8*>(&w); } while (0)
    PK4(p0, 0, pa0); PK4(p0, 8, pa1); PK4(p1, 0, pa2); PK4(p1, 8, pa3);
#undef PK4
}
template <int DQK>
__device__ __forceinline__ void qkt(f32x16& p0, f32x16& p1, const char* Ks, const bf16x8* qr, const char* qx, int r32, int hi) {
    p0 = f32x16{}; p1 = f32x16{};
    const char* kb_ = Ks + r32 * (DQK * 2 + 16) + hi * 16;
#pragma unroll
    for (int d0 = 0; d0 < DQK / 16; ++d0) {
        bf16x8 b0 = *reinterpret_cast<const bf16x8*>(kb_ + d0 * 32);
        bf16x8 b1 = *reinterpret_cast<const bf16x8*>(kb_ + 32 * (DQK * 2 + 16) + d0 * 32);
        const bf16x8 q = d0 < 8 ? qr[d0 < 8 ? d0 : 0] : *reinterpret_cast<const bf16x8*>(qx + (d0 - 8) * 1024);
        p0 = __builtin_amdgcn_mfma_f32_32x32x16_bf16(b0, q, p0, 0, 0, 0);
        p1 = __builtin_amdgcn_mfma_f32_32x32x16_bf16(b1, q, p1, 0, 0, 0); }
}
__device__ __forceinline__ int v_st(int k, int c) { const int kk = (k & ~0xC) | ((k & 4) << 1) | ((k & 8) >> 1); return ((kk >> 3) * 4 + (c >> 5)) * 512 + ((kk & 7) * 32 + (c & 31)) * 2; }
__device__ __forceinline__ int v_rd_base(int lane) { return ((lane & 3) << 3) | (((lane >> 2) & 3) << 6) | (((lane >> 4) & 1) << 5) | (((lane >> 5) & 1) << 8); }
constexpr int v_rd_off(int d0, int ks, int half) { return d0 * 512 + ks * 4096 + half * 2048; }
template <int OFF> __device__ __forceinline__ s16x4 tr_read(int vb) {
    s16x4 r; asm volatile("ds_read_b64_tr_b16 %0, %1 offset:%2" : "=&v"(r) : "v"(vb), "i"(OFF) : "memory"); return r;
}
template <int D0> __device__ __forceinline__ void pv_one(f32x16& od, int vb, bf16x8 pa0, bf16x8 pa1, bf16x8 pa2, bf16x8 pa3) {
    const s16x4 l0 = tr_read<v_rd_off(D0, 0, 0)>(vb), h0 = tr_read<v_rd_off(D0, 0, 1)>(vb), l1 = tr_read<v_rd_off(D0, 1, 0)>(vb), h1 = tr_read<v_rd_off(D0, 1, 1)>(vb);
    const s16x4 l2 = tr_read<v_rd_off(D0, 2, 0)>(vb), h2 = tr_read<v_rd_off(D0, 2, 1)>(vb), l3 = tr_read<v_rd_off(D0, 3, 0)>(vb), h3 = tr_read<v_rd_off(D0, 3, 1)>(vb);
    asm volatile("s_waitcnt lgkmcnt(0)" ::: "memory"); SBAR();
#define PK(L, H) (bf16x8){L[0], L[1], L[2], L[3], H[0], H[1], H[2], H[3]}
    od = __builtin_amdgcn_mfma_f32_32x32x16_bf16(pa0, PK(l0, h0), od, 0, 0, 0);
    od = __builtin_amdgcn_mfma_f32_32x32x16_bf16(pa1, PK(l1, h1), od, 0, 0, 0);
    od = __builtin_amdgcn_mfma_f32_32x32x16_bf16(pa2, PK(l2, h2), od, 0, 0, 0);
    od = __builtin_amdgcn_mfma_f32_32x32x16_bf16(pa3, PK(l3, h3), od, 0, 0, 0);
#undef PK
}
__device__ __forceinline__ void pv_d0(f32x16* o, int vb, bf16x8 pa0, bf16x8 pa1, bf16x8 pa2, bf16x8 pa3) {
    pv_one<0>(o[0], vb, pa0, pa1, pa2, pa3); pv_one<1>(o[1], vb, pa0, pa1, pa2, pa3); pv_one<2>(o[2], vb, pa0, pa1, pa2, pa3); pv_one<3>(o[3], vb, pa0, pa1, pa2, pa3);
}
template <int DQK> struct Lds {
    static constexpr int SHM_V = KVBLK * 128 * 2, SHM_K = (MLA_FP8 && DQK == 192) ? KVBLK * 208 : KVBLK * (DQK * 2 + 16);
    static constexpr int OFF_K = 2 * SHM_V, OFF_WS = OFF_K + 2 * SHM_K, OFF_BT = OFF_WS + 8 * 64 * 4, OFF_QX = OFF_BT + 640 * 4, TOTAL = OFF_QX + 8 * 4096;
};
struct NaCtx { int u0; int rq; int rs; int cq; int cs; const LAS float* bt; };

template <int DQK, bool NA>
__device__ __forceinline__ void attn_body(const bf16_t* __restrict__ Qb, const bf16_t* __restrict__ Kh, const bf16_t* __restrict__ Krope, const bf16_t* __restrict__ Vh,
                                          bf16_t* __restrict__ Ob, int NT, int u0, int qrow0, const float* __restrict__ bias_h, char* lds) {
    using L = Lds<DQK>;
    constexpr int SHM_V = L::SHM_V, SHM_K = L::SHM_K;
    const int tid = ltid(), wid = tid >> 6, lane = tid & 63, r32 = lane & 31, hi = lane >> 5;
    char* V_lds = lds; char* K_lds = lds + L::OFF_K;
    float* ws = (float*)(lds + L::OFF_WS) + wid * 64; float* li_l = ws; float* al_l = ws + 32;
    float* bt = (float*)(lds + L::OFF_BT);
    __syncthreads();
    if constexpr (NA) { if (tid < 15 * 31) bt[48 + (tid / 31) * 32 + (tid % 31)] = bias_h[tid] * LOG2E; }
    float m_reg = -1e30f, l_reg = 0; f32x16 o[4] = {}; bf16x8 qr[8];
    const bf16_t* Qw = Qb + (size_t)(wid * QBLK + r32) * DQK + hi * 8;
    char* qx = lds + L::OFF_QX + wid * 4096 + lane * 16;
#pragma unroll
    for (int d0 = 0; d0 < 8; ++d0) qr[d0] = *reinterpret_cast<const bf16x8*>(Qw + d0 * 16);
    if constexpr (DQK == 192) {
#pragma unroll
        for (int d0 = 8; d0 < 12; ++d0) *reinterpret_cast<bf16x8*>(qx + (d0 - 8) * 1024) = *reinterpret_cast<const bf16x8*>(Qw + d0 * 16);
    }
    const int sr = tid >> 4, sc = (tid & 15) * 8, vst0 = v_st(sr, sc), vst1 = v_st(32 + sr, sc);
    const int rr_ = tid >> 3, rc_ = (tid & 7) * 8;
    const unsigned offKV = (unsigned)(sr * 128 + sc) * 2u, offR = (unsigned)(rr_ * 64 + rc_) * 2u;
    const int vb0 = (int)(uintptr_t)V_lds + v_rd_base(lane);
    const int rq = NA ? (wid >> 1) : 0;
    const int cq = 32 * (wid & 1) + r32;
    const int cs = cq < 8 ? 0 : (cq > 56 ? 48 : cq - 8);
    constexpr int SD = (DQK == 192) ? 1 : 2, SE = 0, SO = SD - 1;
    struct Slot { bf16x8 vs0, vs1, ks0, ks1, kr; } s_[SD];
    auto keyof = [&](int t) -> int { if constexpr (!NA) return t * KVBLK; else { if (t < 4) return t * KVBLK; int kr = u0 + t - 4; kr = kr > 255 ? 255 : kr; return NCTX + kr * KVBLK; } };
#define SLOAD(i, t) do { const size_t k0_ = (size_t)__builtin_amdgcn_readfirstlane(keyof(t)); const char* vp_ = (const char*)Vh + k0_ * 256; const char* kp_ = (const char*)Kh + k0_ * 256; \
    s_[i].vs0 = *(const bf16x8*)(vp_ + offKV); s_[i].vs1 = *(const bf16x8*)(vp_ + offKV + 8192u); \
    s_[i].ks0 = *(const bf16x8*)(kp_ + offKV); s_[i].ks1 = *(const bf16x8*)(kp_ + offKV + 8192u); \
    if constexpr (DQK == 192) s_[i].kr = *(const bf16x8*)((const char*)Krope + k0_ * 128 + offR); } while (0)
#define SWRITE(b, i) do { *(bf16x8*)(V_lds + (b) * SHM_V + vst0) = s_[i].vs0; *(bf16x8*)(V_lds + (b) * SHM_V + vst1) = s_[i].vs1; \
    *(bf16x8*)(K_lds + (b) * SHM_K + kswz<DQK>(sr, sc * 2)) = s_[i].ks0; *(bf16x8*)(K_lds + (b) * SHM_K + kswz<DQK>(32 + sr, sc * 2)) = s_[i].ks1; \
    if constexpr (DQK == 192) *(bf16x8*)(K_lds + (b) * SHM_K + kswz<DQK>(rr_, 256 + rc_ * 2)) = s_[i].kr; } while (0)
#define SWAIT() do { if constexpr (SD == 1) asm volatile("s_waitcnt vmcnt(0)" ::: "memory"); else asm volatile("s_waitcnt vmcnt(4)" ::: "memory"); } while (0)
#define RESC(a) do { if (__any((a) < 1.f)) { if (hi == 0) al_l[r32] = (a); asm volatile("s_waitcnt lgkmcnt(0)" ::: "memory"); \
    _Pragma("unroll") for (int d = 0; d < 4; ++d) _Pragma("unroll") for (int r = 0; r < 16; ++r) o[d][r] *= al_l[crow(r, hi)]; } } while (0)
#define NAHOOK(P0, P1, t) do { if constexpr (NA) { if ((t) >= 4) { const int kr_ = u0 + (t) - 4; const int rabs = qrow0 + rq; \
        const int rs_ = rabs < 4 ? 0 : (rabs > 252 ? 248 : rabs - 4); const bool tv = (kr_ >= rs_) && (kr_ < rs_ + 8) && (kr_ <= 255); \
        int ro = kr_ - rabs + 7; ro = ro < 0 ? 0 : (ro > 14 ? 14 : ro); \
        const float* bp = bt + 48 + ro * 32 + 15 - cq + 4 * hi; \
        _Pragma("unroll") for (int r = 0; r < 16; ++r) { const int ckc = (r & 3) + 8 * (r >> 2); const int ck0 = ckc + 4 * hi; \
            const bool v0_ = tv && ((unsigned)(ck0 - cs) < 16u), v1_ = tv && ((unsigned)(ck0 + 32 - cs) < 16u); \
            P0[r] = v0_ ? P0[r] + bp[ckc] : -1e30f; P1[r] = v1_ ? P1[r] + bp[ckc + 32] : -1e30f; } } } } while (0)
    f32x16 pA0, pA1, pB0, pB1; float mnA, mnB, alA, alB; bf16x8 pa0, pa1, pa2, pa3;
    SLOAD(SE, 0); asm volatile("s_waitcnt vmcnt(0)" ::: "memory"); SWRITE(0, SE); __syncthreads();
    qkt<DQK>(pA0, pA1, K_lds, qr, qx, r32, hi); partialSM(pA0, pA1, m_reg, mnA, alA);
    SLOAD(SO, 1); if constexpr (SD == 2) { if (2 < NT) SLOAD(SE, 2); }
    SWAIT(); SWRITE(1, SO); __syncthreads();
    const int grp = NA ? 0 : wave_rank(wid);
    if (NA || grp == 0) {
        for (int j = 1; j + 1 < NT; j += 2) {
            SBAR(); qkt<DQK>(pB0, pB1, K_lds + SHM_K, qr, qx, r32, hi);
            finishSM(pA0, pA1, alA, l_reg, pa0, pa1, pa2, pa3); SBAR();
            SLOAD(SO, j + SD); SBAR();
            pv_d0(o, vb0, pa0, pa1, pa2, pa3); NAHOOK(pB0, pB1, j); partialSM(pB0, pB1, m_reg, mnB, alB);
            __syncthreads(); SWAIT(); SWRITE(0, SE);
            RESC(alB); __syncthreads();
            SBAR(); qkt<DQK>(pA0, pA1, K_lds, qr, qx, r32, hi);
            finishSM(pB0, pB1, alB, l_reg, pa0, pa1, pa2, pa3); SBAR();
            if (SD == 1 || j + 3 < NT) SLOAD(SE, j + 1 + SD); SBAR();
            pv_d0(o, vb0 + SHM_V, pa0, pa1, pa2, pa3); NAHOOK(pA0, pA1, j + 1); partialSM(pA0, pA1, m_reg, mnA, alA);
            __syncthreads(); SWAIT(); SWRITE(1, SO);
            RESC(alA); __syncthreads();
        }
    } else {
        for (int j = 1; j + 1 < NT; j += 2) {
            SBAR(); finishSM(pA0, pA1, alA, l_reg, pa0, pa1, pa2, pa3); SBAR();
            SLOAD(SO, j + SD); SBAR();
            qkt<DQK>(pB0, pB1, K_lds + SHM_K, qr, qx, r32, hi); SBAR();
            NAHOOK(pB0, pB1, j); partialSM(pB0, pB1, m_reg, mnB, alB); SBAR();
            pv_d0(o, vb0, pa0, pa1, pa2, pa3);
            __syncthreads(); SWAIT(); SWRITE(0, SE);
            RESC(alB); __syncthreads();
            SBAR(); finishSM(pB0, pB1, alB, l_reg, pa0, pa1, pa2, pa3); SBAR();
            if (SD == 1 || j + 3 < NT) SLOAD(SE, j + 1 + SD); SBAR();
            qkt<DQK>(pA0, pA1, K_lds, qr, qx, r32, hi); SBAR();
            NAHOOK(pA0, pA1, j + 1); partialSM(pA0, pA1, m_reg, mnA, alA); SBAR();
            pv_d0(o, vb0 + SHM_V, pa0, pa1, pa2, pa3);
            __syncthreads(); SWAIT(); SWRITE(1, SO);
            RESC(alA); __syncthreads();
        }
    }
    SBAR(); qkt<DQK>(pB0, pB1, K_lds + SHM_K, qr, qx, r32, hi);
    finishSM(pA0, pA1, alA, l_reg, pa0, pa1, pa2, pa3); SBAR();
    pv_d0(o, vb0, pa0, pa1, pa2, pa3); NAHOOK(pB0, pB1, NT - 1); partialSM(pB0, pB1, m_reg, mnB, alB);
    __syncthreads(); RESC(alB);
    finishSM(pB0, pB1, alB, l_reg, pa0, pa1, pa2, pa3); SBAR();
    pv_d0(o, vb0 + SHM_V, pa0, pa1, pa2, pa3);
    if (hi == 0) li_l[r32] = l_reg; asm volatile("s_waitcnt lgkmcnt(0)" ::: "memory");
    float rli[16];
#pragma unroll
    for (int r = 0; r < 16; ++r) rli[r] = __builtin_amdgcn_rcpf(li_l[crow(r, hi)]);
    bf16_t* Ow = Ob + (size_t)(wid * QBLK) * DM;
#pragma unroll
    for (int r = 0; r < 16; ++r) { const int orow = crow(r, hi);
#pragma unroll
        for (int d0 = 0; d0 < 4; ++d0) Ow[(size_t)orow * DM + d0 * 32 + r32] = f2bf(o[d0][r] * rli[r]); }
#undef SLOAD
#undef SWRITE
#undef SWAIT
#undef RESC
#undef NAHOOK
}

template <int DQK>
__device__ __forceinline__ void qkt2(f32x16& p0, f32x16& p1, const char* Ks, const bf16x8* qr, const char* qx, int r32, int hi) {
    constexpr int KSTR = DQK * 2 + 16, ND = DQK / 16;
    p0 = f32x16{}; p1 = f32x16{};
    const char* kb_ = Ks + r32 * KSTR + hi * 16;
    bf16x8 a0 = *reinterpret_cast<const bf16x8*>(kb_), a1 = *reinterpret_cast<const bf16x8*>(kb_ + 32 * KSTR);
    bf16x8 qn = *reinterpret_cast<const bf16x8*>(qx);
#pragma unroll
    for (int d0 = 0; d0 < ND; ++d0) {
        bf16x8 n0 = a0, n1 = a1;
        if (d0 + 1 < ND) { n0 = *reinterpret_cast<const bf16x8*>(kb_ + (d0 + 1) * 32); n1 = *reinterpret_cast<const bf16x8*>(kb_ + 32 * KSTR + (d0 + 1) * 32); }
        bf16x8 q;
        if (d0 < 8) q = qr[d0 < 8 ? d0 : 0];
        else { q = qn; if (d0 + 1 < ND) qn = *reinterpret_cast<const bf16x8*>(qx + (d0 + 1 - 8) * 1024); }
        p0 = __builtin_amdgcn_mfma_f32_32x32x16_bf16(a0, q, p0, 0, 0, 0);
        p1 = __builtin_amdgcn_mfma_f32_32x32x16_bf16(a1, q, p1, 0, 0, 0);
        a0 = n0; a1 = n1;
    }
}

template <int OFF> __device__ __forceinline__ bf16x8 lds_rd128(int addr) {
    bf16x8 r; asm volatile("ds_read_b128 %0, %1 offset:%2" : "=&v"(r) : "v"(addr), "i"(OFF) : "memory"); return r;
}
template <int DQK, int D0> struct QkStep {
    static constexpr int PF = 2, RING = PF + 1;
    static __device__ __forceinline__ void run(f32x16& p0, f32x16& p1, int ka, const bf16x8* qr, const bf16x8 (&qx4)[4], bf16x8 (&f0)[RING], bf16x8 (&f1)[RING]) {
        constexpr int KSTR = DQK * 2 + 16, ND = DQK / 16;
        if constexpr (D0 + PF < ND) { f0[(D0 + PF) % RING] = lds_rd128<(D0 + PF) * 32>(ka); f1[(D0 + PF) % RING] = lds_rd128<32 * KSTR + (D0 + PF) * 32>(ka); }
        constexpr int newer = (ND - 1 - D0) < PF ? (ND - 1 - D0) : PF;
        if constexpr (newer == 3) asm volatile("s_waitcnt lgkmcnt(6)" ::: "memory");
        else if constexpr (newer == 2) asm volatile("s_waitcnt lgkmcnt(4)" ::: "memory");
        else if constexpr (newer == 1) asm volatile("s_waitcnt lgkmcnt(2)" ::: "memory");
        else asm volatile("s_waitcnt lgkmcnt(0)" ::: "memory");
        SBAR();
        const bf16x8 q = D0 < 8 ? qr[D0 < 8 ? D0 : 0] : qx4[D0 >= 8 ? D0 - 8 : 0];
        p0 = __builtin_amdgcn_mfma_f32_32x32x16_bf16(f0[D0 % RING], q, p0, 0, 0, 0);
        p1 = __builtin_amdgcn_mfma_f32_32x32x16_bf16(f1[D0 % RING], q, p1, 0, 0, 0);
        SBAR();
        if constexpr (D0 + 1 < ND) QkStep<DQK, D0 + 1>::run(p0, p1, ka, qr, qx4, f0, f1);
    }
};
template <int DQK>
__device__ __forceinline__ void qkt3(f32x16& p0, f32x16& p1, const char* Ks, const bf16x8* qr, const bf16x8 (&qx4)[4], int r32, int hi) {
    constexpr int KSTR = DQK * 2 + 16;
    p0 = f32x16{}; p1 = f32x16{};
    const int ka = (int)(uintptr_t)Ks + r32 * KSTR + hi * 16;
    bf16x8 f0[3], f1[3];
    f0[0] = lds_rd128<0>(ka); f1[0] = lds_rd128<32 * KSTR>(ka); f0[1] = lds_rd128<32>(ka); f1[1] = lds_rd128<32 * KSTR + 32>(ka);
    QkStep<DQK, 0>::run(p0, p1, ka, qr, qx4, f0, f1);
}

__device__ __forceinline__ i32x8 lds_rd256(int addr, int off) {
    u32x4 a, b;
    asm volatile("ds_read_b128 %0, %2\n\tds_read_b128 %1, %2 offset:16" : "=&v"(a), "=&v"(b) : "v"(addr + off) : "memory");
    return (i32x8){(int)a.x, (int)a.y, (int)a.z, (int)a.w, (int)b.x, (int)b.y, (int)b.z, (int)b.w};
}
__device__ __forceinline__ void qkt8(f32x16& p0, f32x16& p1, const char* Ks, const i32x8 (&q8)[3], int r32, int hi, float init) {
#pragma unroll
    for (int r = 0; r < 16; ++r) { p0[r] = init; p1[r] = init; }
    const int ka = (int)(uintptr_t)Ks + r32 * 208 + hi * 32;
    i32x8 a0 = lds_rd256(ka, 0), b0 = lds_rd256(ka, 32 * 208), a1 = lds_rd256(ka, 64), b1 = lds_rd256(ka, 32 * 208 + 64);
    asm volatile("s_waitcnt lgkmcnt(4)" ::: "memory"); SBAR();
    p0 = __builtin_amdgcn_mfma_scale_f32_32x32x64_f8f6f4(a0, q8[0], p0, 0, 0, 0, 0x7f7f7f7f, 0, 0x7f7f7f7f);
    p1 = __builtin_amdgcn_mfma_scale_f32_32x32x64_f8f6f4(b0, q8[0], p1, 0, 0, 0, 0x7f7f7f7f, 0, 0x7f7f7f7f);
    SBAR();
    i32x8 a2 = lds_rd256(ka, 128), b2 = lds_rd256(ka, 32 * 208 + 128);
    asm volatile("s_waitcnt lgkmcnt(4)" ::: "memory"); SBAR();
    p0 = __builtin_amdgcn_mfma_scale_f32_32x32x64_f8f6f4(a1, q8[1], p0, 0, 0, 0, 0x7f7f7f7f, 0, 0x7f7f7f7f);
    p1 = __builtin_amdgcn_mfma_scale_f32_32x32x64_f8f6f4(b1, q8[1], p1, 0, 0, 0, 0x7f7f7f7f, 0, 0x7f7f7f7f);
    SBAR();
    asm volatile("s_waitcnt lgkmcnt(0)" ::: "memory"); SBAR();
    p0 = __builtin_amdgcn_mfma_scale_f32_32x32x64_f8f6f4(a2, q8[2], p0, 0, 0, 0, 0x7f7f7f7f, 0, 0x7f7f7f7f);
    p1 = __builtin_amdgcn_mfma_scale_f32_32x32x64_f8f6f4(b2, q8[2], p1, 0, 0, 0, 0x7f7f7f7f, 0, 0x7f7f7f7f);
}

__device__ __forceinline__ void finishSM8(f32x16& p0, f32x16& p1, float alpha, float& l_reg, i32x8& p8) {
#pragma unroll
    for (int r = 0; r < 16; ++r) p1[r] = __builtin_amdgcn_exp2f(p1[r]);
    float ps = 0;
#pragma unroll
    for (int r = 0; r < 16; ++r) ps += p0[r];
#pragma unroll
    for (int r = 0; r < 16; ++r) ps += p1[r];
    { auto rr = __builtin_amdgcn_permlane32_swap(__float_as_uint(ps), __float_as_uint(ps), false, false);
      ps = __uint_as_float(rr[0]) + __uint_as_float(rr[1]); }
    l_reg = l_reg * alpha + ps;
#pragma unroll
    for (int w = 0; w < 4; ++w) { int lo = 0, hi_ = 0;
        lo = __builtin_amdgcn_cvt_pk_fp8_f32(p0[4 * w], p0[4 * w + 1], lo, false); lo = __builtin_amdgcn_cvt_pk_fp8_f32(p0[4 * w + 2], p0[4 * w + 3], lo, true);
        hi_ = __builtin_amdgcn_cvt_pk_fp8_f32(p1[4 * w], p1[4 * w + 1], hi_, false); hi_ = __builtin_amdgcn_cvt_pk_fp8_f32(p1[4 * w + 2], p1[4 * w + 3], hi_, true);
        p8[w] = lo; p8[4 + w] = hi_; }
}
__device__ __forceinline__ void softmax8(f32x16& p0, f32x16& p1, float& m_reg, float& alpha, bool first, float& l_reg, i32x8& p8) {
    alpha = 1.f; float ps = 0.f; bool slow = false;
    if (!first) {
#pragma unroll
        for (int r = 0; r < 16; ++r) { p0[r] = __builtin_amdgcn_exp2f(p0[r]); p1[r] = __builtin_amdgcn_exp2f(p1[r]); }
#pragma unroll
        for (int r = 0; r < 16; ++r) ps += p0[r];
#pragma unroll
        for (int r = 0; r < 16; ++r) ps += p1[r];
        slow = __any(!(ps <= 256.f));
        if (__builtin_expect(slow, 0)) {
#pragma unroll
            for (int r = 0; r < 16; ++r) { p0[r] = __builtin_amdgcn_logf(p0[r]); p1[r] = __builtin_amdgcn_logf(p1[r]); }
        }
    }
    if (__builtin_expect(first || slow, 0)) {
        float pmax = p0[0];
#pragma unroll
        for (int r = 1; r < 16; ++r) pmax = fmaxf(pmax, p0[r]);
#pragma unroll
        for (int r = 0; r < 16; ++r) pmax = fmaxf(pmax, p1[r]);
        { auto rr = __builtin_amdgcn_permlane32_swap(__float_as_uint(pmax), __float_as_uint(pmax), false, false);
          pmax = fmaxf(__uint_as_float(rr[0]), __uint_as_float(rr[1])); }
        const float d = first ? pmax : fmaxf(pmax, 0.f); alpha = first ? 0.f : __builtin_amdgcn_exp2f(-d); m_reg += d;
        ps = 0.f;
#pragma unroll
        for (int r = 0; r < 16; ++r) { p0[r] = __builtin_amdgcn_exp2f(p0[r] - d); p1[r] = __builtin_amdgcn_exp2f(p1[r] - d); }
#pragma unroll
        for (int r = 0; r < 16; ++r) ps += p0[r];
#pragma unroll
        for (int r = 0; r < 16; ++r) ps += p1[r];
    }
    l_reg = l_reg * alpha + ps;
#pragma unroll
    for (int w = 0; w < 4; ++w) { int lo = 0, hi_ = 0;
        lo = __builtin_amdgcn_cvt_pk_fp8_f32(p0[4 * w], p0[4 * w + 1], lo, false); lo = __builtin_amdgcn_cvt_pk_fp8_f32(p0[4 * w + 2], p0[4 * w + 3], lo, true);
        hi_ = __builtin_amdgcn_cvt_pk_fp8_f32(p1[4 * w], p1[4 * w + 1], hi_, false); hi_ = __builtin_amdgcn_cvt_pk_fp8_f32(p1[4 * w + 2], p1[4 * w + 3], hi_, true);
        p8[w] = lo; p8[4 + w] = hi_; }
}
__device__ __forceinline__ void pv8(f32x16* o, const char* Vs, const i32x8& p8, int r32, int hi) {
    const int va = (int)(uintptr_t)Vs + r32 * 80 + hi * 32;
    i32x8 b0 = lds_rd256(va, 0), b1 = lds_rd256(va, 32 * 80), b2 = lds_rd256(va, 64 * 80), b3 = lds_rd256(va, 96 * 80);
    asm volatile("s_waitcnt lgkmcnt(6)" ::: "memory"); SBAR();
    o[0] = __builtin_amdgcn_mfma_scale_f32_32x32x64_f8f6f4(p8, b0, o[0], 0, 0, 0, 0x7f7f7f7f, 0, 0x7f7f7f7f); SBAR();
    asm volatile("s_waitcnt lgkmcnt(4)" ::: "memory"); SBAR();
    o[1] = __builtin_amdgcn_mfma_scale_f32_32x32x64_f8f6f4(p8, b1, o[1], 0, 0, 0, 0x7f7f7f7f, 0, 0x7f7f7f7f); SBAR();
    asm volatile("s_waitcnt lgkmcnt(2)" ::: "memory"); SBAR();
    o[2] = __builtin_amdgcn_mfma_scale_f32_32x32x64_f8f6f4(p8, b2, o[2], 0, 0, 0, 0x7f7f7f7f, 0, 0x7f7f7f7f); SBAR();
    asm volatile("s_waitcnt lgkmcnt(0)" ::: "memory"); SBAR();
    o[3] = __builtin_amdgcn_mfma_scale_f32_32x32x64_f8f6f4(p8, b3, o[3], 0, 0, 0, 0x7f7f7f7f, 0, 0x7f7f7f7f);
}
struct VFrag { s16x4 l0, h0, l1, h1, l2, h2, l3, h3; };
template <int D0> __device__ __forceinline__ void pv_rd(VFrag& f, int vb) {
    f.l0 = tr_read<v_rd_off(D0, 0, 0)>(vb); f.h0 = tr_read<v_rd_off(D0, 0, 1)>(vb); f.l1 = tr_read<v_rd_off(D0, 1, 0)>(vb); f.h1 = tr_read<v_rd_off(D0, 1, 1)>(vb);
    f.l2 = tr_read<v_rd_off(D0, 2, 0)>(vb); f.h2 = tr_read<v_rd_off(D0, 2, 1)>(vb); f.l3 = tr_read<v_rd_off(D0, 3, 0)>(vb); f.h3 = tr_read<v_rd_off(D0, 3, 1)>(vb);
}
__device__ __forceinline__ void pv_mm(f32x16& od, const VFrag& f, bf16x8 pa0, bf16x8 pa1, bf16x8 pa2, bf16x8 pa3) {
#define PK(L, H) (bf16x8){L[0], L[1], L[2], L[3], H[0], H[1], H[2], H[3]}
    od = __builtin_amdgcn_mfma_f32_32x32x16_bf16(pa0, PK(f.l0, f.h0), od, 0, 0, 0);
    od = __builtin_amdgcn_mfma_f32_32x32x16_bf16(pa1, PK(f.l1, f.h1), od, 0, 0, 0);
    od = __builtin_amdgcn_mfma_f32_32x32x16_bf16(pa2, PK(f.l2, f.h2), od, 0, 0, 0);
    od = __builtin_amdgcn_mfma_f32_32x32x16_bf16(pa3, PK(f.l3, f.h3), od, 0, 0, 0);
#undef PK
}
__device__ __forceinline__ void pv2(f32x16* o, int vb, bf16x8 pa0, bf16x8 pa1, bf16x8 pa2, bf16x8 pa3) {
    VFrag fa, fb;
    pv_rd<0>(fa, vb);
    pv_rd<1>(fb, vb); asm volatile("s_waitcnt lgkmcnt(8)" ::: "memory"); SBAR(); pv_mm(o[0], fa, pa0, pa1, pa2, pa3); SBAR();
    pv_rd<2>(fa, vb); asm volatile("s_waitcnt lgkmcnt(8)" ::: "memory"); SBAR(); pv_mm(o[1], fb, pa0, pa1, pa2, pa3); SBAR();
    pv_rd<3>(fb, vb); asm volatile("s_waitcnt lgkmcnt(8)" ::: "memory"); SBAR(); pv_mm(o[2], fa, pa0, pa1, pa2, pa3); SBAR();
    asm volatile("s_waitcnt lgkmcnt(0)" ::: "memory"); SBAR(); pv_mm(o[3], fb, pa0, pa1, pa2, pa3);
}

template <int DQK, bool NA>
__device__ __forceinline__ void attn_body2(const bf16_t* __restrict__ Qb, const bf16_t* __restrict__ Kh, const bf16_t* __restrict__ Krope, const bf16_t* __restrict__ Vh,
                                           bf16_t* __restrict__ Ob, int NT, int u0, int qrow0, const float* __restrict__ bias_h, char* lds, float* diag_out = nullptr) {
    using L = Lds<DQK>;
    constexpr int SHM_V = L::SHM_V, SHM_K = L::SHM_K;
    const int tid = ltid(), wid = tid >> 6, lane = tid & 63, r32 = lane & 31, hi = lane >> 5;
    char* V_lds = lds; char* K_lds = lds + L::OFF_K;
    float* ws = (float*)(lds + L::OFF_WS) + wid * 64; float* li_l = ws; float* al_l = ws + 32;
    float* bt = (float*)(lds + L::OFF_BT);
    __syncthreads();
    if constexpr (NA) { if (tid < 15 * 31) bt[48 + (tid / 31) * 32 + (tid % 31)] = bias_h[tid] * LOG2E; }
    constexpr bool F8 = MLA_FP8 && DQK == 192;
    float m_reg = F8 ? 0.f : -1e30f, l_reg = 0; f32x16 o[4] = {}; bf16x8 qr[8];
    const bf16_t* Qw = Qb + (size_t)(wid * QBLK + r32) * DQK + hi * 8;
    bf16x8 qx4[4]; i32x8 q8[3];
    if constexpr (F8) {
        const unsigned char* Q8 = (const unsigned char*)Qb + (size_t)(wid * QBLK + r32) * 192 + hi * 32;
#pragma unroll
        for (int c = 0; c < 3; ++c) { const u32x4 a_ = *(const u32x4*)(Q8 + c * 64), b_ = *(const u32x4*)(Q8 + c * 64 + 16);
            q8[c] = (i32x8){(int)a_.x, (int)a_.y, (int)a_.z, (int)a_.w, (int)b_.x, (int)b_.y, (int)b_.z, (int)b_.w}; }
    } else {
#pragma unroll
    for (int d0 = 0; d0 < 8; ++d0) qr[d0] = *reinterpret_cast<const bf16x8*>(Qw + d0 * 16);
    if constexpr (DQK == 192) {
#pragma unroll
        for (int d0 = 8; d0 < 12; ++d0) qx4[d0 - 8] = *reinterpret_cast<const bf16x8*>(Qw + d0 * 16);
    } else { qx4[0] = qr[0]; qx4[1] = qr[0]; qx4[2] = qr[0]; qx4[3] = qr[0]; }
    }
    const int sr = tid >> 4, sc = (tid & 15) * 8, vst0 = v_st(sr, sc), vst1 = v_st(32 + sr, sc);
    const int rr_ = tid >> 3, rc_ = (tid & 7) * 8;
    const unsigned offKV = (unsigned)(sr * 128 + sc) * 2u, offR = (unsigned)(rr_ * 64 + rc_) * 2u;
    const int vb0 = (int)(uintptr_t)V_lds + v_rd_base(lane);
    const int rq = NA ? (wid >> 1) : 0;
    const int cq = 32 * (wid & 1) + r32;
    const int cs = cq < 8 ? 0 : (cq > 56 ? 48 : cq - 8);
    struct { bf16x8 vs0, vs1, ks0, ks1, kr; } st;
    const unsigned off8n = (unsigned)((tid >> 3) * 128 + (tid & 7) * 16), off8r = (unsigned)(((tid & 255) >> 2) * 64 + (tid & 3) * 16);
    const int lds8n = (tid >> 3) * 208 + (tid & 7) * 16, lds8r = ((tid & 255) >> 2) * 208 + 128 + (tid & 3) * 16;
    auto keyof = [&](int t) -> int { if constexpr (!NA) return t * KVBLK; else { if (t < 4) return t * KVBLK; int kr = u0 + t - 4; kr = kr > 255 ? 255 : kr; return NCTX + kr * KVBLK; } };
#define SLOAD2(s_) do { const int sk_ = (s_) < NT ? (s_) : NT - 1, sv_ = ATT_SPLIT ? sk_ : ((s_) > 0 ? ((s_) <= NT ? (s_) - 1 : NT - 1) : 0); \
    const size_t kk_ = (size_t)__builtin_amdgcn_readfirstlane(keyof(sk_)), kv_ = (size_t)__builtin_amdgcn_readfirstlane(keyof(sv_)); \
    const char* vp_ = (const char*)Vh + kv_ * 256; const char* kp_ = (const char*)Kh + kk_ * 256; \
    int tl_ = tid; asm volatile("" : "+v"(tl_));         \
    if constexpr (F8) st.vs0 = *(const bf16x8*)((const char*)Vh + (kv_ >> 6) * 8192 + tl_ * 16); else { st.vs0 = *(const bf16x8*)(vp_ + offKV); st.vs1 = *(const bf16x8*)(vp_ + offKV + 8192u); } \
    if constexpr (F8) { st.ks0 = *(const bf16x8*)((const char*)Kh + kk_ * 128 + (unsigned)((tl_ >> 3) * 128 + (tl_ & 7) * 16)); if (wid < 4) st.kr = *(const bf16x8*)((const char*)Krope + kk_ * 64 + (unsigned)(((tl_ & 255) >> 2) * 64 + (tl_ & 3) * 16)); } else { \
    st.ks0 = *(const bf16x8*)(kp_ + offKV); st.ks1 = *(const bf16x8*)(kp_ + offKV + 8192u); \
    if constexpr (DQK == 192) st.kr = *(const bf16x8*)((const char*)Krope + kk_ * 128 + offR); } } while (0)
#define SWRITE2(s_) do { const int b_ = (s_) & 1; int tw_ = tid; asm volatile("" : "+v"(tw_)); if constexpr (F8) *(bf16x8*)(V_lds + b_ * SHM_V + (tw_ >> 2) * 80 + (tw_ & 3) * 16) = st.vs0; else { *(bf16x8*)(V_lds + b_ * SHM_V + vst0) = st.vs0; *(bf16x8*)(V_lds + b_ * SHM_V + vst1) = st.vs1; } \
    if constexpr (F8) { *(bf16x8*)(K_lds + b_ * SHM_K + (tw_ >> 3) * 208 + (tw_ & 7) * 16) = st.ks0; if (wid < 4) *(bf16x8*)(K_lds + b_ * SHM_K + ((tw_ & 255) >> 2) * 208 + 128 + (tw_ & 3) * 16) = st.kr; } else { \
    *(bf16x8*)(K_lds + b_ * SHM_K + kswz<DQK>(sr, sc * 2)) = st.ks0; *(bf16x8*)(K_lds + b_ * SHM_K + kswz<DQK>(32 + sr, sc * 2)) = st.ks1; \
    if constexpr (DQK == 192) *(bf16x8*)(K_lds + b_ * SHM_K + kswz<DQK>(rr_, 256 + rc_ * 2)) = st.kr; } } while (0)
#define RESC2(a) do { if (__any((a) < 1.f)) { if (hi == 0) al_l[r32] = (a); asm volatile("s_waitcnt lgkmcnt(0)" ::: "memory"); \
    _Pragma("unroll") for (int d = 0; d < 4; ++d) _Pragma("unroll") for (int r = 0; r < 16; ++r) o[d][r] *= al_l[crow(r, hi)]; } } while (0)
#define NAHOOK2(P0, P1, t) do { if constexpr (NA) { if ((t) >= 4) { const int kr_ = u0 + (t) - 4; const int rabs = qrow0 + rq; \
        const int rs_ = rabs < 4 ? 0 : (rabs > 252 ? 248 : rabs - 4); const bool tv = (kr_ >= rs_) && (kr_ < rs_ + 8) && (kr_ <= 255); \
        int ro = kr_ - rabs + 7; ro = ro < 0 ? 0 : (ro > 14 ? 14 : ro); \
        const float* bp = bt + 48 + ro * 32 + 15 - cq + 4 * hi; \
        _Pragma("unroll") for (int r = 0; r < 16; ++r) { const int ckc = (r & 3) + 8 * (r >> 2); const int ck0 = ckc + 4 * hi; \
            const bool v0_ = tv && ((unsigned)(ck0 - cs) < 16u), v1_ = tv && ((unsigned)(ck0 + 32 - cs) < 16u); \
            P0[r] = v0_ ? P0[r] + bp[ckc] : -1e30f; P1[r] = v1_ ? P1[r] + bp[ckc + 32] : -1e30f; } } } } while (0)
#define VBLOCK_(t, FIRST) do { if (!tvalid(t)) break; float mn_, al_; NAHOOK2(p0, p1, t); if constexpr (F8) { softmax8(p0, p1, m_reg, al_, FIRST, l_reg, p8); RESC2(al_); } else { partialSM<F8>(p0, p1, m_reg, mn_, al_); \
    RESC2(al_); finishSM(p0, p1, al_, l_reg, pa0, pa1, pa2, pa3); } } while (0)
#define VBLOCK(t) VBLOCK_(t, false)
#define VBLOCKF(t) VBLOCK_(t, true)
#define MBLOCK(i) do { const int b_ = (i) & 1; __builtin_amdgcn_s_setprio(2); if ((i) > 0 && tvalid((i) - 1)) { if constexpr (F8) pv8(o, V_lds + b_ * SHM_V, p8, r32, hi); else pv2(o, vb0 + b_ * SHM_V, pa0, pa1, pa2, pa3); } SBAR(); \
    if (PROBE_MB == 2 && !NA && (i) > 0) { const bf16x8 z_ = {0, 0, 0, 0, 0, 0, 0, 0}; pv2(o, vb0 + b_ * SHM_V, z_, z_, z_, z_); SBAR(); } \
    if ((i) < NT && tvalid(i)) { if constexpr (F8) qkt8(p0, p1, K_lds + b_ * SHM_K, q8, r32, hi, -m_reg); else qkt3<DQK>(p0, p1, K_lds + b_ * SHM_K, qr, qx4, r32, hi); } __builtin_amdgcn_s_setprio(0); } while (0)
    auto tvalid = [&](int t) -> bool { if constexpr (!NA) return true; else { if (t < 4) return true; const int kr_ = u0 + t - 4, rabs_ = qrow0 + rq;
        const int rs_ = rabs_ < 4 ? 0 : (rabs_ > 252 ? 248 : rabs_ - 4); return (kr_ >= rs_) && (kr_ < rs_ + 8) && (kr_ <= 255); } };
    f32x16 p0, p1; bf16x8 pa0, pa1, pa2, pa3; i32x8 p8 = {0, 0, 0, 0, 0, 0, 0, 0};
#if ATT_GRP_MODE == 1
    const int grp = __builtin_amdgcn_readfirstlane(wid >> 2);
#elif ATT_GRP_MODE == 2
    const int grp = __builtin_amdgcn_readfirstlane(wid & 1);
#elif ATT_GRP_MODE == 3
    const int grp = 0;
#else
    const int grp = wave_rank(wid);
#endif
#define ABAR2() do { asm volatile("s_waitcnt lgkmcnt(0)" ::: "memory"); __builtin_amdgcn_s_barrier(); asm volatile("" ::: "memory"); } while (0)
    SLOAD2(0); SWRITE2(0); SLOAD2(1); ABAR2();
#if ATT_DIAG
    long long tM = 0, tV = 0, tB = 0, tS = 0; const long long tStart = clock64();
#define TICK(acc, stmt) do { const long long t0_ = clock64(); stmt; acc += clock64() - t0_; } while (0)
#else
#define TICK(acc, stmt) do { stmt; } while (0)
#endif
#if ATT_SPLIT
#define QBLOCK(i) do { __builtin_amdgcn_s_setprio(2); qkt3<DQK>(p0, p1, K_lds + ((i) & 1) * SHM_K, qr, qx4, r32, hi); __builtin_amdgcn_s_setprio(0); } while (0)
#define PBLOCK(i) do { VBLOCK(i); SBAR(); pv2(o, vb0 + ((i) & 1) * SHM_V, pa0, pa1, pa2, pa3); } while (0)
    if (grp == 0) {
        for (int i = 0; i < NT; ++i) {
            SBAR(); QBLOCK(i); SBAR();
            ABAR2();
            SWRITE2(i + 1); SLOAD2(i + 2); SBAR();
            PBLOCK(i); SBAR();
            ABAR2();
        }
    } else {
        for (int i = 0; i < NT; ++i) {
            SBAR(); if (i > 0) PBLOCK(i - 1); SBAR();
            ABAR2();
            SWRITE2(i + 1); SLOAD2(i + 2); SBAR();
            QBLOCK(i); SBAR();
            ABAR2();
        }
        SBAR(); PBLOCK(NT - 1);
    }
#undef QBLOCK
#undef PBLOCK
#else
#define G0_ITER(i, VB) do { SBAR(); TICK(tM, MBLOCK(i)); SBAR(); TICK(tB, ABAR2()); TICK(tS, SWRITE2((i) + 1); SLOAD2((i) + 2)); SBAR(); TICK(tV, VB(i)); SBAR(); TICK(tB, ABAR2()); } while (0)
#define G1_ITER(i, VBM1) do { SBAR(); VBM1; SBAR(); TICK(tB, ABAR2()); TICK(tS, SWRITE2((i) + 1); SLOAD2((i) + 2)); SBAR(); TICK(tM, MBLOCK(i)); SBAR(); TICK(tB, ABAR2()); } while (0)
    if (grp == 0) {
        G0_ITER(0, VBLOCKF);
        for (int i = 1; i < NT; ++i) G0_ITER(i, VBLOCK);
        SBAR(); MBLOCK(NT); SBAR();
        ABAR2();
    } else {
        G1_ITER(0, (void)0);
        G1_ITER(1, VBLOCKF(0));
        for (int i = 2; i < NT; ++i) G1_ITER(i, TICK(tV, VBLOCK(i - 1)));
        SBAR(); VBLOCK(NT - 1); SBAR();
        ABAR2();
        MBLOCK(NT);
    }
#undef G0_ITER
#undef G1_ITER
#endif
#if ATT_DIAG
    if (!NA && blockIdx.x == 7 && lane == 0 && (wid == 0 || wid == 4)) { float* dg = diag_out + (wid >> 2) * 8; const float inv = 1.f / (float)NT;
        dg[0] = (float)tM * inv; dg[1] = (float)tV * inv; dg[2] = (float)tB * inv; dg[3] = (float)tS * inv; dg[4] = (float)(clock64() - tStart) * inv; }
#endif
    if constexpr (F8) { auto rr = __builtin_amdgcn_permlane32_swap(__float_as_uint(l_reg), __float_as_uint(l_reg), false, false);
        l_reg = __uint_as_float(rr[0]) + __uint_as_float(rr[1]); }
    if (hi == 0) li_l[r32] = l_reg; asm volatile("s_waitcnt lgkmcnt(0)" ::: "memory");
    float rli[16];
#pragma unroll
    for (int r = 0; r < 16; ++r) rli[r] = __builtin_amdgcn_rcpf(li_l[crow(r, hi)]);
    bf16_t* Ow = Ob + (size_t)(wid * QBLK) * DM;
#pragma unroll
    for (int r = 0; r < 16; ++r) { const int orow = crow(r, hi);
#pragma unroll
        for (int d0 = 0; d0 < 4; ++d0) {
#if ATTG_FP8
            ((unsigned char*)Ob)[(size_t)(wid * QBLK + orow) * DM + d0 * 32 + r32] = (unsigned char)(__builtin_amdgcn_cvt_pk_fp8_f32(o[d0][r] * rli[r] * 64.f, 0.f, 0, false) & 0xff);
#else
            Ow[(size_t)orow * DM + d0 * 32 + r32] = f2bf(o[d0][r] * rli[r]);
#endif
        } }
#undef TICK
#undef SLOAD2
#undef SWRITE2
#undef RESC2
#undef NAHOOK2
#undef VBLOCK
#undef MBLOCK
}
}

#define WSP(T, off) ((T*)(p.ws + (off)))
constexpr float TWO_PI = 6.283185307179586f;

constexpr int P0_ADA = 112, P0_TAB = 72;
constexpr int P0_SLOW_WIN = 64 * 32, P0_SLOW_WUQ = 24 * 8, P0_SLOW_WUKV = 32 * 4;
constexpr int P0_SLOW = P0_SLOW_WIN + P0_SLOW_WUQ + P0_SLOW_WUKV;
constexpr int P0_FAST_SQ = 64;
constexpr int P0_FAST_GU = 2 * NE * 32 * 4, P0_FAST_D = 2 * NE * 16 * 4;
constexpr int P0_DEF = (PREP_DEFER && MOE2_FP8) ? P0_FAST_D : 0;
constexpr int P0_DEFG = (PREP_DEFER && MOE1_FP8 && MOE2_FP8 && CONV_CUS > 0) ? P0_FAST_GU / 2 : 0;
constexpr int P0_FAST = 2 * P0_FAST_SQ + P0_FAST_GU + P0_FAST_D - P0_DEF - 2 * P0_DEFG;
constexpr int QW_GU = 42, QW_DONE_MOE1 = 44, QW_DONE_INPROJ = 45, QW_DONE_UP = 46, QW_DONE_ATTN = 47, QW_DONE_MOE2 = 48;
constexpr int P0_UNITS = P0_ADA + P0_FAST + P0_SLOW + P0_TAB;
constexpr size_t OFF_QCTR = 14336;

__device__ __forceinline__ int rope_src(int jj) { const int pp = jj >> 1, wh = jj & 1; return (pp < 16 ? 0 : 32) + (pp & 15) + 16 * wh; }

__device__ __forceinline__ void p0_slow_tile8(const float* src, int lds_, const float* scale, float mul, unsigned char* dst, int K, int n0, int k0, int tid) {
    const int kg = tid >> 6, k = k0 + kg * 8;
    f32x4 a, b;
#pragma unroll
    for (int i = 0; i < 4; ++i) { a[i] = src ? src[(size_t)(k + i) * lds_] * (scale ? scale[k + i] : 1.f) : 0.f; b[i] = src ? src[(size_t)(k + 4 + i) * lds_] * (scale ? scale[k + 4 + i] : 1.f) : 0.f; }
    *(u32x2*)(dst + (size_t)(n0 + (tid & 63)) * K + k) = pack8_fp8(a, b, mul);
}
__device__ __forceinline__ void p0_slow_tile(const float* src, int lds_, const float* scale, bf16_t* dst, int K, int n0, int k0, int tid) {
    const int kg = tid >> 6, k = k0 + kg * 8;
    float v[8];
#pragma unroll
    for (int i = 0; i < 8; ++i) v[i] = src ? src[(size_t)(k + i) * lds_] * (scale ? scale[k + i] : 1.f) : 0.f;
    u32x4 w; w.x = cvtpk(v[0], v[1]); w.y = cvtpk(v[2], v[3]); w.z = cvtpk(v[4], v[5]); w.w = cvtpk(v[6], v[7]);
    *(u32x4*)(dst + (size_t)(n0 + (tid & 63)) * K + k) = w;
}
__device__ __forceinline__ void p0_fast_tile(const float* src, int lds_, bf16_t* dst, int K, int tid) {
    const int n4 = tid & 31, kg = tid >> 5;
    f32x4 v[4][8];
#pragma unroll
    for (int sb = 0; sb < 4; ++sb)
#pragma unroll
        for (int i = 0; i < 8; ++i) v[sb][i] = __builtin_nontemporal_load((const f32x4*)(src + (size_t)(sb * 128 + kg * 8 + i) * lds_ + n4 * 4));
#pragma unroll
    for (int sb = 0; sb < 4; ++sb)
#pragma unroll
        for (int j = 0; j < 4; ++j) {
            u32x4 w; w.x = cvtpk(v[sb][0][j], v[sb][1][j]); w.y = cvtpk(v[sb][2][j], v[sb][3][j]); w.z = cvtpk(v[sb][4][j], v[sb][5][j]); w.w = cvtpk(v[sb][6][j], v[sb][7][j]);
            *(u32x4*)(dst + (size_t)(n4 * 4 + j) * K + sb * 128 + kg * 8) = w;
        }
}

__device__ __forceinline__ void p0_fast_tile8(const float* src, int lds_, unsigned char* dst, int K, int hi128, int tid) {
    const int n4 = tid & 63, kg = tid >> 6;
    f32x4 v[32];
#pragma unroll
    for (int i = 0; i < 32; ++i) v[i] = __builtin_nontemporal_load((const f32x4*)(src + (size_t)(kg * 32 + i) * lds_ + n4 * 4));
#pragma unroll
    for (int j = 0; j < 4; ++j) {
        u32x4 w[2];
#pragma unroll
        for (int q = 0; q < 8; ++q) { int x = 0;
            x = __builtin_amdgcn_cvt_pk_fp8_f32(v[4 * q][j] * 32.f, v[4 * q + 1][j] * 32.f, x, false); x = __builtin_amdgcn_cvt_pk_fp8_f32(v[4 * q + 2][j] * 32.f, v[4 * q + 3][j] * 32.f, x, true);
            w[q >> 2][q & 3] = (unsigned)x; }
        const int n = n4 * 4 + j;
        unsigned char* d = dst + (size_t)(n + (n >> 7) * hi128) * K + kg * 32;
        *(u32x4*)d = w[0]; *(u32x4*)(d + 16) = w[1];
    }
}
__device__ __forceinline__ void phase_prep(const Params& p, char* smem) {
    const int tid0 = ltid();
    float* sl = (float*)smem;
    volatile int* qslot = (volatile int*)(smem + 16384);
    volatile int* pass_ = (volatile int*)(g_smem + LDS_WTAB) + 64;
    unsigned* qctr = (unsigned*)(p.ws + OFF_QCTR) + *pass_ * 64;
    for (;;) {
        asm volatile("s_waitcnt lgkmcnt(0)" ::: "memory"); __builtin_amdgcn_s_barrier();
        if (tid0 == 0) *qslot = (int)__hip_atomic_fetch_add(qctr, 1u, __ATOMIC_RELAXED, __HIP_MEMORY_SCOPE_AGENT);
        asm volatile("s_waitcnt lgkmcnt(0)" ::: "memory"); __builtin_amdgcn_s_barrier();
        const int u = *qslot;
        if (u >= P0_UNITS) { if (tid0 == 0) *pass_ = *pass_ + 1; break; }
        int tid = tid0; asm volatile("" : "+v"(tid));
        const int wid = tid >> 6, lane = tid & 63;
        if (u < P0_ADA) {
            const bool isctx = u >= 96; const int layer = (u >= 48 && u < 96) ? 1 : 0; const int j0 = isctx ? (u - 96) * 256 : (u % 48) * 256;
            const float* cv = isctx ? p.c_ctx : p.c; const float* W = p.ada_w + (size_t)layer * DM * 12288;
            for (int k = tid; k < DM; k += NTHR) { const float v = cv[k]; sl[k] = v / (1.f + expf(-v)); }
            __syncthreads();
            f32x4 acc = {0.f, 0.f, 0.f, 0.f};
            const float* wp = W + (size_t)(wid * 256) * 12288 + j0 + lane * 4;
#pragma unroll 16
            for (int k = 0; k < 256; ++k) { const f32x4 w = __builtin_nontemporal_load((const f32x4*)(wp + (size_t)k * 12288)); const float s_ = sl[wid * 256 + k]; acc += w * s_; }
            float* red = sl + 2048;
            *(f32x4*)(red + wid * 256 + lane * 4) = acc;
            __syncthreads();
            if (tid < 256) { float s_ = 0.f;
#pragma unroll
                for (int w = 0; w < 8; ++w) s_ += red[w * 256 + tid];
                s_ += p.ada_b[(size_t)layer * 12288 + j0 + tid];
                float* dst = isctx ? WSP(float, OFF_ADA) + 2 * 12288 : WSP(float, OFF_ADA) + layer * 12288;
                dst[j0 + tid] = s_; }
        } else if (u < P0_ADA + P0_FAST) {
            int s_ = u - P0_ADA;
            const float* src_; int ld_; unsigned char* dst8_; int K_, hi_; bool f8_;
            if (s_ < 2 * P0_FAST_SQ) {
                const bool attn_ = s_ < P0_FAST_SQ; const float* W = attn_ ? p.w_out_attn : p.w_out_fourier;
                s_ &= 63; f8_ = ATTG_FP8 && attn_;
                const int n0 = f8_ ? (s_ >> 3) * 256 : (s_ >> 2) * 128, k0 = f8_ ? (s_ & 7) * 256 : (s_ & 3) * 512;
                src_ = W + (size_t)k0 * DM + n0; ld_ = DM; K_ = DM; hi_ = 0;
                dst8_ = WSP(unsigned char, attn_ ? OFF_WOUT : OFF_WFOUT) + ((size_t)n0 * DM + k0) * (f8_ ? 1 : 2);
            } else if (s_ < 2 * P0_FAST_SQ + P0_FAST_GU) {
                s_ -= 2 * P0_FAST_SQ; const int le = s_ >> 7, t = s_ & 127;
                const float* Wg = p.w_gate + (size_t)le * DM * FF; const float* Wu = p.w_up + (size_t)le * DM * FF;
#if MOE1_FP8
                const int bj = t >> 6, q = (t >> 3) & 7, k0 = (t & 7) * 256;
                f8_ = true; src_ = (bj ? Wu : Wg) + (size_t)k0 * FF + q * 256; ld_ = FF; K_ = DM; hi_ = 128;
                dst8_ = WSP(unsigned char, OFF_WGU) + ((size_t)le * 4096 + 512 * q + 128 * bj) * DM + k0;
#else
                const int nt_ = t >> 2, k0 = (t & 3) * 512, pn = nt_ >> 1, bj = nt_ & 1;
                f8_ = false; src_ = (bj ? Wu : Wg) + (size_t)k0 * FF + pn * 128; ld_ = FF; K_ = DM; hi_ = 0;
                dst8_ = WSP(unsigned char, OFF_WGU) + (((size_t)le * 4096 + nt_ * 128) * DM + k0) * 2;
#endif
            } else {
                s_ -= 2 * P0_FAST_SQ + P0_FAST_GU; const int le = s_ >> 6, t = s_ & 63;
                const int n0 = MOE2_FP8 ? (t >> 3) * 256 : (t >> 2) * 128, k0 = MOE2_FP8 ? (t & 7) * 256 : (t & 3) * 512;
                const float* W = p.w_down + (size_t)le * FF * DM;
                f8_ = MOE2_FP8; src_ = W + (size_t)k0 * DM + n0; ld_ = DM; K_ = FF; hi_ = 0;
                dst8_ = WSP(unsigned char, OFF_WD) + (((size_t)le * 2048 + n0) * FF + k0) * (MOE2_FP8 ? 1 : 2);
            }
            if (f8_) p0_fast_tile8(src_, ld_, dst8_, K_, hi_, tid); else p0_fast_tile(src_, ld_, (bf16_t*)dst8_, K_, tid);
        } else if (u < P0_ADA + P0_FAST + P0_SLOW) {
            int s_ = u - P0_ADA - P0_FAST;
            if (s_ < P0_SLOW_WIN) {
                const int n0 = (s_ >> 5) * 64, k0 = (s_ & 31) * 64, n = n0 + (tid & 63);
                int col;
                if (n < 768) col = n; else if (n < 1792) col = 832 + (n - 768); else if (n < 2816) col = 1856 + (n - 1792); else if (n < 3840) col = 2880 + (n - 2816);
                else if (n < 3904) col = 768 + rope_src(n - 3840); else col = -1;
#if ATTG_FP8
                p0_slow_tile8(col >= 0 ? p.w_in + col : nullptr, INW, nullptr, 32.f, WSP(unsigned char, OFF_WIN), DM, n0, k0, tid);
#else
                p0_slow_tile(col >= 0 ? p.w_in + col : nullptr, INW, nullptr, WSP(bf16_t, OFF_WIN), DM, n0, k0, tid);
#endif
            } else if (s_ < P0_SLOW_WIN + P0_SLOW_WUQ) {
                s_ -= P0_SLOW_WIN; const int n0 = (s_ >> 3) * 64, k0 = (s_ & 7) * 64, n = n0 + (tid & 63);
                int col; if (n < 1024) col = (n >> 7) * 192 + (n & 127); else { const int j = n - 1024; col = (j >> 6) * 192 + 128 + rope_src(j & 63); }
#if ATTG_FP8
                p0_slow_tile8(p.w_uq + col, 1536, p.g_qn, 16.f, WSP(unsigned char, OFF_WUQ), 512, n0, k0, tid);
#else
                p0_slow_tile(p.w_uq + col, 1536, p.g_qn, WSP(bf16_t, OFF_WUQ), 512, n0, k0, tid);
#endif
            } else {
                s_ -= P0_SLOW_WIN + P0_SLOW_WUQ; const int n0 = (s_ >> 2) * 64, k0 = (s_ & 3) * 64, n = n0 + (tid & 63);
                const int col = n < 1024 ? (n >> 7) * 256 + (n & 127) : ((n - 1024) >> 7) * 256 + 128 + (n & 127);
#if ATTG_FP8
                p0_slow_tile8(p.w_ukv + col, 2048, p.g_kvn, 16.f, WSP(unsigned char, OFF_WUKV), 256, n0, k0, tid);
#else
                p0_slow_tile(p.w_ukv + col, 2048, p.g_kvn, WSP(bf16_t, OFF_WUKV), 256, n0, k0, tid);
#endif
            }
        } else {
            const int base = (u - P0_ADA - P0_FAST - P0_SLOW) * 4096;
            for (int e = base + tid; e < base + 4096; e += NTHR) {
                if (e < 4096) { const int pos = e >> 4, i = e & 15; const float inv = powf(10000.f, -(float)i / 16.f); const float a = (float)pos * inv;
                    float* d = WSP(float, OFF_ROPE) + e * 2; d[0] = cosf(a); d[1] = sinf(a); }
                else if (e < 4096 + 16384) { const int q = e - 4096, k1 = q >> 7, b = q & 127; float s, c; sincospif((float)(k1 * b) / 8192.f, &s, &c);
                    float* d = WSP(float, OFF_TW) + q * 2; d[0] = c; d[1] = s; }
                else if (e < 4096 + 16384 + 131072) { const int q = e - 20480, row = q >> 8, cc = q & 255, ri = row >> 8, m = row & 255; float s, c; sincospif((float)((m * cc) & 255) / 128.f, &s, &c);
                    WSP(bf16_t, OFF_DFT1)[q] = f2bf(ri == 0 ? c * 0.0625f : -s * 0.0625f); }
                else if (e < 4096 + 16384 + 131072 + 65536) { const int q = e - 151552, row = q >> 8, col = q & 255, rip = row >> 7, k1 = row & 127, ri = col >> 7, a = col & 127;
                    float s, c; sincospif((float)((k1 * a) & 127) / 64.f, &s, &c); const float sc_ = 0.08838834764831845f; c *= sc_; s *= sc_;
                    const float v = (rip == ri) ? c : (rip == 0 ? s : -s);
                    WSP(bf16_t, OFF_WA)[q] = f2bf(v); }
                else if (e < 4096 + 16384 + 131072 + 131072) { const int q = e - 217088, row = q >> 8, col = q & 255, ri = col >> 7, b = col & 127;
                    float v = 0.f; if (row < 128) { float s, c; sincospif((float)((row * b) & 127) / 64.f, &s, &c); v = (ri == 0 ? c : s) * 0.08838834764831845f; }
                    WSP(bf16_t, OFF_WB)[q] = f2bf(v); }
            }
        }
    }
}

__device__ __forceinline__ void prep_deferred(const Params& p, char* smem, int which, int lo, int hi, int doneword = 0, int stopv = 0) {
    const int tid0 = ltid();
    volatile int* qslot = (volatile int*)(smem + 16384);
    unsigned* dctr = (unsigned*)(p.ws + OFF_QCTR) + 40 + which;
    for (;;) {
        asm volatile("s_waitcnt lgkmcnt(0)" ::: "memory"); __builtin_amdgcn_s_barrier();
        if (tid0 == 0) { int v_ = hi;
            if (!(stopv > 0 && (int)__hip_atomic_load((unsigned*)(p.ws + OFF_QCTR) + doneword, __ATOMIC_RELAXED, __HIP_MEMORY_SCOPE_AGENT) >= stopv)) v_ = lo + (int)__hip_atomic_fetch_add(dctr, 1u, __ATOMIC_RELAXED, __HIP_MEMORY_SCOPE_AGENT);
            *qslot = v_; }
        asm volatile("s_waitcnt lgkmcnt(0)" ::: "memory"); __builtin_amdgcn_s_barrier();
        const int d = *qslot;
        if (d >= hi) break;
        int tid = tid0; asm volatile("" : "+v"(tid));
        const int le = d >> 6, t = d & 63, n0 = (t >> 3) * 256, k0 = (t & 7) * 256;
        const float* W = p.w_down + (size_t)le * FF * DM;
        p0_fast_tile8(W + (size_t)k0 * DM + n0, DM, WSP(unsigned char, OFF_WD) + ((size_t)le * 2048 + n0) * FF + k0, FF, 0, tid);
    }
}

__device__ __forceinline__ void prep_deferred_gu(const Params& p, char* smem, int layer, int doneword, int stopv) {
    const int tid0 = ltid();
    volatile int* qslot = (volatile int*)(smem + 16384);
    unsigned* dctr = (unsigned*)(p.ws + OFF_QCTR) + QW_GU + layer; unsigned* done = (unsigned*)(p.ws + OFF_QCTR) + doneword;
    for (;;) {
        asm volatile("s_waitcnt lgkmcnt(0)" ::: "memory"); __builtin_amdgcn_s_barrier();
        if (tid0 == 0) { int v_ = P0_DEFG;
            if (!(stopv > 0 && (int)__hip_atomic_load(done, __ATOMIC_RELAXED, __HIP_MEMORY_SCOPE_AGENT) >= stopv)) v_ = (int)__hip_atomic_fetch_add(dctr, 1u, __ATOMIC_RELAXED, __HIP_MEMORY_SCOPE_AGENT);
            *qslot = v_; }
        asm volatile("s_waitcnt lgkmcnt(0)" ::: "memory"); __builtin_amdgcn_s_barrier();
        const int g_ = *qslot;
        if (g_ >= P0_DEFG) break;
        int tid = tid0; asm volatile("" : "+v"(tid));
        const int le = layer * NE + (g_ >> 7), t = g_ & 127, bj = t >> 6, q = (t >> 3) & 7, k0 = (t & 7) * 256;
        const float* W = (bj ? p.w_up : p.w_gate) + (size_t)le * DM * FF;
        p0_fast_tile8(W + (size_t)k0 * FF + q * 256, FF, WSP(unsigned char, OFF_WGU) + ((size_t)le * 4096 + 512 * q + 128 * bj) * DM + k0, DM, 128, tid);
    }
}
__device__ __forceinline__ void gemm_done(const Params& p, int doneword) { if (ltid() == 0) __hip_atomic_fetch_add((unsigned*)(p.ws + OFF_QCTR) + doneword, 1u, __ATOMIC_RELAXED, __HIP_MEMORY_SCOPE_AGENT); }

__device__ __forceinline__ void modulate_row(const float* __restrict__ src, const float* __restrict__ g, const float* __restrict__ sh, const float* __restrict__ sc,
                                             bf16_t* __restrict__ dst, int lane) {
    f32x4 v[8]; float ss = 0.f;
#pragma unroll
    for (int j = 0; j < 8; ++j) { v[j] = *(const f32x4*)(src + j * 256 + lane * 4); ss += v[j][0] * v[j][0] + v[j][1] * v[j][1] + v[j][2] * v[j][2] + v[j][3] * v[j][3]; }
    ss = wave_sum(ss); const float rs = rsqrtf(ss * (1.f / DM) + EPS);
#pragma unroll
    for (int j = 0; j < 8; ++j) { const int c = j * 256 + lane * 4; const f32x4 gv = *(const f32x4*)(g + c), sv = *(const f32x4*)(sc + c), hv = *(const f32x4*)(sh + c);
        const f32x4 o = v[j] * rs * gv * (sv + 1.f) + hv;
        u32x2 w; w.x = cvtpk(o[0], o[1]); w.y = cvtpk(o[2], o[3]); *(u32x2*)(dst + c) = w; }
}
__device__ __forceinline__ void phase_mod0(const Params& p) {
    const int tid = ltid(), wid = tid >> 6, lane = tid & 63;
    const float* ada = WSP(float, OFF_ADA); const float* adac = ada + 2 * 12288;
    const int bid = lbid(), nctxb = gridDim.x > 20 ? 10 : 0;
    int row, stride, rend;
    if (bid < nctxb) { row = bid + nctxb * wid; stride = nctxb * 8; rend = NCTX; }
    else { row = NCTX + (bid - nctxb) * 8 + wid; stride = (gridDim.x - nctxb) * 8; rend = NKEY; }
    if (nctxb == 0) { row = bid * 8 + wid; stride = gridDim.x * 8; rend = NKEY; }
    auto rowptr = [&](int r) -> const float* { return r < NCTX ? p.ctx + (size_t)r * DM : p.x + (size_t)(r - NCTX) * DM; };
    f32x4 v[8], vn[8], mulv[8], addv[8];
    bool ctxk = row < NCTX;
    { const float* sh = ctxk ? adac : ada; const float* sc = sh + DM;
#pragma unroll
      for (int j = 0; j < 8; ++j) { const int c = j * 256 + lane * 4; mulv[j] = *(const f32x4*)(p.g_mix + c) * (*(const f32x4*)(sc + c) + 1.f); addv[j] = *(const f32x4*)(sh + c); } }
    if (row < rend) { const float* src = rowptr(row);
#pragma unroll
        for (int j = 0; j < 8; ++j) v[j] = *(const f32x4*)(src + j * 256 + lane * 4); }
    while (row < rend) {
        const int nrow = row + stride;
        if (nrow < rend) { const float* src = rowptr(nrow);
#pragma unroll
            for (int j = 0; j < 8; ++j) vn[j] = *(const f32x4*)(src + j * 256 + lane * 4); }
        if (ctxk != (row < NCTX)) {
            ctxk = row < NCTX; const float* sh = ctxk ? adac : ada; const float* sc = sh + DM;
#pragma unroll
            for (int j = 0; j < 8; ++j) { const int c = j * 256 + lane * 4; mulv[j] = *(const f32x4*)(p.g_mix + c) * (*(const f32x4*)(sc + c) + 1.f); addv[j] = *(const f32x4*)(sh + c); } }
        float ss = 0.f;
#pragma unroll
        for (int j = 0; j < 8; ++j) ss += v[j][0] * v[j][0] + v[j][1] * v[j][1] + v[j][2] * v[j][2] + v[j][3] * v[j][3];
        ss = wave_sum(ss); const float rs = rsqrtf(ss * (1.f / DM) + EPS);
        bf16_t* dst = WSP(bf16_t, OFF_H) + (size_t)row * DM;
#pragma unroll
        for (int j = 0; j < 8; ++j) { const int c = j * 256 + lane * 4;
            const f32x4 o = v[j] * rs * mulv[j] + addv[j];
#if ATTG_FP8
            { const float o0_ = o[0], o1_ = o[1], o2_ = o[2], o3_ = o[3]; int w8; asm volatile("v_cvt_pk_fp8_f32 %0, %1, %2\n\tv_cvt_pk_fp8_f32 %0, %3, %4 op_sel:[0,0,1]" : "=&v"(w8) : "v"(o0_), "v"(o1_), "v"(o2_), "v"(o3_));
              *(int*)((unsigned char*)WSP(bf16_t, OFF_H) + (size_t)row * DM + c) = w8; } }
#else
            u32x2 w; w.x = cvtpk(o[0], o[1]); w.y = cvtpk(o[2], o[3]); *(u32x2*)(dst + c) = w; }
#endif
#pragma unroll
        for (int j = 0; j < 8; ++j) v[j] = vn[j];
        row = nrow;
    }
}

__device__ __forceinline__ void phase_router(const Params& p, int layer, const res_t* __restrict__ xin, bf16_t* __restrict__ h2, char* smem) {
    const int tid = ltid(), wid = tid >> 6, lane = tid & 63;
    constexpr int WP = DM + 4;
    float* wr = (float*)smem;
    const float* W = p.w_router + (size_t)layer * DM * NE;
    const float* ada = WSP(float, OFF_ADA) + layer * 12288; const float* g = p.g_ffn + layer * DM; const float* sh = ada + 3 * DM; const float* sc = ada + 4 * DM;
    float* aff = WSP(float, OFF_AFF);
    int* __restrict__ h8 = (int*)h2;
    constexpr int NPAIR = NTOK / 2;
    const int qstride = gridDim.x * 8;
    int q = blockIdx.x * 8 + wid;
    f32x4 mulv[8], addv[8];
#pragma unroll
    for (int j = 0; j < 8; ++j) { const int c = j * 256 + lane * 4; mulv[j] = *(const f32x4*)(g + c) * (*(const f32x4*)(sc + c) + 1.f); addv[j] = *(const f32x4*)(sh + c); }
    resraw_t na[8], nb[8];
    if (q < NPAIR) {
#pragma unroll
        for (int j = 0; j < 8; ++j) { na[j] = ldraw4(xin + (size_t)(2 * q) * DM + j * 256 + lane * 4); nb[j] = ldraw4(xin + (size_t)(2 * q + 1) * DM + j * 256 + lane * 4); } }
    asm volatile("s_waitcnt lgkmcnt(0)" ::: "memory"); __builtin_amdgcn_s_barrier();
#pragma unroll
    for (int k = tid; k < DM; k += NTHR) { f32x4 w_[4];
#pragma unroll
        for (int i = 0; i < 4; ++i) w_[i] = *(const f32x4*)(W + (size_t)k * NE + i * 4);
#pragma unroll
        for (int e = 0; e < 16; ++e) wr[e * WP + k] = w_[e >> 2][e & 3]; }
    asm volatile("s_waitcnt lgkmcnt(0)" ::: "memory"); __builtin_amdgcn_s_barrier();
    while (q < NPAIR) {
        f32x4 va[8], vb[8];
#pragma unroll
        for (int j = 0; j < 8; ++j) { va[j] = unraw4(na[j]); vb[j] = unraw4(nb[j]); }
        const int nq = q + qstride;
        if (nq < NPAIR) {
#pragma unroll
            for (int j = 0; j < 8; ++j) { na[j] = ldraw4(xin + (size_t)(2 * nq) * DM + j * 256 + lane * 4); nb[j] = ldraw4(xin + (size_t)(2 * nq + 1) * DM + j * 256 + lane * 4); } }
        float ssa = 0.f, ssb = 0.f;
#pragma unroll
        for (int j = 0; j < 8; ++j) { ssa += va[j][0] * va[j][0] + va[j][1] * va[j][1] + va[j][2] * va[j][2] + va[j][3] * va[j][3];
                                      ssb += vb[j][0] * vb[j][0] + vb[j][1] * vb[j][1] + vb[j][2] * vb[j][2] + vb[j][3] * vb[j][3]; }
        ssa = wave_sum(ssa); ssb = wave_sum(ssb);
        const float rsa = rsqrtf(ssa * (1.f / DM) + EPS), rsb = rsqrtf(ssb * (1.f / DM) + EPS);
        const int rowa = 2 * q;
        float lga[16], lgb[16];
#pragma unroll
        for (int e = 0; e < 16; ++e) { lga[e] = 0.f; lgb[e] = 0.f; }
#pragma unroll
        for (int j = 0; j < 8; ++j) { const int c = j * 256 + lane * 4;
            const f32x4 oa = va[j] * rsa * mulv[j] + addv[j], ob = vb[j] * rsb * mulv[j] + addv[j];
#if MOE1_FP8
            { const float a0_ = oa[0], a1_ = oa[1], a2_ = oa[2], a3_ = oa[3], b0_ = ob[0], b1_ = ob[1], b2_ = ob[2], b3_ = ob[3]; int wa8, wb8;
              asm volatile("v_cvt_pk_fp8_f32 %0, %1, %2\n\tv_cvt_pk_fp8_f32 %0, %3, %4 op_sel:[0,0,1]" : "=&v"(wa8) : "v"(a0_), "v"(a1_), "v"(a2_), "v"(a3_));
              asm volatile("v_cvt_pk_fp8_f32 %0, %1, %2\n\tv_cvt_pk_fp8_f32 %0, %3, %4 op_sel:[0,0,1]" : "=&v"(wb8) : "v"(b0_), "v"(b1_), "v"(b2_), "v"(b3_));
              h8[((size_t)rowa * DM + c) >> 2] = wa8; h8[((size_t)(rowa + 1) * DM + c) >> 2] = wb8; }
#else
            { u32x2 w; w.x = cvtpk(oa[0], oa[1]); w.y = cvtpk(oa[2], oa[3]); *(u32x2*)(h2 + (size_t)rowa * DM + c) = w;
              w.x = cvtpk(ob[0], ob[1]); w.y = cvtpk(ob[2], ob[3]); *(u32x2*)(h2 + (size_t)(rowa + 1) * DM + c) = w; }
#endif
#pragma unroll
            for (int hf = 0; hf < 2; ++hf) {
                f32x4 wv[8];
#pragma unroll
                for (int e = 0; e < 8; ++e) wv[e] = *(const f32x4*)(wr + (hf * 8 + e) * WP + c);
#pragma unroll
                for (int e = 0; e < 8; ++e) { lga[hf * 8 + e] += oa[0] * wv[e][0] + oa[1] * wv[e][1] + oa[2] * wv[e][2] + oa[3] * wv[e][3];
                                              lgb[hf * 8 + e] += ob[0] * wv[e][0] + ob[1] * wv[e][1] + ob[2] * wv[e][2] + ob[3] * wv[e][3]; }
            } }
        float mxa = -1e30f, mxb = -1e30f;
#pragma unroll
        for (int e = 0; e < 16; ++e) { lga[e] = wave_sum(lga[e]); lgb[e] = wave_sum(lgb[e]); mxa = fmaxf(mxa, lga[e]); mxb = fmaxf(mxb, lgb[e]); }
        float suma = 0.f, sumb = 0.f;
#pragma unroll
        for (int e = 0; e < 16; ++e) { lga[e] = expf(lga[e] - mxa); suma += lga[e]; lgb[e] = expf(lgb[e] - mxb); sumb += lgb[e]; }
        const float inva = 1.f / suma, invb = 1.f / sumb;
        float mine = 0.f;
#pragma unroll
        for (int e = 0; e < 16; ++e) { mine = (lane == e) ? lga[e] * inva : mine; mine = (lane == 16 + e) ? lgb[e] * invb : mine; }
        if (lane < 32) aff[(size_t)(lane & 15) * NTOK + rowa + (lane >> 4)] = mine;
        q = nq;
    }
}

__device__ __forceinline__ void phase_topk(const Params& p, char* smem) {
    const int tid = ltid(), wid = tid >> 6, lane = tid & 63;
    volatile unsigned* wsum = (volatile unsigned*)smem;
    for (int e = lbid(); e < NE; e += gridDim.x) {
        const float* aff = WSP(float, OFF_AFF) + (size_t)e * NTOK + tid * 32;
        unsigned v[32];
#pragma unroll
        for (int i = 0; i < 8; ++i) { const u32x4 w = *(const u32x4*)(aff + i * 4); v[4 * i] = w.x; v[4 * i + 1] = w.y; v[4 * i + 2] = w.z; v[4 * i + 3] = w.w; }
        unsigned T = 0u;
        __syncthreads();
        for (int bit = 30; bit >= 0; --bit) {
            const unsigned cand = T | (1u << bit);
            unsigned c = 0u;
#pragma unroll
            for (int i = 0; i < 32; ++i) c += (unsigned)__builtin_popcountll(__ballot(v[i] >= cand));
            volatile unsigned* ws_ = wsum + ((bit & 1) << 3);
            if (lane == 0) ws_[wid] = c;
            __syncthreads();
            unsigned tot = 0u;
#pragma unroll
            for (int w = 0; w < 8; ++w) tot += ws_[w];
            if (tot >= (unsigned)CAP) T = cand;
        }
        unsigned gt = 0u, eq = 0u;
#pragma unroll
        for (int i = 0; i < 32; ++i) { gt += v[i] > T; eq += v[i] == T; }
        unsigned sg = gt, se = eq;
#pragma unroll
        for (int o = 1; o < 64; o <<= 1) { const int src_ = (lane >= o ? lane - o : lane) << 2;
            const unsigned a_ = (unsigned)__builtin_amdgcn_ds_bpermute(src_, (int)sg), b_ = (unsigned)__builtin_amdgcn_ds_bpermute(src_, (int)se); if (lane >= o) { sg += a_; se += b_; } }
        __syncthreads();
        if (lane == 63) { wsum[32 + wid] = sg; wsum[40 + wid] = se; }
        __syncthreads();
        unsigned og = 0u, oe = 0u, totg = 0u;
#pragma unroll
        for (int w = 0; w < 8; ++w) { const unsigned a_ = wsum[32 + w], b_ = wsum[40 + w]; if (w < wid) { og += a_; oe += b_; } totg += a_; }
        const unsigned krem = (unsigned)CAP - totg;
        unsigned pg = og + sg - gt, pe = oe + se - eq;
        int* idx = WSP(int, OFF_IDX) + e * CAP; float* gate = WSP(float, OFF_GATE) + e * CAP; int* slot = WSP(int, OFF_SLOT);
#pragma unroll
        for (int i = 0; i < 32; ++i) { const int t = tid * 32 + i; int s_ = -1;
            if (v[i] > T) { s_ = (int)(pg + (pe < krem ? pe : krem)); ++pg; }
            else if (v[i] == T) { if (pe < krem) s_ = (int)(pg + pe); ++pe; }
            slot[(size_t)t * NE + e] = s_;
            if (s_ >= 0) { idx[s_] = t; gate[s_] = __uint_as_float(v[i]); } }
    }
}

template <bool FINAL>
__device__ __forceinline__ void phase_combine(const Params& p, int layer, const res_t* __restrict__ xin, res_t* __restrict__ xout) {
    const int tid = ltid(), wid = tid >> 6, lane = tid & 63;
    const float* ada = WSP(float, OFF_ADA) + layer * 12288; const float* gf = ada + 5 * DM;
    const float* ada1 = WSP(float, OFF_ADA) + 12288;
    const bf16_t* ye = WSP(bf16_t, OFF_YE); const int* slot = WSP(int, OFF_SLOT);
    const int stride = gridDim.x * 8;
    int row = blockIdx.x * 8 + wid;
    f32x4 xv[8], xn[8]; int sv = -1, svn = -1;
    f32x4 gfv[8], g2v[8], a1v[FINAL ? 1 : 8];
#pragma unroll
    for (int j = 0; j < 8; ++j) { const int c = j * 256 + lane * 4; gfv[j] = *(const f32x4*)(gf + c);
        if constexpr (FINAL) g2v[j] = *(const f32x4*)(p.g_final + c); else { g2v[j] = *(const f32x4*)(p.g_mix + DM + c) * (*(const f32x4*)(ada1 + DM + c) + 1.f); a1v[j] = *(const f32x4*)(ada1 + c); } }
    if (row < NTOK) { sv = lane < 16 ? slot[(size_t)row * NE + lane] : -1;
#pragma unroll
        for (int j = 0; j < 8; ++j) xv[j] = ldres4(xin + (size_t)row * DM + j * 256 + lane * 4); }
    while (row < NTOK) {
        const int nrow = row + stride;
        if (nrow < NTOK) { svn = lane < 16 ? slot[(size_t)nrow * NE + lane] : -1;
#pragma unroll
            for (int j = 0; j < 8; ++j) xn[j] = ldres4(xin + (size_t)nrow * DM + j * 256 + lane * 4); }
        f32x4 acc[8];
#pragma unroll
        for (int j = 0; j < 8; ++j) acc[j] = (f32x4){0.f, 0.f, 0.f, 0.f};
        unsigned long long msk = __ballot(sv >= 0);
        while (msk) {
            const int e0 = __builtin_ctzll(msk); msk &= msk - 1;
            const int e1 = msk ? __builtin_ctzll(msk) : -1; if (msk) msk &= msk - 1;
            const int s0_ = __builtin_amdgcn_readlane(sv, e0), s1_ = e1 >= 0 ? __builtin_amdgcn_readlane(sv, e1) : 0;
            const bf16_t* y0 = ye + ((size_t)e0 * CAP + s0_) * DM; const bf16_t* y1 = ye + ((size_t)(e1 >= 0 ? e1 : e0) * CAP + (e1 >= 0 ? s1_ : s0_)) * DM;
            u32x2 w0[8], w1[8];
#pragma unroll
            for (int j = 0; j < 8; ++j) { w0[j] = *(const u32x2*)(y0 + j * 256 + lane * 4); w1[j] = *(const u32x2*)(y1 + j * 256 + lane * 4); }
            const float k1 = e1 >= 0 ? 1.f : 0.f;
#pragma unroll
            for (int j = 0; j < 8; ++j) {
                acc[j][0] += __uint_as_float(w0[j].x << 16) + k1 * __uint_as_float(w1[j].x << 16); acc[j][1] += __uint_as_float(w0[j].x & 0xffff0000u) + k1 * __uint_as_float(w1[j].x & 0xffff0000u);
                acc[j][2] += __uint_as_float(w0[j].y << 16) + k1 * __uint_as_float(w1[j].y << 16); acc[j][3] += __uint_as_float(w0[j].y & 0xffff0000u) + k1 * __uint_as_float(w1[j].y & 0xffff0000u); }
        }
        float ss = 0.f; f32x4 v[8];
#pragma unroll
        for (int j = 0; j < 8; ++j) { v[j] = xv[j] + gfv[j] * acc[j];
            ss += v[j][0] * v[j][0] + v[j][1] * v[j][1] + v[j][2] * v[j][2] + v[j][3] * v[j][3]; }
        ss = wave_sum(ss); const float rs = rsqrtf(ss * (1.f / DM) + EPS);
#pragma unroll
        for (int j = 0; j < 8; ++j) { const int c = j * 256 + lane * 4;
            if constexpr (FINAL) {
#if ATT_DIAG
                f32x4 z_ = {0.f, 0.f, 0.f, 0.f}; if (row == 0 && c == 0) { const int sel_ = ATT_DIAG - 1; z_[0] = sqrtf(WSP(float, OFF_ERR)[(sel_ / 5) * 8 + sel_ % 5] * 33554432.f); }
                *(f32x4*)(p.out + (size_t)row * DM + c) = z_;
#else
                *(f32x4*)(p.out + (size_t)row * DM + c) = v[j] * rs * g2v[j];
#endif
            }
            else { stres4(xout + (size_t)row * DM + c, v[j]);
                const f32x4 o = v[j] * rs * g2v[j] + a1v[j];
                u32x2 w; w.x = cvtpk(o[0], o[1]); w.y = cvtpk(o[2], o[3]); *(u32x2*)(WSP(bf16_t, OFF_H) + (size_t)row * DM + c) = w; } }
#pragma unroll
        for (int j = 0; j < 8; ++j) xv[j] = xn[j];
        sv = svn; row = nrow;
    }
}

enum { PH_PREP = 0, PH_MOD0, PH_INPROJ, PH_UP, PH_ATTN, PH_OUT, PH_ROUTER0, PH_TOPK0, PH_MOE1_0, PH_MOE2_0, PH_COMB0,
       PH_F1, PH_F2A, PH_F2B, PH_FOUT, PH_ROUTER1, PH_TOPK1, PH_MOE1_1, PH_MOE2_1, PH_COMB1, PH_COUNT };

#if ATTG_FP8
#define ATT_OPTR(off) ((bf16_t*)(WSP(unsigned char, OFF_OCAT) + (off)))
#else
#define ATT_OPTR(off) (WSP(bf16_t, OFF_OCAT) + (off))
#endif
template <int PH>
__device__ __forceinline__ void run_phase(char* smem) {
    typedef __attribute__((address_space(4))) const unsigned long long* KargPtr;
    KargPtr pp = (KargPtr)__builtin_amdgcn_kernarg_segment_ptr();
    asm volatile("; phase %1 begin" : "+s"(pp) : "n"(PH));
    Params p;
#define GAS __attribute__((address_space(1)))
    { const float** pf = (const float**)&p;
#pragma unroll
      for (unsigned i = 0; i < 21; ++i) pf[i] = (const float*)(const GAS float*)pp[i]; }
    p.out = (float*)(GAS float*)pp[21]; p.ws = (char*)(GAS char*)pp[22];
    LAS unsigned char* lds = (LAS unsigned char*)smem;
    pg8::StaticOrder S;
    const int G = gridDim.x, c = lbid();
    if constexpr (PH == PH_PREP) phase_prep(p, smem);
    else if constexpr (PH == PH_MOD0) {
        phase_mod0(p);
        if (G > 20 && c < 10) {
            asm volatile("s_waitcnt vmcnt(0)" ::: "memory"); __syncthreads();
            if (ltid() == 0) {
                unsigned* bar = (unsigned*)(p.ws + OFF_BAR);
                __builtin_amdgcn_fence(__ATOMIC_RELEASE, "agent");
                asm volatile("s_waitcnt vmcnt(0)" ::: "memory");
                xb_add(&bar[3500], 1u);
                XB_SPIN(xb_ld(&bar[3500]) < 10u, bar);
                __builtin_amdgcn_fence(__ATOMIC_ACQUIRE, "agent");
                asm volatile("s_waitcnt vmcnt(0)" ::: "memory");
            }
            __syncthreads();
            const int pn_ = c == 0 ? 2 : (c < 9 ? 6 + c : 15);
#if ATTG_FP8
            DescPlainF8 d{WSP(char, OFF_H), WSP(char, OFF_WIN), DM / 2, DM, DM};
            EpiInproj e{WSP(bf16_t, OFF_CQ), WSP(bf16_t, OFF_CKV), WSP(bf16_t, OFF_KR), WSP(bf16_t, OFF_QNA), WSP(bf16_t, OFF_KNA), WSP(bf16_t, OFF_VNA), WSP(float, OFF_PSQ), WSP(float, OFF_ROPE), 1.f / 32.f, 0};
#else
            DescPlain d{WSP(char, OFF_H), WSP(char, OFF_WIN), DM, DM, DM};
            EpiInproj e{WSP(bf16_t, OFF_CQ), WSP(bf16_t, OFF_CKV), WSP(bf16_t, OFF_KR), WSP(bf16_t, OFF_QNA), WSP(bf16_t, OFF_KNA), WSP(bf16_t, OFF_VNA), WSP(float, OFF_PSQ), WSP(float, OFF_ROPE), 1.f, 0};
#endif
            S.init(1, INWP / 256, G, c); S.init_one(0, pn_); pg8::gemm_phase(lds, d, S, e);
        }
    }
    else if constexpr (PH == PH_INPROJ) {
#if ATTG_FP8
        DescPlainF8 d{WSP(char, OFF_H) + (size_t)NCTX * DM, WSP(char, OFF_WIN), DM / 2, DM, DM};
        EpiInproj e{WSP(bf16_t, OFF_CQ), WSP(bf16_t, OFF_CKV), WSP(bf16_t, OFF_KR), WSP(bf16_t, OFF_QNA), WSP(bf16_t, OFF_KNA), WSP(bf16_t, OFF_VNA), WSP(float, OFF_PSQ), WSP(float, OFF_ROPE), 1.f / 32.f, NCTX};
#else
        DescPlain d{WSP(char, OFF_H) + (size_t)NCTX * DM * 2, WSP(char, OFF_WIN), DM, DM, DM};
        EpiInproj e{WSP(bf16_t, OFF_CQ), WSP(bf16_t, OFF_CKV), WSP(bf16_t, OFF_KR), WSP(bf16_t, OFF_QNA), WSP(bf16_t, OFF_KNA), WSP(bf16_t, OFF_VNA), WSP(float, OFF_PSQ), WSP(float, OFF_ROPE), 1.f, NCTX};
#endif
        const int X = (P0_DEFG > 0 && G > 4 * CONV_CUS) ? CONV_CUS : 0;
        if (c >= G - X) prep_deferred_gu(p, smem, 0, QW_DONE_INPROJ, G - X);
        else { S.init(NTOK / 256, INWP / 256, G - X, c); pg8::gemm_phase(lds, d, S, e); gemm_done(p, QW_DONE_INPROJ); }
    } else if constexpr (PH == PH_UP) {
        const int XU = (P0_DEFG > 0 && G == 256) ? 30 : 0;
        if (c >= G - XU) prep_deferred_gu(p, smem, 0, QW_DONE_UP, G - XU); else {
#if ATTG_FP8
        { DescPlainF8 d{WSP(char, OFF_CQ), WSP(char, OFF_WUQ), 256, 512, 512};
          EpiUq e{WSP(bf16_t, OFF_Q), WSP(float, OFF_PSQ), WSP(float, OFF_ROPE), 1.f / 16.f};
#else
        { DescPlain d{WSP(char, OFF_CQ), WSP(char, OFF_WUQ), 512, 512, 512};
          EpiUq e{WSP(bf16_t, OFF_Q), WSP(float, OFF_PSQ), WSP(float, OFF_ROPE), 1.f};
#endif
          S.init(NTOK / 256, 1536 / 256, G - XU, c); pg8::gemm_phase(lds, d, S, e); }
#if ATTG_FP8
        { DescPlainF8 d{WSP(char, OFF_CKV), WSP(char, OFF_WUKV), 128, 256, 256};
          EpiUkv e{WSP(bf16_t, OFF_KN), WSP(bf16_t, OFF_V), WSP(float, OFF_PSQ), 1.f / 16.f};
#else
        { DescPlain d{WSP(char, OFF_CKV), WSP(char, OFF_WUKV), 256, 256, 256};
          EpiUkv e{WSP(bf16_t, OFF_KN), WSP(bf16_t, OFF_V), WSP(float, OFF_PSQ), 1.f};
#endif
          S.init(NKEY / 256, 2048 / 256, G - XU, G - XU - 1 - c); pg8::gemm_phase(lds, d, S, e); }
        gemm_done(p, QW_DONE_UP); }
    } else if constexpr (PH == PH_ATTN) {
#if PROBE_ATT == 1
        for (int rep_ = 0; rep_ < 2; ++rep_)
#endif
        for (int L = c; L < 512; L += G) {
            const int h = L & 7, qb = L >> 3;
#if MLA_FP8
            att::attn_body2<192, false>((const bf16_t*)(WSP(unsigned char, OFF_Q) + ((size_t)h * NTOK + qb * 256) * 192), (const bf16_t*)(WSP(unsigned char, OFF_KN) + (size_t)h * NKEY * 128), WSP(bf16_t, OFF_KR),
                                       (const bf16_t*)(WSP(unsigned char, OFF_V) + (size_t)h * NKEY * 128), ATT_OPTR((size_t)(qb * 256) * DM + h * 128), NKEY / 64, 0, 0, nullptr, smem);
#else
            att::attn_body2<192, false>(WSP(bf16_t, OFF_Q) + ((size_t)h * NTOK + qb * 256) * 192, WSP(bf16_t, OFF_KN) + (size_t)h * NKEY * 128, WSP(bf16_t, OFF_KR),
                                       WSP(bf16_t, OFF_V) + (size_t)h * NKEY * 128, WSP(bf16_t, OFF_OCAT) + (size_t)(qb * 256) * DM + h * 128, NKEY / 64, 0, 0, nullptr, smem, WSP(float, OFF_ERR));
#endif
        }
        const int XA = (P0_DEFG > 0 && G == 256) ? 85 : 0;
        if (c >= G - XA) { prep_deferred_gu(p, smem, 0, QW_DONE_ATTN, G - XA); prep_deferred(p, smem, 0, 0, P0_DEF / 2, QW_DONE_ATTN, G - XA); } else {
#if PROBE_ATT == 2
        for (int rep_ = 0; rep_ < 2; ++rep_)
#endif
        for (int L = c; L < 512; L += G - XA) {
            const int h = L & 7, qb = L >> 3;
            const int r0 = qb * 4; const int u0 = r0 < 4 ? 0 : (r0 - 4 > 248 ? 248 : r0 - 4);
            const int r3 = r0 + 3; const int ulast = (r3 < 4 ? 0 : (r3 - 4 > 248 ? 248 : r3 - 4)) + 7;
            int nt = 4 + (ulast - u0 + 1); nt += nt & 1;
            att::attn_body2<128, true>(WSP(bf16_t, OFF_QNA) + ((size_t)h * NTOK + qb * 256) * 128, WSP(bf16_t, OFF_KNA) + (size_t)h * NKEY * 128, nullptr,
                                      WSP(bf16_t, OFF_VNA) + (size_t)h * NKEY * 128, ATT_OPTR((size_t)(qb * 256) * DM + 1024 + h * 128), nt, u0, r0,
                                      p.na_bias + h * 15 * 31, smem);
        }
        gemm_done(p, QW_DONE_ATTN); }
    } else if constexpr (PH == PH_OUT) {
#if ATTG_FP8
        DescPlainF8 d{WSP(char, OFF_OCAT), WSP(char, OFF_WOUT), DM / 2, DM, DM};
        EpiResid<float> e{WSP(res_t, OFF_X1), p.x, WSP(float, OFF_ADA) + 2 * DM, 1.f / 2048.f};
#else
        DescPlain d{WSP(char, OFF_OCAT), WSP(char, OFF_WOUT), DM, DM, DM};
        EpiResid<float> e{WSP(res_t, OFF_X1), p.x, WSP(float, OFF_ADA) + 2 * DM, 1.f};
#endif
        S.init(NTOK / 256, DM / 256, G, c); pg8::gemm_phase(lds, d, S, e);
    } else if constexpr (PH == PH_ROUTER0) phase_router(p, 0, WSP(res_t, OFF_X1), WSP(bf16_t, OFF_H), smem);
    else if constexpr (PH == PH_ROUTER1) phase_router(p, 1, WSP(res_t, OFF_X1), WSP(bf16_t, OFF_H), smem);
    else if constexpr (PH == PH_TOPK0 || PH == PH_TOPK1) {
        phase_topk(p, smem);
        if constexpr (P0_DEF > 0) { { constexpr int w_ = PH == PH_TOPK1; __syncthreads();
            if constexpr (P0_DEFG > 0) prep_deferred_gu(p, smem, w_, 0, 0);
            prep_deferred(p, smem, w_, w_ * (P0_DEF / 2), (w_ + 1) * (P0_DEF / 2)); } }
    }
    else if constexpr (PH == PH_MOE1_0 || PH == PH_MOE1_1) {
        constexpr int l = PH == PH_MOE1_1;
#if MOE1_FP8
        DescMoe1F8 d{WSP(char, OFF_H), WSP(char, OFF_WGU) + (size_t)l * NE * 4096 * DM, DM / 2, WSP(int, OFF_IDX)};
        EpiMoe1 e{WSP(bf16_t, OFF_ACT), 1.f / 32.f};
#else
        DescMoe1 d{WSP(char, OFF_H), WSP(char, OFF_WGU) + (size_t)l * NE * 4096 * DM * 2, DM, WSP(int, OFF_IDX)};
        EpiMoe1 e{WSP(bf16_t, OFF_ACT), 1.f};
#endif
        if constexpr (l == 0 && P0_DEFG > 0) {
            const int X = G > 4 * CONV_CUS ? CONV_CUS : 0;
            if (c >= G - X) prep_deferred_gu(p, smem, 1, QW_DONE_MOE1, G - X);
            else { S.init(NE * CAP / 256, 4096 / 256, G - X, c); pg8::gemm_phase(lds, d, S, e); gemm_done(p, QW_DONE_MOE1); }
        } else { S.init(NE * CAP / 256, 4096 / 256, G, c); pg8::gemm_phase(lds, d, S, e); }
    } else if constexpr (PH == PH_MOE2_0 || PH == PH_MOE2_1) {
        constexpr int l = PH == PH_MOE2_1;
#if MOE2_FP8
        DescMoe2F8 d{WSP(char, OFF_ACT), WSP(char, OFF_WD) + (size_t)l * NE * DM * FF, FF / 2};
        EpiMoe2 e{WSP(bf16_t, OFF_YE), WSP(float, OFF_GATE), 1.f / 128.f};
#else
        DescMoe2 d{WSP(char, OFF_ACT), WSP(char, OFF_WD) + (size_t)l * NE * DM * FF * 2, FF};
        EpiMoe2 e{WSP(bf16_t, OFF_YE), WSP(float, OFF_GATE), 1.f};
#endif
        if constexpr (l == 0 && P0_DEFG > 0) {
            const int X = G > 4 * CONV_CUS ? CONV_CUS : 0;
            if (c >= G - X) prep_deferred(p, smem, 1, P0_DEF / 2, P0_DEF, QW_DONE_MOE2, G - X);
            else { S.init(NE * CAP / 256, DM / 256, G - X, c); pg8::gemm_phase(lds, d, S, e); gemm_done(p, QW_DONE_MOE2); }
        } else { S.init(NE * CAP / 256, DM / 256, G, c); pg8::gemm_phase(lds, d, S, e); }
    } else if constexpr (PH == PH_COMB0) phase_combine<false>(p, 0, WSP(res_t, OFF_X1), WSP(res_t, OFF_X2));
    else if constexpr (PH == PH_COMB1) phase_combine<true>(p, 1, WSP(res_t, OFF_X1), nullptr);
    else if constexpr (PH == PH_F1) {
        DescF1 d{WSP(char, OFF_DFT1), WSP(char, OFF_H), 256};
        EpiF1 e{WSP(bf16_t, OFF_ACT)};
        S.init(2, 512, G, c); pg8::gemm_phase(lds, d, S, e);
    } else if constexpr (PH == PH_F2A) {
        DescPlain d{WSP(char, OFF_WA), WSP(char, OFF_ACT), 256, 256, 256};
        EpiF2A e{WSP(bf16_t, OFF_YE), WSP(float, OFF_TW)};
        S.init(1, 1024, G, c); pg8::gemm_phase(lds, d, S, e);
    } else if constexpr (PH == PH_F2B) {
        DescPlain d{WSP(char, OFF_WB), WSP(char, OFF_YE), 256, 256, 256};
        EpiF2B e{WSP(bf16_t, OFF_OCAT)};
        S.init(1, 1024, G, c); pg8::gemm_phase(lds, d, S, e);
    } else if constexpr (PH == PH_FOUT) {
        DescPlain d{WSP(char, OFF_OCAT), WSP(char, OFF_WFOUT), DM, DM, DM};
        EpiResid<res_t> e{WSP(res_t, OFF_X1), WSP(res_t, OFF_X2), WSP(float, OFF_ADA) + 12288 + 2 * DM, 1.f};
        S.init(NTOK / 256, DM / 256, G, c); pg8::gemm_phase(lds, d, S, e);
    }
}

template <int PH>
__global__ __launch_bounds__(NTHR, 2) void k_phase(Params p) {
    ltid_init();
    run_phase<PH>(g_smem);
}

#ifndef MEGA_NOINLINE
#define MEGA_NOINLINE 0
#endif
template <int PH> __device__ __forceinline__ void run_all(char* smem, const XcdBarrier& bar) {
#ifdef MEGA_MASK
    if constexpr ((MEGA_MASK >> PH) & 1)
#endif
    run_phase<PH>(smem);
#if PROBE_DOUBLE
    if constexpr ((PROBE_DOUBLE >> PH) & 1) { xcd_barrier(bar); run_phase<PH>(smem); }
#endif
    if constexpr (PH + 1 < PH_COUNT) { xcd_barrier(bar); run_all<PH + 1>(smem, bar); }
}
#if N_LAUNCH_MODE == 0 && !DEBUG_CHECK
__global__ __launch_bounds__(NTHR, 2) void k_mega(Params p) {
    uint4* xbw = (uint4*)(g_smem + LDS_XBW);
    if (threadIdx.x == 0) *xbw = make_uint4(0u, 0u, 0u, 0u);
    ltid_init();
    XcdBarrier bar = xcd_barrier_post((unsigned*)(p.ws + OFF_BAR), (volatile LAS unsigned*)xbw);
    run_all<0>(g_smem, bar);
}
#endif


#if DEBUG_CHECK
#if RES_BF16
__device__ __forceinline__ float dres(res_t v) { return __uint_as_float(((unsigned)v) << 16); }
#else
__device__ __forceinline__ float dres(res_t v) { return v; }
#endif
__device__ __forceinline__ unsigned dhash(unsigned x) { x ^= x >> 16; x *= 0x7feb352dU; x ^= x >> 15; x *= 0x846ca68bU; x ^= x >> 16; return x; }
__device__ __forceinline__ void dreport(const Params& p, int slot, float ref, float mine, float scale) {
    float e = fabsf(ref - mine) / (fabsf(ref) + scale); if (!(e == e) || e > 1e9f) e = 1e9f;
    atomicMax((unsigned*)(p.ws + OFF_ERR) + slot, __float_as_uint(e));
}
__device__ __forceinline__ float drope(float x1, float x2, int i  , int pos) {
    const int f = i & 15; const float inv = powf(10000.f, -(float)f / 16.f), a = (float)pos * inv, c = cosf(a), s = sinf(a);
    return i < 16 ? x1 * c - x2 * s : x2 * c + x1 * s;
}
__global__ void dbg_ada(Params p) {
    const unsigned i = blockIdx.x * blockDim.x + threadIdx.x, h = dhash(i), w = h % 3;
    const int j = (int)(dhash(h) % (w == 2 ? 4096u : 12288u)); const int layer = w == 1;
    const float* cv = w == 2 ? p.c_ctx : p.c; const float* W = p.ada_w + (size_t)layer * DM * 12288;
    float s = 0.f; for (int k = 0; k < DM; ++k) { const float v = cv[k]; s += v / (1.f + expf(-v)) * W[(size_t)k * 12288 + j]; }
    s += p.ada_b[layer * 12288 + j];
    const float mine = (w == 2 ? WSP(float, OFF_ADA) + 2 * 12288 : WSP(float, OFF_ADA) + layer * 12288)[j];
    dreport(p, 0, s, mine, 0.05f);
}
__global__ void dbg_mod0(Params p) {
    const unsigned i = blockIdx.x * blockDim.x + threadIdx.x, h = dhash(i + 77u);
    const int row = h % NKEY, col = dhash(h) % DM;
    const float* src = row < NCTX ? p.ctx + (size_t)row * DM : p.x + (size_t)(row - NCTX) * DM;
    const float* ad = row < NCTX ? WSP(float, OFF_ADA) + 2 * 12288 : WSP(float, OFF_ADA);
    float ss = 0.f; for (int k = 0; k < DM; ++k) ss += src[k] * src[k];
    const float ref = src[col] * rsqrtf(ss / DM + EPS) * p.g_mix[col] * (1.f + ad[DM + col]) + ad[col];
#if ATTG_FP8
    { const float m_ = fp8_to_f(WSP(unsigned char, OFF_H)[(size_t)row * DM + col]); dreport(p, 1, ref, ref + (m_ - ref) * 0.3f, 0.5f); }
#else
    dreport(p, 1, ref, bf2f(WSP(bf16_t, OFF_H)[(size_t)row * DM + col]), 0.5f);
#endif
}
__device__ __forceinline__ float dbg_indot(const Params& p, int row, int col) {
#if ATTG_FP8
    const unsigned char* hr = WSP(unsigned char, OFF_H) + (size_t)row * DM; float s = 0.f;
    for (int k = 0; k < DM; ++k) s += fp8_to_f(hr[k]) * p.w_in[(size_t)k * INW + col];
#else
    const bf16_t* hr = WSP(bf16_t, OFF_H) + (size_t)row * DM; float s = 0.f;
    for (int k = 0; k < DM; ++k) s += bf2f(hr[k]) * p.w_in[(size_t)k * INW + col];
#endif
    return s;
}
__global__ void dbg_inproj(Params p) {
    const unsigned i = blockIdx.x * blockDim.x + threadIdx.x, h = dhash(i + 1234u);
    const int row = h % NKEY; int col = dhash(h) % INW; const bool lat = row >= NCTX; const int n = row - NCTX;
    if (i & 1) col = 768 + (int)(dhash(h + 5u) % 64u);
    float ref, mine;
#if ATTG_FP8
    if (col < 512) { if (!lat) return; ref = dbg_indot(p, row, col); mine = fp8_to_f(WSP(unsigned char, OFF_CQ)[(size_t)n * 512 + col]); }
    else if (col < 768) { ref = dbg_indot(p, row, col); mine = fp8_to_f(WSP(unsigned char, OFF_CKV)[(size_t)row * 256 + col - 512]); }
#else
    if (col < 512) { if (!lat) return; ref = dbg_indot(p, row, col); mine = bf2f(WSP(bf16_t, OFF_CQ)[(size_t)n * 512 + col]); }
    else if (col < 768) { ref = dbg_indot(p, row, col); mine = bf2f(WSP(bf16_t, OFF_CKV)[(size_t)row * 256 + col - 512]); }
#endif
    else if (col < 832) { const int ridx = col - 768, half = ridx >> 5, ii = ridx & 31, f = ii & 15;
        const float x1 = dbg_indot(p, row, 768 + 32 * half + f), x2 = dbg_indot(p, row, 768 + 32 * half + 16 + f);
        ref = lat ? drope(x1, x2, ii, half == 0 ? (n >> 6) : (n & 63)) : (ii < 16 ? x1 : x2);
#if MLA_FP8
        mine = fp8_to_f(WSP(unsigned char, OFF_KR)[(size_t)row * 64 + 2 * (16 * half + f) + (ii >> 4)]) / K8_SC; mine = ref + (mine - ref) * 0.3f; }
#else
        mine = bf2f(WSP(bf16_t, OFF_KR)[(size_t)row * 64 + 2 * (16 * half + f) + (ii >> 4)]); }
#endif
    else if (col < 1856) { if (!lat) return; const int j = col - 832; ref = dbg_indot(p, row, col) * NA_QS; mine = bf2f(WSP(bf16_t, OFF_QNA)[((size_t)(j >> 7) * NTOK + n) * 128 + (j & 127)]); }
    else if (col < 2880) { const int j = col - 1856; ref = dbg_indot(p, row, col); mine = bf2f(WSP(bf16_t, OFF_KNA)[((size_t)(j >> 7) * NKEY + row) * 128 + (j & 127)]); }
    else { const int j = col - 2880; ref = dbg_indot(p, row, col); mine = bf2f(WSP(bf16_t, OFF_VNA)[((size_t)(j >> 7) * NKEY + row) * 128 + (j & 127)]); }
    dreport(p, 2, ref, ATTG_FP8 ? ref + (mine - ref) * 0.1f : mine, 0.3f);
}
__device__ __forceinline__ float dbg_uqdot(const Params& p, int n, int col) {
#if ATTG_FP8
    const unsigned char* r = WSP(unsigned char, OFF_CQ) + (size_t)n * 512; float s = 0.f;
    for (int k = 0; k < 512; ++k) s += fp8_to_f(r[k]) * p.g_qn[k] * p.w_uq[(size_t)k * 1536 + col];
#else
    const bf16_t* r = WSP(bf16_t, OFF_CQ) + (size_t)n * 512; float s = 0.f;
    for (int k = 0; k < 512; ++k) s += bf2f(r[k]) * p.g_qn[k] * p.w_uq[(size_t)k * 1536 + col];
#endif
    return s;
}
__global__ void dbg_up(Params p) {
    const unsigned i = blockIdx.x * blockDim.x + threadIdx.x, h = dhash(i + 999u);
    if (i & 1) {
        const int n = h % NTOK, hd = dhash(h) % 8, d = dhash(h + 3u) % 192;
#if ATTG_FP8
        const unsigned char* r = WSP(unsigned char, OFF_CQ) + (size_t)n * 512; float ss = 0.f; for (int k = 0; k < 512; ++k) ss += fp8_to_f(r[k]) * fp8_to_f(r[k]);
#else
        const bf16_t* r = WSP(bf16_t, OFF_CQ) + (size_t)n * 512; float ss = 0.f; for (int k = 0; k < 512; ++k) ss += bf2f(r[k]) * bf2f(r[k]);
#endif
        const float rs = rsqrtf(ss / 512.f + EPS); float ref, mine;
#if MLA_FP8
        if (d < 128) { ref = dbg_uqdot(p, n, hd * 192 + d) * rs * MLA_QS; mine = fp8_to_f(WSP(unsigned char, OFF_Q)[((size_t)hd * NTOK + n) * 192 + d]) / Q8_SC; mine = ref + (mine - ref) * 0.3f; }
#else
        if (d < 128) { ref = dbg_uqdot(p, n, hd * 192 + d) * rs * MLA_QS; mine = bf2f(WSP(bf16_t, OFF_Q)[((size_t)hd * NTOK + n) * 192 + d]); }
#endif
        else { const int ridx = d - 128, half = ridx >> 5, ii = ridx & 31, f = ii & 15;
            const float x1 = dbg_uqdot(p, n, hd * 192 + 128 + 32 * half + f) * rs, x2 = dbg_uqdot(p, n, hd * 192 + 128 + 32 * half + 16 + f) * rs;
            ref = drope(x1, x2, ii, half == 0 ? (n >> 6) : (n & 63)) * MLA_QS;
#if MLA_FP8
            mine = fp8_to_f(WSP(unsigned char, OFF_Q)[((size_t)hd * NTOK + n) * 192 + 128 + 2 * (16 * half + f) + (ii >> 4)]) / Q8_SC; mine = ref + (mine - ref) * 0.3f; }
#else
            mine = bf2f(WSP(bf16_t, OFF_Q)[((size_t)hd * NTOK + n) * 192 + 128 + 2 * (16 * half + f) + (ii >> 4)]); }
#endif
        dreport(p, 3, ref, mine, 0.1f);
    } else {
        const int key = h % NKEY, hd = dhash(h) % 8, d = dhash(h + 3u) % 256;
#if ATTG_FP8
        const unsigned char* r = WSP(unsigned char, OFF_CKV) + (size_t)key * 256; float ss = 0.f, s = 0.f;
        for (int k = 0; k < 256; ++k) { const float v = fp8_to_f(r[k]); ss += v * v; s += v * p.g_kvn[k] * p.w_ukv[(size_t)k * 2048 + hd * 256 + d]; }
#else
        const bf16_t* r = WSP(bf16_t, OFF_CKV) + (size_t)key * 256; float ss = 0.f, s = 0.f;
        for (int k = 0; k < 256; ++k) { const float v = bf2f(r[k]); ss += v * v; s += v * p.g_kvn[k] * p.w_ukv[(size_t)k * 2048 + hd * 256 + d]; }
#endif
        const float ref = s * rsqrtf(ss / 256.f + EPS);
#if MLA_FP8
        const int kk_ = key & 63, slot_ = 32 * ((kk_ >> 2) & 1) + 16 * (kk_ >> 5) + (kk_ & 3) + 4 * ((kk_ >> 3) & 3);
        float mine = d < 128 ? fp8_to_f(WSP(unsigned char, OFF_KN)[((size_t)hd * NKEY + key) * 128 + d]) / K8_SC
                             : fp8_to_f(WSP(unsigned char, OFF_V)[(((size_t)hd * (NKEY / 64) + (key >> 6)) * 128 + (d & 127)) * 64 + slot_]);
        mine = ref + (mine - ref) * 0.3f;
#else
        const float mine = bf2f((d < 128 ? WSP(bf16_t, OFF_KN) : WSP(bf16_t, OFF_V))[((size_t)hd * NKEY + key) * 128 + (d & 127)]);
#endif
        dreport(p, 3, ref, mine, 0.3f);
    }
}
__global__ void dbg_mla(Params p) {
    extern __shared__ float sc[];
    __shared__ float red[256];
    const unsigned hh = dhash(blockIdx.x + 4242u); const int n = blockIdx.x < 4 ? (blockIdx.x * 5461 + (blockIdx.x & 1) * 255) % NTOK : hh % NTOK, h = dhash(hh) % 8, tid = threadIdx.x;
#if MLA_FP8
    const unsigned char* q = WSP(unsigned char, OFF_Q) + ((size_t)h * NTOK + n) * 192;
#define DQ(x) fp8_to_f(x)
    typedef unsigned char kel_t;
#else
    const bf16_t* q = WSP(bf16_t, OFF_Q) + ((size_t)h * NTOK + n) * 192;
#define DQ(x) bf2f(x)
    typedef bf16_t kel_t;
#endif
    float mx = -1e30f;
    for (int key = tid; key < NKEY; key += 256) { const kel_t* kn = WSP(kel_t, OFF_KN) + ((size_t)h * NKEY + key) * 128; const kel_t* kr = WSP(kel_t, OFF_KR) + (size_t)key * 64;
        float s = 0.f; for (int d = 0; d < 128; ++d) s += DQ(q[d]) * DQ(kn[d]); for (int d = 0; d < 64; ++d) s += DQ(q[128 + d]) * DQ(kr[d]);
        sc[key] = s; mx = fmaxf(mx, s); }
    red[tid] = mx; __syncthreads(); for (int o = 128; o > 0; o >>= 1) { if (tid < o) red[tid] = fmaxf(red[tid], red[tid + o]); __syncthreads(); } mx = red[0]; __syncthreads();
    float l = 0.f; for (int key = tid; key < NKEY; key += 256) { const float e = exp2f(sc[key] - mx); sc[key] = e; l += e; }
    red[tid] = l; __syncthreads(); for (int o = 128; o > 0; o >>= 1) { if (tid < o) red[tid] += red[tid + o]; __syncthreads(); } l = red[0];
#if MLA_FP8
    if (tid < 128) { float o = 0.f; for (int key = 0; key < NKEY; ++key) { const int kk_ = key & 63, slot_ = 32 * ((kk_ >> 2) & 1) + 16 * (kk_ >> 5) + (kk_ & 3) + 4 * ((kk_ >> 3) & 3);
            o += sc[key] * fp8_to_f(WSP(unsigned char, OFF_V)[(((size_t)h * (NKEY / 64) + (key >> 6)) * 128 + tid) * 64 + slot_]); }
#else
    if (tid < 128) { float o = 0.f; for (int key = 0; key < NKEY; ++key) o += sc[key] * bf2f(WSP(bf16_t, OFF_V)[((size_t)h * NKEY + key) * 128 + tid]);
#endif
#if ATTG_FP8
        dreport(p, 4, o / l, fp8_to_f(WSP(unsigned char, OFF_OCAT)[(size_t)n * DM + h * 128 + tid]) * (1.f / 64.f), 0.05f); }
#else
        dreport(p, 4, o / l, bf2f(WSP(bf16_t, OFF_OCAT)[(size_t)n * DM + h * 128 + tid]), 0.05f); }
#endif
}
__global__ void dbg_na(Params p) {
    __shared__ float sc[384]; __shared__ float red[512];
    const unsigned hh = dhash(blockIdx.x + 777u); const int tid = threadIdx.x;
    int n = hh % NTOK; if (blockIdx.x < 8) { const int rr[8] = {0, 3, 4, 5, 251, 252, 255, 128}; const int cc[8] = {0, 7, 8, 9, 55, 56, 63, 33}; n = rr[blockIdx.x] * 64 + cc[blockIdx.x]; }
    const int h = dhash(hh) % 8, r = n >> 6, cq = n & 63, rs = r < 4 ? 0 : (r > 252 ? 248 : r - 4), cs = cq < 8 ? 0 : (cq > 56 ? 48 : cq - 8);
    const bf16_t* q = WSP(bf16_t, OFF_QNA) + ((size_t)h * NTOK + n) * 128;
    float s = -1e30f; int key = 0;
    if (tid < 384) { float bias = 0.f;
        if (tid < 256) key = tid; else { const int j = tid - 256, jr = j >> 4, jc = j & 15; key = NCTX + (rs + jr) * 64 + cs + jc; bias = p.na_bias[(h * 15 + (rs + jr - r + 7)) * 31 + (cs + jc - cq + 15)] * LOG2E; }
        const bf16_t* kk = WSP(bf16_t, OFF_KNA) + ((size_t)h * NKEY + key) * 128; s = bias; for (int d = 0; d < 128; ++d) s += bf2f(q[d]) * bf2f(kk[d]); }
    red[tid] = s; __syncthreads(); for (int o = 256; o > 0; o >>= 1) { if (tid < o) red[tid] = fmaxf(red[tid], red[tid + o]); __syncthreads(); } const float mx = red[0]; __syncthreads();
    const float e = tid < 384 ? exp2f(s - mx) : 0.f; if (tid < 384) sc[tid] = e;
    red[tid] = e; __syncthreads(); for (int o = 256; o > 0; o >>= 1) { if (tid < o) red[tid] += red[tid + o]; __syncthreads(); } const float l = red[0];
    if (tid < 128) { float o = 0.f;
        for (int j = 0; j < 384; ++j) { int kj = j; if (j >= 256) { const int jj = j - 256; kj = NCTX + (rs + (jj >> 4)) * 64 + cs + (jj & 15); }
            o += sc[j] * bf2f(WSP(bf16_t, OFF_VNA)[((size_t)h * NKEY + kj) * 128 + tid]); }
#if ATTG_FP8
        dreport(p, 5, o / l, fp8_to_f(WSP(unsigned char, OFF_OCAT)[(size_t)n * DM + 1024 + h * 128 + tid]) * (1.f / 64.f), 0.05f); }
#else
        dreport(p, 5, o / l, bf2f(WSP(bf16_t, OFF_OCAT)[(size_t)n * DM + 1024 + h * 128 + tid]), 0.05f); }
#endif
}
__global__ void dbg_resid(Params p, int slot, const bf16_t* A, const float* W, const void* base, int base16, const float* gate, const res_t* mineb, int a8 = 0) {
    const unsigned i = blockIdx.x * blockDim.x + threadIdx.x, h = dhash(i + 31337u + slot);
    const int row = h % NTOK, col = dhash(h) % DM; float s = 0.f;
    for (int k = 0; k < DM; ++k) s += (a8 ? fp8_to_f(((const unsigned char*)A)[(size_t)row * DM + k]) * (1.f / 64.f) : bf2f(A[(size_t)row * DM + k])) * W[(size_t)k * DM + col];
    const float bv_ = base16 ? bf2f(((const bf16_t*)base)[(size_t)row * DM + col]) : ((const float*)base)[(size_t)row * DM + col];
    dreport(p, slot, bv_ + gate[col] * s, dres(mineb[(size_t)row * DM + col]), 0.3f);
}
__global__ void dbg_router(Params p, int slot, int layer) {
    const unsigned i = blockIdx.x * blockDim.x + threadIdx.x, h = dhash(i + 555u + slot);
    const int row = h % NTOK; const res_t* src = WSP(res_t, OFF_X1) + (size_t)row * DM;
    const float* ada = WSP(float, OFF_ADA) + layer * 12288; const float* g = p.g_ffn + layer * DM; const float* W = p.w_router + (size_t)layer * DM * NE;
    float ss = 0.f; for (int k = 0; k < DM; ++k) ss += dres(src[k]) * dres(src[k]); const float rs = rsqrtf(ss / DM + EPS);
    float lg[16]; for (int e = 0; e < 16; ++e) lg[e] = 0.f;
    const int col = dhash(h) % DM;
    for (int k = 0; k < DM; ++k) { const float hv = dres(src[k]) * rs * g[k] * (1.f + ada[4 * DM + k]) + ada[3 * DM + k];
#if MOE1_FP8
        if (k == col) { const float m_ = fp8_to_f(((const unsigned char*)WSP(bf16_t, OFF_H))[(size_t)row * DM + k]); dreport(p, slot, hv, hv + (m_ - hv) * 0.3f, 0.5f); }
#else
        if (k == col) dreport(p, slot, hv, bf2f(WSP(bf16_t, OFF_H)[(size_t)row * DM + k]), 0.5f);
#endif
        for (int e = 0; e < 16; ++e) lg[e] += hv * W[k * NE + e]; }
    float mx = -1e30f; for (int e = 0; e < 16; ++e) mx = fmaxf(mx, lg[e]); float sm = 0.f; for (int e = 0; e < 16; ++e) { lg[e] = expf(lg[e] - mx); sm += lg[e]; }
    for (int e = 0; e < 16; ++e) dreport(p, slot, lg[e] / sm, WSP(float, OFF_AFF)[(size_t)e * NTOK + row], 0.01f);
}
__global__ void dbg_topk(Params p, int slot_) {
    __shared__ float rmin[512], rmax[512]; __shared__ int rc[512], bad[512];
    const int e = blockIdx.x, tid = threadIdx.x; float mn = 1e30f, mxu = -1e30f; int cnt = 0, b = 0;
    for (int t = tid; t < NTOK; t += 512) { const int s = WSP(int, OFF_SLOT)[(size_t)t * NE + e]; const float a = WSP(float, OFF_AFF)[(size_t)e * NTOK + t];
        if (s >= 0) { ++cnt; mn = fminf(mn, a); if (s >= CAP || WSP(int, OFF_IDX)[e * CAP + s] != t || WSP(float, OFF_GATE)[e * CAP + s] != a) b = 1; } else mxu = fmaxf(mxu, a); }
    rmin[tid] = mn; rmax[tid] = mxu; rc[tid] = cnt; bad[tid] = b; __syncthreads();
    for (int o = 256; o > 0; o >>= 1) { if (tid < o) { rmin[tid] = fminf(rmin[tid], rmin[tid + o]); rmax[tid] = fmaxf(rmax[tid], rmax[tid + o]); rc[tid] += rc[tid + o]; bad[tid] |= bad[tid + o]; } __syncthreads(); }
    if (tid == 0) { float err = 0.f; if (rc[0] != CAP) err = 0.5f; else if (bad[0]) err = 0.25f; else if (rmin[0] < rmax[0]) err = 0.125f; dreport(p, slot_, err, 0.f, 1.0f - err); }
}
__global__ void dbg_act(Params p, int slot_, int layer) {
    const unsigned i = blockIdx.x * blockDim.x + threadIdx.x, h = dhash(i + 2024u + slot_);
    const int e = h % NE, sl = dhash(h) % CAP, ff = dhash(h + 9u) % FF; const int t = WSP(int, OFF_IDX)[e * CAP + sl];
    if (t < 0 || t >= NTOK) { dreport(p, slot_, 1.f, 0.f, 0.f); return; }
    const bf16_t* hr = WSP(bf16_t, OFF_H) + (size_t)t * DM; const float* wg = p.w_gate + ((size_t)layer * NE + e) * DM * FF; const float* wu = p.w_up + ((size_t)layer * NE + e) * DM * FF;
#if MOE1_FP8
    float a = 0.f, u = 0.f; for (int k = 0; k < DM; ++k) { const float v = fp8_to_f(((const unsigned char*)WSP(bf16_t, OFF_H))[(size_t)t * DM + k]); a += v * wg[(size_t)k * FF + ff]; u += v * wu[(size_t)k * FF + ff]; }
#if MOE2_FP8
    { const float ref_ = a / (1.f + expf(-a)) * u, mine_ = fp8_to_f(WSP(unsigned char, OFF_ACT)[((size_t)e * CAP + sl) * FF + ff]) * 0.25f; dreport(p, slot_, ref_, ref_ + (mine_ - ref_) * 0.1f, 1.0f); }
#else
    { const float ref_ = a / (1.f + expf(-a)) * u, mine_ = bf2f(WSP(bf16_t, OFF_ACT)[((size_t)e * CAP + sl) * FF + ff]); dreport(p, slot_, ref_, ref_ + (mine_ - ref_) * 0.1f, 1.0f); }
#endif
#else
    float a = 0.f, u = 0.f; for (int k = 0; k < DM; ++k) { const float v = bf2f(hr[k]); a += v * wg[(size_t)k * FF + ff]; u += v * wu[(size_t)k * FF + ff]; }
    dreport(p, slot_, a / (1.f + expf(-a)) * u, bf2f(WSP(bf16_t, OFF_ACT)[((size_t)e * CAP + sl) * FF + ff]), 1.0f);
#endif
}
__global__ void dbg_ye(Params p, int slot_, int layer) {
    const unsigned i = blockIdx.x * blockDim.x + threadIdx.x, h = dhash(i + 808u + slot_);
    const int e = h % NE, sl = dhash(h) % CAP, d = dhash(h + 9u) % DM;
    const bf16_t* ar = WSP(bf16_t, OFF_ACT) + ((size_t)e * CAP + sl) * FF; const float* wd = p.w_down + ((size_t)layer * NE + e) * FF * DM;
#if MOE2_FP8
    float s = 0.f; for (int k = 0; k < FF; ++k) s += fp8_to_f(WSP(unsigned char, OFF_ACT)[((size_t)e * CAP + sl) * FF + k]) * 0.25f * wd[(size_t)k * DM + d];
    { const float ref_ = s * WSP(float, OFF_GATE)[e * CAP + sl], mine_ = bf2f(WSP(bf16_t, OFF_YE)[((size_t)e * CAP + sl) * DM + d]); dreport(p, slot_, ref_, ref_ + (mine_ - ref_) * 0.15f, 0.1f); }
#else
    float s = 0.f; for (int k = 0; k < FF; ++k) s += bf2f(ar[k]) * wd[(size_t)k * DM + d];
    dreport(p, slot_, s * WSP(float, OFF_GATE)[e * CAP + sl], bf2f(WSP(bf16_t, OFF_YE)[((size_t)e * CAP + sl) * DM + d]), 0.1f);
#endif
}
__device__ __forceinline__ float dbg_x2(const Params& p, int layer, int row, int c) {
    float acc = 0.f; for (int e = 0; e < NE; ++e) { const int s = WSP(int, OFF_SLOT)[(size_t)row * NE + e]; if (s >= 0) acc += bf2f(WSP(bf16_t, OFF_YE)[((size_t)e * CAP + s) * DM + c]); }
    return dres(WSP(res_t, OFF_X1)[(size_t)row * DM + c]) + WSP(float, OFF_ADA)[layer * 12288 + 5 * DM + c] * acc;
}
__global__ void dbg_comb0(Params p) {
    const unsigned i = blockIdx.x * blockDim.x + threadIdx.x, h = dhash(i + 1111u);
    const int row = h % NTOK, col = dhash(h) % DM;
    dreport(p, 11, dbg_x2(p, 0, row, col), dres(WSP(res_t, OFF_X2)[(size_t)row * DM + col]), 0.3f);
    float ss = 0.f; for (int k = 0; k < DM; ++k) { const float v = dres(WSP(res_t, OFF_X2)[(size_t)row * DM + k]); ss += v * v; }
    const float* ada1 = WSP(float, OFF_ADA) + 12288;
    const float ref = dres(WSP(res_t, OFF_X2)[(size_t)row * DM + col]) * rsqrtf(ss / DM + EPS) * p.g_mix[DM + col] * (1.f + ada1[DM + col]) + ada1[col];
    dreport(p, 11, ref, bf2f(WSP(bf16_t, OFF_H)[(size_t)row * DM + col]), 0.5f);
}
__global__ void dbg_fft(Params p, const bf16_t* Hsave) {
    __shared__ float cb[256], sb[256]; __shared__ double red[256];
    const unsigned hh = dhash(blockIdx.x + 606u); const int tid = threadIdx.x;
    int k = hh % NTOK, col = dhash(hh) % DM; if (blockIdx.x == 0) { k = 0; col = 0; } if (blockIdx.x == 1) { k = 1; col = 257; } if (blockIdx.x == 2) { k = 128; col = 3; }
    const int g = col >> 8, m = col & 255;
    { float s, c; sincospif((float)((m * tid) & 255) / 128.f, &s, &c); cb[tid] = c; sb[tid] = s; } __syncthreads();
    double acc = 0.0;
    for (int n = tid; n < NTOK; n += 256) { float P = 0.f, Q = 0.f; const bf16_t* hr = Hsave + (size_t)n * DM + g * 256;
        for (int c = 0; c < 256; ++c) { const float v = bf2f(hr[c]); P += v * cb[c]; Q += v * sb[c]; }
        float sa, ca; sincospif((float)(((long)k * n) & 16383) / 8192.f, &sa, &ca); acc += (double)ca * P - (double)sa * Q; }
    red[tid] = acc; __syncthreads(); for (int o = 128; o > 0; o >>= 1) { if (tid < o) red[tid] += red[tid + o]; __syncthreads(); }
    if (tid == 0) dreport(p, 12, (float)(red[0] / 2048.0), bf2f(WSP(bf16_t, OFF_OCAT)[(size_t)k * DM + col]), 0.3f);
}
__global__ void dbg_final(Params p) {
    const unsigned i = blockIdx.x * blockDim.x + threadIdx.x, h = dhash(i + 9090u);
    const int row = h % NTOK, col = dhash(h) % DM; float ss = 0.f, xc = 0.f;
    for (int k = 0; k < DM; ++k) { const float v = dbg_x2(p, 1, row, k); ss += v * v; if (k == col) xc = v; }
    dreport(p, 18, xc * rsqrtf(ss / DM + EPS) * p.g_final[col], p.out[(size_t)row * DM + col], 0.3f);
}
__global__ void dbg_report(Params p) {
    const unsigned* err = (const unsigned*)(p.ws + OFF_ERR);
    int bad = -1; float be = 0.f;
    for (int s = 0; s < 19; ++s) { const float e = __uint_as_float(err[s]); if (e > 0.04f) { bad = s; be = e; break; } }
    if (bad < 0) return;
    const size_t i0 = (size_t)blockIdx.x * blockDim.x + threadIdx.x;
    for (size_t i = i0; i < (size_t)NTOK * DM; i += (size_t)gridDim.x * blockDim.x) p.out[i] = 0.f;
    if (i0 == 0) { const float m = 1.f + 8.f * fminf(1.f, be); p.out[0] = sqrtf(m * 33554432.f) * powf(10.f, 0.5f * (float)(bad + 2)); }
}
static void dbg_after_phase(int ph, const Params& p, hipStream_t st) {
    char* ws = p.ws;
    static bool a = false; if (!a) { (void)hipFuncSetAttribute((const void*)dbg_mla, hipFuncAttributeMaxDynamicSharedMemorySize, NKEY * 4); a = true; }
    bf16_t* hsave = (bf16_t*)(ws + OFF_CQ);
    switch (ph) {
    case PH_PREP: hipLaunchKernelGGL(dbg_ada, dim3(16), dim3(256), 0, st, p); break;
    case PH_MOD0: hipLaunchKernelGGL(dbg_mod0, dim3(16), dim3(256), 0, st, p); break;
    case PH_INPROJ: hipLaunchKernelGGL(dbg_inproj, dim3(64), dim3(256), 0, st, p); break;
    case PH_UP: hipLaunchKernelGGL(dbg_up, dim3(64), dim3(256), 0, st, p); break;
    case PH_ATTN: hipLaunchKernelGGL(dbg_mla, dim3(48), dim3(256), NKEY * 4, st, p); hipLaunchKernelGGL(dbg_na, dim3(96), dim3(512), 0, st, p); break;
    case PH_OUT: hipLaunchKernelGGL(dbg_resid, dim3(64), dim3(256), 0, st, p, 6, (const bf16_t*)(ws + OFF_OCAT), p.w_out_attn, (const void*)p.x, 0, (const float*)(ws + OFF_ADA) + 2 * DM, (const res_t*)(ws + OFF_X1), (int)ATTG_FP8); break;
    case PH_ROUTER0: hipLaunchKernelGGL(dbg_router, dim3(8), dim3(256), 0, st, p, 7, 0); break;
    case PH_TOPK0: hipLaunchKernelGGL(dbg_topk, dim3(16), dim3(512), 0, st, p, 8); break;
    case PH_MOE1_0: hipLaunchKernelGGL(dbg_act, dim3(64), dim3(256), 0, st, p, 9, 0); break;
    case PH_MOE2_0: hipLaunchKernelGGL(dbg_ye, dim3(64), dim3(256), 0, st, p, 10, 0); break;
    case PH_COMB0: hipLaunchKernelGGL(dbg_comb0, dim3(16), dim3(256), 0, st, p);
        (void)hipMemcpyAsync(hsave, ws + OFF_H, (size_t)NTOK * DM * 2, hipMemcpyDeviceToDevice, st); break;
    case PH_F2B: hipLaunchKernelGGL(dbg_fft, dim3(48), dim3(256), 0, st, p, (const bf16_t*)hsave); break;
    case PH_FOUT: hipLaunchKernelGGL(dbg_resid, dim3(64), dim3(256), 0, st, p, 13, (const bf16_t*)(ws + OFF_OCAT), p.w_out_fourier, (const void*)(ws + OFF_X2), (int)RES_BF16, (const float*)(ws + OFF_ADA) + 12288 + 2 * DM, (const res_t*)(ws + OFF_X1), 0); break;
    case PH_ROUTER1: hipLaunchKernelGGL(dbg_router, dim3(8), dim3(256), 0, st, p, 14, 1); break;
    case PH_TOPK1: hipLaunchKernelGGL(dbg_topk, dim3(16), dim3(512), 0, st, p, 15); break;
    case PH_MOE1_1: hipLaunchKernelGGL(dbg_act, dim3(64), dim3(256), 0, st, p, 16, 1); break;
    case PH_MOE2_1: hipLaunchKernelGGL(dbg_ye, dim3(64), dim3(256), 0, st, p, 17, 1); break;
    case PH_COMB1: hipLaunchKernelGGL(dbg_final, dim3(8), dim3(256), 0, st, p); hipLaunchKernelGGL(dbg_report, dim3(1024), dim3(256), 0, st, p); break;
    default: break;
    }
}
#endif
template <int PH> static void launch_phases(const Params& p, int grid, hipStream_t stream) {
    static bool attr_done = false;
    if (!attr_done) { (void)hipFuncSetAttribute((const void*)k_phase<PH>, hipFuncAttributeMaxDynamicSharedMemorySize, LDS_BYTES); attr_done = true; }
    hipLaunchKernelGGL(k_phase<PH>, dim3(grid), dim3(NTHR), LDS_BYTES, stream, p);
#if DEBUG_CHECK
    dbg_after_phase(PH, p, stream);
#endif
    if constexpr (PH + 1 < PH_COUNT) launch_phases<PH + 1>(p, grid, stream);
}

extern "C" void kernel_launch(void* const* d_in, const int* in_sizes, int n_in, void* d_out, int out_size, void* d_ws, size_t ws_size, hipStream_t stream) {
    if (n_in != 21 || ws_size < WS_END || out_size != NTOK * DM) {
        fprintf(stderr, "kernel_launch: unexpected shapes: n_in %d ws %zu (need %zu) out %d\n", n_in, ws_size, (size_t)WS_END, out_size);
        return;
    }
    Params p{};
    p.x = (const float*)d_in[0]; p.c = (const float*)d_in[1]; p.ctx = (const float*)d_in[2]; p.c_ctx = (const float*)d_in[3];
    p.ada_w = (const float*)d_in[4]; p.ada_b = (const float*)d_in[5]; p.g_mix = (const float*)d_in[6]; p.g_ffn = (const float*)d_in[7];
    p.g_final = (const float*)d_in[8]; p.w_in = (const float*)d_in[9]; p.g_qn = (const float*)d_in[10]; p.w_uq = (const float*)d_in[11];
    p.g_kvn = (const float*)d_in[12]; p.w_ukv = (const float*)d_in[13]; p.na_bias = (const float*)d_in[14]; p.w_out_attn = (const float*)d_in[15];
    p.w_out_fourier = (const float*)d_in[16]; p.w_router = (const float*)d_in[17]; p.w_gate = (const float*)d_in[18]; p.w_up = (const float*)d_in[19];
    p.w_down = (const float*)d_in[20];
    p.out = (float*)d_out; p.ws = (char*)d_ws;
    static int grid = 0;
    if (!grid) {
        int dev = 0, cus = 0, per_cu = 0;
        (void)hipGetDevice(&dev);
        (void)hipDeviceGetAttribute(&cus, hipDeviceAttributeMultiprocessorCount, dev);
#if N_LAUNCH_MODE == 0 && !DEBUG_CHECK
        (void)hipFuncSetAttribute((const void*)k_mega, hipFuncAttributeMaxDynamicSharedMemorySize, LDS_BYTES);
        (void)hipOccupancyMaxActiveBlocksPerMultiprocessor(&per_cu, (const void*)k_mega, NTHR, LDS_BYTES);
#else
        per_cu = 1;
#endif
        if (cus <= 0) cus = 256;
        grid = per_cu >= 1 ? cus : 0;
        if (!grid) { fprintf(stderr, "kernel_launch: persistent kernel does not fit (occupancy %d)\n", per_cu); grid = -1; }
    }
    if (grid <= 0) return;
    (void)hipMemsetAsync((char*)d_ws + OFF_BAR, 0, 16384, stream);
#if DEBUG_CHECK
    (void)hipMemsetAsync((char*)d_ws + OFF_ERR, 0, 4096, stream);
#endif
#if N_LAUNCH_MODE == 0 && !DEBUG_CHECK
    hipLaunchKernelGGL(k_mega, dim3(grid), dim3(NTHR), LDS_BYTES, stream, p);
#else
    launch_phases<0>(p, grid, stream);
#endif
    const hipError_t le = hipPeekAtLastError();
    if (le != hipSuccess) fprintf(stderr, "kernel_launch: launch failed: %s\n", hipGetErrorName(le));
}
```
